# Optimizing an MI355X kernel written in HIP

```python
import math
import jax, jax.numpy as jnp
from jax import lax
import numpy as np

D_MODEL = 1024
BATCH = 8
SEQ = 2048
DEPTH = 2

GRID_W = 64
CTX_LEN = 256
EPS = 1e-6
DA_HEADS = 4
DA_QK = 64
DA_V = 2 * DA_QK
DA_WIDTH = DA_HEADS * DA_V
ROPE_BASE = 10000.0
Q_BLOCK = 128
ML_HEADS = 4
ML_DH = 128
ML_WIDTH = ML_HEADS * ML_DH
ML_CHUNK = 128
SHORT_CONV = 3
CV_WIDTH = 512
N_BRANCH = 3
D_IN = 3 * DA_WIDTH + 4 * ML_WIDTH + 4 * ML_HEADS + 3 * CV_WIDTH + N_BRANCH * D_MODEL
PEER_HEADS = 8
PEER_NKEYS = 128
PEER_N = PEER_NKEYS * PEER_NKEYS
PEER_DKEY = 256
PEER_TOPK = 16
PEER_BLOCK = 128

kernel_name = "hybrid_diffattn_mlstm_conv_peer_dit"


def rmsnorm(x, g):
    x32 = x.astype(jnp.float32)
    y = x32 * lax.rsqrt(jnp.mean(x32 * x32, axis=-1, keepdims=True) + EPS)
    return (y * g.astype(jnp.float32)).astype(x.dtype)


def modulate(h, shift, scale):
    return h * (1 + scale) + shift


def split_cols(z):
    sizes = [DA_WIDTH, DA_WIDTH, DA_WIDTH, 2 * ML_WIDTH, ML_WIDTH, ML_WIDTH, 4 * ML_HEADS,
             CV_WIDTH, CV_WIDTH, CV_WIDTH, N_BRANCH * D_MODEL]
    offs = np.cumsum(sizes)[:-1].tolist()
    return jnp.split(z, offs, axis=-1)


def conv3(x, w):
    ch = x.shape[-1]
    return lax.conv_general_dilated(x, w[:, None, :].astype(x.dtype), window_strides=(1,),
                                    padding=((SHORT_CONV // 2, SHORT_CONV // 2),),
                                    dimension_numbers=('NWC', 'WIO', 'NWC'),
                                    feature_group_count=ch)


def axial_rope(x, row, col):
    quarter = DA_QK // 4
    inv = ROPE_BASE ** (-jnp.arange(quarter, dtype=jnp.float32) / quarter)

    def rot(xp, pos):
        ang = pos.astype(jnp.float32)[:, None] * inv[None, :]
        cos = jnp.cos(ang)[None, :, None, None, :].astype(x.dtype)
        sin = jnp.sin(ang)[None, :, None, None, :].astype(x.dtype)
        x1, x2 = jnp.split(xp, 2, axis=-1)
        return jnp.concatenate([x1 * cos - x2 * sin, x1 * sin + x2 * cos], axis=-1)

    xr, xc = jnp.split(x, 2, axis=-1)
    return jnp.concatenate([rot(xr, row), rot(xc, col)], axis=-1)


def diff_attention(qc, kc, vc, ql, kl, vl, lam, lam_init, subln_g, need_ctx):
    B, S, _ = ql.shape
    rows = S // GRID_W
    row = jnp.repeat(jnp.arange(rows), GRID_W)
    col = jnp.tile(jnp.arange(GRID_W), rows)

    def heads_qk(a):
        return a.reshape(a.shape[0], a.shape[1], DA_HEADS, 2, DA_QK)

    def heads_v(a):
        return a.reshape(a.shape[0], a.shape[1], DA_HEADS, DA_V)

    ql = axial_rope(heads_qk(ql), row, col)
    kl = axial_rope(heads_qk(kl), row, col)
    qc, kc, vc = heads_qk(qc), heads_qk(kc), heads_v(vc)
    k_all = jnp.concatenate([kc, kl], axis=1)
    v_all = jnp.concatenate([vc, heads_v(vl)], axis=1)
    scale = DA_QK ** -0.5

    def attend(q, k, v):
        s = jnp.einsum('bqhmd,bkhmd->bhmqk', q, k).astype(jnp.float32) * scale
        a = jax.nn.softmax(s, axis=-1)
        w = (a[:, :, 0] - lam * a[:, :, 1]).astype(v.dtype)
        return jnp.einsum('bhqk,bkhe->bqhe', w, v)

    def finish(o):
        T = o.shape[1]
        o = rmsnorm(o, subln_g) * (1.0 - lam_init)
        return o.reshape(o.shape[0], T, DA_WIDTH)

    nb = S // Q_BLOCK
    qb = jnp.moveaxis(ql.reshape(B, nb, Q_BLOCK, DA_HEADS, 2, DA_QK), 1, 0)
    ol = lax.map(lambda q: attend(q, k_all, v_all), qb)
    ol = finish(jnp.moveaxis(ol, 0, 1).reshape(B, S, DA_HEADS, DA_V))
    oc = finish(attend(qc, kc, vc)) if need_ctx else None
    return oc, ol


def mlstm_chunk(carry, inp):
    C, n, m = carry
    q, k, v, ig, lf = inp
    L = q.shape[2]
    b = jnp.cumsum(lf, axis=-1)
    seen = jnp.tril(jnp.ones((L, L), dtype=bool))
    log_d = jnp.where(seen, b[..., :, None] - b[..., None, :] + ig[..., None, :], -jnp.inf)
    m_path = b + m[..., None]
    m_t = jnp.maximum(m_path, jnp.max(log_d, axis=-1))
    d = jnp.exp(log_d - m_t[..., None])
    carry_w = jnp.exp(m_path - m_t)
    w = jnp.einsum('bhtd,bhsd->bhts', q, k) * d
    num = jnp.einsum('bhts,bhse->bhte', w, v) + carry_w[..., None] * jnp.einsum('bhtd,bhde->bhte', q, C)
    den = jnp.sum(w, axis=-1) + carry_w * jnp.einsum('bhtd,bhd->bht', q, n)
    h = num / jnp.maximum(jnp.abs(den), jnp.exp(-m_t))[..., None]
    b_end = b[..., -1]
    log_w = b_end[..., None] - b + ig
    m_new = jnp.maximum(b_end + m, jnp.max(log_w, axis=-1))
    wk = jnp.exp(log_w - m_new[..., None])
    decay = jnp.exp(b_end + m - m_new)
    C_new = decay[..., None, None] * C + jnp.einsum('bhs,bhsd,bhse->bhde', wk, k, v)
    n_new = decay[..., None] * n + jnp.einsum('bhs,bhsd->bhd', wk, k)
    return (C_new, n_new, m_new), h


def mlstm_scan(q, k, v, ig, lf, state):
    B, H, T, d = q.shape
    nc = T // ML_CHUNK

    def to_chunks(a):
        return jnp.moveaxis(a.reshape(a.shape[:2] + (nc, ML_CHUNK) + a.shape[3:]), 2, 0)

    state, h = lax.scan(mlstm_chunk, state, (to_chunks(q), to_chunks(k), to_chunks(v), to_chunks(ig), to_chunks(lf)))
    h = jnp.moveaxis(h, 0, 2).reshape(B, H, T, d)
    return h, state


def mlstm_mixer(qk_c, v_c, o_c, g_c, qk_l, v_l, o_l, g_l, conv_w, gate_b, norm_g, need_ctx):
    def prep(qk, v, gates):
        qk = jax.nn.silu(conv3(qk, conv_w))
        q, k = jnp.split(qk, 2, axis=-1)
        B, T, _ = q.shape

        def hd(a):
            return a.reshape(B, T, ML_HEADS, ML_DH).transpose(0, 2, 1, 3).astype(jnp.float32)

        g = (gates.reshape(B, T, 4, ML_HEADS) + gate_b).astype(jnp.float32).transpose(2, 0, 3, 1)
        fwd = (g[0], jax.nn.log_sigmoid(g[1]))
        bwd = (g[2], jax.nn.log_sigmoid(g[3]))
        return hd(q), hd(k) * (ML_DH ** -0.5), hd(v), fwd, bwd

    qc, kc, vc, gfc, gbc = prep(qk_c, v_c, g_c)
    ql, kl, vl, gfl, gbl = prep(qk_l, v_l, g_l)
    B = ql.shape[0]
    zero = (jnp.zeros((B, ML_HEADS, ML_DH, ML_DH), jnp.float32),
            jnp.zeros((B, ML_HEADS, ML_DH), jnp.float32),
            jnp.zeros((B, ML_HEADS), jnp.float32))

    def flip(a):
        return jnp.flip(a, axis=2)

    hc_f, st_f = mlstm_scan(qc, kc, vc, gfc[0], gfc[1], zero)
    hl_f, _ = mlstm_scan(ql, kl, vl, gfl[0], gfl[1], st_f)
    hc_b, st_b = mlstm_scan(flip(qc), flip(kc), flip(vc), flip(gbc[0]), flip(gbc[1]), zero)
    hl_b, _ = mlstm_scan(flip(ql), flip(kl), flip(vl), flip(gbl[0]), flip(gbl[1]), st_b)

    def out(h, o):
        Bh, H, T, d = h.shape
        h = rmsnorm(h.transpose(0, 2, 1, 3), norm_g.reshape(H, d)).reshape(Bh, T, H * d)
        return (h * jax.nn.sigmoid(o.astype(jnp.float32))).astype(o.dtype)

    yl = out(hl_f + flip(hl_b), o_l)
    yc = out(hc_f + flip(hc_b), o_c) if need_ctx else None
    return yc, yl


def short_conv(bg, cg, xv, w):
    return bg * conv3(cg * xv, w)


def merge(y_da, y_ml, y_cv, gate, w_da, w_ml, w_cv, w_o):
    g = jax.nn.sigmoid(gate.astype(jnp.float32)).astype(y_da.dtype)
    g_da, g_ml, g_cv = jnp.split(g, N_BRANCH, axis=-1)
    m = g_da * (y_da @ w_da) + g_ml * (y_ml @ w_ml) + g_cv * (y_cv @ w_cv)
    return m @ w_o


def token_mixers(hc, hl, w_in, ml_gate_b, ml_conv_w, ml_norm_g, cv_conv_w, da_lam, da_subln_g,
                 w_da, w_ml, w_cv, w_o, lam_init, need_ctx):
    zc = split_cols(hc @ w_in)
    zl = split_cols(hl @ w_in)
    lv = da_lam.astype(jnp.float32)
    lam = jnp.exp(jnp.sum(lv[0] * lv[1])) - jnp.exp(jnp.sum(lv[2] * lv[3])) + lam_init
    da_c, da_l = diff_attention(zc[0], zc[1], zc[2], zl[0], zl[1], zl[2], lam, lam_init, da_subln_g, need_ctx)
    ml_c, ml_l = mlstm_mixer(zc[3], zc[4], zc[5], zc[6], zl[3], zl[4], zl[5], zl[6],
                             ml_conv_w, ml_gate_b, ml_norm_g, need_ctx)
    cv_l = short_conv(zl[7], zl[8], zl[9], cv_conv_w)
    out_l = merge(da_l, ml_l, cv_l, zl[10], w_da, w_ml, w_cv, w_o)
    out_c = None
    if need_ctx:
        cv_c = short_conv(zc[7], zc[8], zc[9], cv_conv_w)
        out_c = merge(da_c, ml_c, cv_c, zc[10], w_da, w_ml, w_cv, w_o)
    return out_c, out_l


def peer(h, wq, keys, u_tab, v_tab):
    B, T, D = h.shape
    N = B * T
    K = PEER_TOPK
    x = h.reshape(N, D)
    q = (x @ wq).reshape(N, PEER_HEADS, 2, PEER_DKEY // 2)
    s = jnp.einsum('nhpd,hpkd->nhpk', q, keys).astype(jnp.float32)
    top_s, top_i = lax.top_k(s, K)
    cand = top_s[:, :, 0, :, None] + top_s[:, :, 1, None, :]
    best_s, best = lax.top_k(cand.reshape(N, PEER_HEADS, K * K), K)
    i1 = jnp.take_along_axis(top_i[:, :, 0], best // K, axis=-1)
    i2 = jnp.take_along_axis(top_i[:, :, 1], best % K, axis=-1)
    expert = (i1 * PEER_NKEYS + i2).reshape(N, PEER_HEADS * K)
    gate = jax.nn.softmax(best_s, axis=-1).reshape(N, PEER_HEADS * K).astype(h.dtype)
    nb = N // PEER_BLOCK

    def block(args):
        xb, eb, gb = args
        a = jax.nn.gelu(jnp.einsum('tkd,td->tk', u_tab[eb], xb), approximate=False)
        return jnp.einsum('tk,tkd->td', gb * a, v_tab[eb])

    y = lax.map(block, (x.reshape(nb, PEER_BLOCK, D),
                        expert.reshape(nb, PEER_BLOCK, PEER_HEADS * K),
                        gate.reshape(nb, PEER_BLOCK, PEER_HEADS * K)))
    return y.reshape(B, T, D)


def setup_inputs(seed: int = 0) -> dict:
    key = jax.random.key(seed)
    ks = jax.random.split(key, 26)

    def nrm(k, shape, s):
        return jax.random.normal(k, shape, jnp.float32) * s

    f_bias = jnp.linspace(3.0, 6.0, ML_HEADS, dtype=jnp.float32)
    zb = jnp.zeros((ML_HEADS,), jnp.float32)
    gate_base = jnp.stack([zb, f_bias, zb, f_bias])
    return {
        "x": nrm(ks[0], (BATCH, SEQ, D_MODEL), 1.0),
        "c": nrm(ks[1], (BATCH, D_MODEL), 1.0),
        "ctx": nrm(ks[2], (BATCH, CTX_LEN, D_MODEL), 1.0),
        "c_ctx": nrm(ks[3], (D_MODEL,), 1.0),
        "w_ada": nrm(ks[4], (DEPTH, D_MODEL, 6 * D_MODEL), D_MODEL ** -0.5),
        "b_ada": nrm(ks[5], (DEPTH, 6 * D_MODEL), 0.02),
        "norm1_g": 1.0 + nrm(ks[6], (DEPTH, D_MODEL), 0.02),
        "norm2_g": 1.0 + nrm(ks[7], (DEPTH, D_MODEL), 0.02),
        "w_in": nrm(ks[8], (DEPTH, D_MODEL, D_IN), D_MODEL ** -0.5),
        "ml_gate_b": gate_base[None] + nrm(ks[9], (DEPTH, 4, ML_HEADS), 0.1),
        "ml_conv_w": nrm(ks[10], (DEPTH, SHORT_CONV, 2 * ML_WIDTH), SHORT_CONV ** -0.5),
        "ml_norm_g": 1.0 + nrm(ks[11], (DEPTH, ML_WIDTH), 0.02),
        "cv_conv_w": nrm(ks[12], (DEPTH, SHORT_CONV, CV_WIDTH), SHORT_CONV ** -0.5),
        "da_lam": nrm(ks[13], (DEPTH, 4, DA_QK), 0.1),
        "da_subln_g": 1.0 + nrm(ks[14], (DEPTH, DA_V), 0.02),
        "w_da": nrm(ks[15], (DEPTH, DA_WIDTH, D_MODEL), DA_WIDTH ** -0.5),
        "w_ml": nrm(ks[16], (DEPTH, ML_WIDTH, D_MODEL), ML_WIDTH ** -0.5),
        "w_cv": nrm(ks[17], (DEPTH, CV_WIDTH, D_MODEL), CV_WIDTH ** -0.5),
        "w_o": nrm(ks[18], (DEPTH, D_MODEL, D_MODEL), D_MODEL ** -0.5),
        "peer_wq": nrm(ks[19], (DEPTH, D_MODEL, PEER_HEADS * PEER_DKEY), D_MODEL ** -0.5),
        "peer_keys": nrm(ks[20], (DEPTH, PEER_HEADS, 2, PEER_NKEYS, PEER_DKEY // 2), (PEER_DKEY // 2) ** -0.5),
        "peer_u": nrm(ks[21], (DEPTH, PEER_N, D_MODEL), D_MODEL ** -0.5),
        "peer_v": nrm(ks[22], (DEPTH, PEER_N, D_MODEL), 0.5),
        "final_g": 1.0 + nrm(ks[23], (D_MODEL,), 0.02),
    }


def reference(x, c, ctx, c_ctx, w_ada, b_ada, norm1_g, norm2_g, w_in, ml_gate_b, ml_conv_w, ml_norm_g,
              cv_conv_w, da_lam, da_subln_g, w_da, w_ml, w_cv, w_o, peer_wq, peer_keys, peer_u, peer_v,
              final_g):
    xl, xc = x, ctx
    for l in range(DEPTH):
        need_ctx = l < DEPTH - 1
        lam_init = 0.8 - 0.6 * math.exp(-0.3 * l)
        sh1, sc1, g1, sh2, sc2, g2 = jnp.split(jax.nn.silu(c) @ w_ada[l] + b_ada[l], 6, axis=-1)
        csh1, csc1, cg1, csh2, csc2, cg2 = jnp.split(jax.nn.silu(c_ctx) @ w_ada[l] + b_ada[l], 6, axis=-1)
        hl = modulate(rmsnorm(xl, norm1_g[l]), sh1[:, None], sc1[:, None])
        hc = modulate(rmsnorm(xc, norm1_g[l]), csh1, csc1)
        out_c, out_l = token_mixers(hc, hl, w_in[l], ml_gate_b[l], ml_conv_w[l], ml_norm_g[l], cv_conv_w[l],
                                    da_lam[l], da_subln_g[l], w_da[l], w_ml[l], w_cv[l], w_o[l], lam_init, need_ctx)
        xl = xl + g1[:, None] * out_l
        hl = modulate(rmsnorm(xl, norm2_g[l]), sh2[:, None], sc2[:, None])
        xl = xl + g2[:, None] * peer(hl, peer_wq[l], peer_keys[l], peer_u[l], peer_v[l])
        if need_ctx:
            xc = xc + cg1 * out_c
            hc = modulate(rmsnorm(xc, norm2_g[l]), csh2, csc2)
            xc = xc + cg2 * peer(hc, peer_wq[l], peer_keys[l], peer_u[l], peer_v[l])
    return rmsnorm(xl, final_g)
```

```cpp
#include <hip/hip_runtime.h>
#include <cstdio>
#include <cstdint>
#include <cmath>

constexpr int DM = 1024, NBATCH = 8, SEQ = 2048, CTXL = 256, DEPTH = 2;
constexpr int NLAT = NBATCH * SEQ, NCTX = NBATCH * CTXL, NROW = NLAT + NCTX;
constexpr int DIN = 8208;
constexpr int ZW = 8192;
constexpr int ZQ = 0, ZK = 512, ZV = 1024, ZMQ = 1536, ZMK = 2048, ZMV = 2560, ZMO = 3072, ZBG = 3584, ZCG = 4096, ZXV = 4608, ZGT = 5120;
constexpr int ORIG_GATE_COL = 3584;
constexpr int PEER_HEADS = 8, PEER_NK = 128, PEER_K = 16, PEER_NEXP = 16384, PEER_HK = PEER_HEADS * PEER_K;
constexpr float EPS = 1e-6f;
constexpr float QSCALE = 0.125f * 1.4426950408889634f;
constexpr int NCHUNK = 18;
constexpr int STW = 144;

constexpr size_t MiB = 1u << 20;
constexpr size_t WS_CTL = 0, CTL_ZERO_BYTES = 1 * MiB;
constexpr size_t WS_MOD = 1 * MiB;
constexpr size_t WS_MISC = WS_MOD + 512 * 1024;
constexpr size_t WS_WG = WS_MOD + 768 * 1024;
constexpr size_t WS_WIN = 2 * MiB;
constexpr size_t WS_WBR = 34 * MiB;
constexpr size_t WS_WO = 40 * MiB;
constexpr size_t WS_WQK = 44 * MiB;
constexpr size_t WS_H = 52 * MiB;
constexpr size_t WS_Y = 88 * MiB;
constexpr size_t WS_XC = 142 * MiB;
constexpr size_t WS_G = 150 * MiB;
constexpr size_t WS_ST = 152 * MiB;
constexpr size_t WS_Z = 193 * MiB;
constexpr size_t WS_END = WS_Z + (size_t)NROW * ZW * 2;
constexpr size_t WS_SC = WS_Z;
constexpr size_t WS_EIDX = WS_Z + 72 * MiB;
constexpr size_t WS_EGATE = WS_Z + 81 * MiB;
constexpr size_t WS_TU = WS_Z + 96 * MiB;
constexpr size_t WS_TV = WS_Z + 128 * MiB;
static_assert(WS_ST + (size_t)8 * 4 * 2 * 18 * STW * 128 * 2 <= WS_Z, "state buffer fits");
static_assert(WS_TV + 32 * MiB <= WS_END, "peer overlay fits");
constexpr int MISC_LAM = 0, MISC_COS = 64, MISC_SIN = 64 + 1024, MISC_DEC = 4096;
constexpr int CW_TMO = 0, CW_CODE = 1, CW_BAR = 4096;

constexpr int LDS_BYTES = 147456;
constexpr int LDSCTL_OFF = LDS_BYTES - 512;
constexpr int SCR_BYTES = LDSCTL_OFF;
constexpr int NWAVES = 8, NTHR = 512;

#ifndef ABL
#define ABL 0u
#endif
#define ABLF(l, k) ((ABL >> (4 * (l) + (k))) & 1u ? 0.0f : 1.0f)
#define MK_ONE_LAUNCH 0
namespace pg8 {
#define PG8_LAS __attribute__((address_space(3)))
typedef unsigned short bf16_t;
typedef short bf16x8 __attribute__((ext_vector_type(8)));
typedef float f32x4 __attribute__((ext_vector_type(4)));
typedef unsigned u32x4 __attribute__((ext_vector_type(4)));
constexpr int BM = 256, BK = 64, HALF = 128, HTB = HALF * BK * 2  , STAGE_BYTES = 8 * HTB, NXCD = 8, WGM = 8;

__host__ __device__ __forceinline__ int lds_byte(int r, int c) { const int st = (r >> 4) * 2 + (c >> 5), rr = r & 15, cc = c & 31, ob = rr * 64 + cc * 2; return st * 1024 + (ob ^ (((ob >> 9) & 1) << 5)); }
__host__ __device__ __forceinline__ void stage_rc(int b, int& R, int& C) { const int st = b / 1024, sb = b % 1024, swz = sb ^ (((sb >> 9) & 1) << 5); R = (st >> 1) * 16 + swz / 64; C = (st & 1) * 32 + (swz % 64) / 2; }
__host__ __device__ __forceinline__ int perm32(int rho) { const int n = rho >> 4, i = rho & 15; return 8 * (i >> 2) + 4 * n + (i & 3); }

struct Unit { int pm, pn; };
struct Gemm { const bf16_t* A; const bf16_t* Bt; int M, N, K; };

struct StaticOrder {
    int nM, nN, nwg, G, c;
    __host__ __device__ void init(int M, int N, int G_, int c_) { nM = M / BM; nN = N / BM; nwg = nM * nN; G = G_; c = c_; }
    __host__ __device__ bool next(int i, Unit& u) const {
        const long L = (long)i * G + c; if (L >= nwg) return false;
        int wgid = (int)L; { const int q = nwg / NXCD, r = nwg % NXCD, xcd = wgid % NXCD, off = wgid / NXCD; wgid = (xcd < r ? xcd * (q + 1) : r * (q + 1) + (xcd - r) * q) + off; }
        const int nig = WGM * nN, gid = wgid / nig, fm = gid * WGM, gsz = (nM - fm) < WGM ? (nM - fm) : WGM;
        u.pm = fm + ((wgid % nig) % gsz); u.pn = (wgid % nig) / gsz; return true;
    }
    __device__ __forceinline__ void a_ready(const Unit&) const {}
    __device__ __forceinline__ void done(const Unit&) const {}
};
__device__ __forceinline__ unsigned cvt_pk_bf16(float lo, float hi) { unsigned r; asm volatile("v_cvt_pk_bf16_f32 %0, %1, %2" : "=v"(r) : "v"(lo), "v"(hi)); return r; }
typedef unsigned u32x2 __attribute__((ext_vector_type(2)));
typedef _Float16 f16x2 __attribute__((ext_vector_type(2)));
__device__ __forceinline__ unsigned cvt_pk_f16(float lo, float hi) { f16x2 v = {(_Float16)lo, (_Float16)hi}; return __builtin_bit_cast(unsigned, v); }
__device__ __forceinline__ float bflo(unsigned w) { return __builtin_bit_cast(float, w << 16); }
__device__ __forceinline__ float bfhi(unsigned w) { return __builtin_bit_cast(float, w & 0xffff0000u); }
__device__ __forceinline__ float sigmoidf_(float x) { return 1.0f / (1.0f + __expf(-x)); }

template <bool F16> struct EpiStore16 {
    static constexpr bool PERM = true, AFTER_DRAIN = false;
    bf16_t* O; int ldc;
    __device__ __forceinline__ void operator()(const f32x4 (&acc)[2][2][4][2], const Unit& u, int wr, int wc, int fr, int fq) const {
        const int row0 = u.pm * BM + wr * 64 + fr, col0 = u.pn * BM + wc * 32 + 8 * fq;
#pragma unroll
        for (int ai = 0; ai < 2; ++ai)
#pragma unroll
            for (int m = 0; m < 4; ++m) { bf16_t* rowp = O + (size_t)(row0 + ai * HALF + m * 16) * ldc + col0;
#pragma unroll
                for (int bj = 0; bj < 2; ++bj) { const f32x4 v0 = acc[ai][bj][m][0], v1 = acc[ai][bj][m][1]; u32x4 w;
                    if (F16) { w.x = cvt_pk_f16(v0[0], v0[1]); w.y = cvt_pk_f16(v0[2], v0[3]); w.z = cvt_pk_f16(v1[0], v1[1]); w.w = cvt_pk_f16(v1[2], v1[3]); }
                    else { w.x = cvt_pk_bf16(v0[0], v0[1]); w.y = cvt_pk_bf16(v0[2], v0[3]); w.z = cvt_pk_bf16(v1[0], v1[1]); w.w = cvt_pk_bf16(v1[2], v1[3]); }
                    *(u32x4*)(rowp + bj * HALF) = w; } }
    }
};

struct EpiMerge {
    static constexpr bool PERM = true, AFTER_DRAIN = false;
    const bf16_t* Z; bf16_t* MB; int nMs, zw, zgt;
    __device__ __forceinline__ void operator()(const f32x4 (&acc)[2][2][4][2], const Unit& u, int wr, int wc, int fr, int fq) const {
        const int br = u.pn >> 2, pn = u.pn & 3, pmt = u.pm - br * nMs;
        const int row0 = pmt * BM + wr * 64 + fr, col0 = pn * BM + wc * 32 + 8 * fq;
#pragma unroll
        for (int ai = 0; ai < 2; ++ai)
#pragma unroll
            for (int m = 0; m < 4; ++m) { const size_t row = (size_t)(row0 + ai * HALF + m * 16);
#pragma unroll
                for (int bj = 0; bj < 2; ++bj) { const int col = col0 + bj * HALF;
                    const u32x4 gw = *(const u32x4*)(Z + row * zw + zgt + br * 1024 + col);
                    const f32x4 v0 = acc[ai][bj][m][0], v1 = acc[ai][bj][m][1];
                    float r[8];
                    r[0] = v0[0] * sigmoidf_(bflo(gw.x)); r[1] = v0[1] * sigmoidf_(bfhi(gw.x)); r[2] = v0[2] * sigmoidf_(bflo(gw.y)); r[3] = v0[3] * sigmoidf_(bfhi(gw.y));
                    r[4] = v1[0] * sigmoidf_(bflo(gw.z)); r[5] = v1[1] * sigmoidf_(bfhi(gw.z)); r[6] = v1[2] * sigmoidf_(bflo(gw.w)); r[7] = v1[3] * sigmoidf_(bfhi(gw.w));
                    bf16_t* op = MB + row * 1024 + col;
                    if (br > 0) { const u32x4 o = *(const u32x4*)op;
                        r[0] += bflo(o.x); r[1] += bfhi(o.x); r[2] += bflo(o.y); r[3] += bfhi(o.y); r[4] += bflo(o.z); r[5] += bfhi(o.z); r[6] += bflo(o.w); r[7] += bfhi(o.w); }
                    u32x4 w; w.x = cvt_pk_bf16(r[0], r[1]); w.y = cvt_pk_bf16(r[2], r[3]); w.z = cvt_pk_bf16(r[4], r[5]); w.w = cvt_pk_bf16(r[6], r[7]);
                    *(u32x4*)op = w; } }
    }
};
struct MergeOrder {
    int ntile, G, c, nMs;
    __device__ __forceinline__ bool next(int i, Unit& u) const { const int t = (i / 3) * G + c; if (t >= ntile) return false; const int br = i % 3; u.pm = br * nMs + (t >> 2); u.pn = br * 4 + (t & 3); return true; }
    __device__ __forceinline__ void a_ready(const Unit&) const {}
    __device__ __forceinline__ void done(const Unit&) const {}
};

struct EpiRes {
    static constexpr bool PERM = false, AFTER_DRAIN = false;
    const float* base_lat; float* dst_lat; const float* base_ctx; float* dst_ctx; const float* mod; int goff, nlat;
    __device__ __forceinline__ void operator()(const f32x4 (&acc)[2][2][4][2], const Unit& u, int wr, int wc, int fr, int fq) const {
        const int rowt = u.pm * BM; const bool lat = rowt < nlat;
        const float* base = lat ? base_lat + (size_t)rowt * 1024 : base_ctx + (size_t)(rowt - nlat) * 1024;
        float* dst = lat ? dst_lat + (size_t)rowt * 1024 : dst_ctx + (size_t)(rowt - nlat) * 1024;
        const float* g = mod + (lat ? (rowt >> 11) : 8) * 6144 + goff;
        const int col0 = u.pn * BM + wc * 32 + 4 * fq;
        f32x4 gv[2][2];
#pragma unroll
        for (int bj = 0; bj < 2; ++bj)
#pragma unroll
            for (int n = 0; n < 2; ++n) gv[bj][n] = *(const f32x4*)(g + col0 + bj * HALF + n * 16);
#pragma unroll
        for (int ai = 0; ai < 2; ++ai)
#pragma unroll
            for (int m = 0; m < 4; ++m) { const size_t off = (size_t)(ai * HALF + wr * 64 + m * 16 + fr) * 1024 + col0;
#pragma unroll
                for (int bj = 0; bj < 2; ++bj)
#pragma unroll
                    for (int n = 0; n < 2; ++n) { const f32x4 bs = *(const f32x4*)(base + off + bj * HALF + n * 16);
                        *(f32x4*)(dst + off + bj * HALF + n * 16) = bs + gv[bj][n] * acc[ai][bj][m][n]; } }
    }
};
template <class Epi, class Sched, bool ALIGN_EPI = false, bool SP2 = false>
__device__ __forceinline__ void gemm_phase(PG8_LAS unsigned char* lds, const Gemm g, const Sched& S, const Epi& E) {
    int tid_ = threadIdx.x; asm volatile("" : "+v"(tid_));
    const int tid = tid_, wid = __builtin_amdgcn_readfirstlane(tid >> 6), lane = tid & 63, wr = wid >> 2, wc = wid & 3, fr = lane & 15, fq = lane >> 4;
    const int K = g.K, nt = K / BK;
    unsigned voffA[2], voffB[2];
#pragma unroll
    for (int i = 0; i < 2; ++i) { int R, C; stage_rc(tid * 16 + i * 8192, R, C); const int Rb = Epi::PERM ? ((R & ~31) + perm32(R & 31)) : R;
        voffA[i] = (unsigned)(R * K + C) * 2u; voffB[i] = (unsigned)(Rb * K + C) * 2u; }
    const size_t kstep = (size_t)(BK * 2);
    const size_t hstep = (size_t)HALF * K * 2;
    const size_t tstep = 2 * hstep;
    const unsigned ldsw = (unsigned)wid * 1024u;
    const int aoff = lds_byte(wr * 64 + fr, fq * 8), boff = lds_byte(wc * 32 + fr, fq * 8);
#define PG8_SA(b, h) (((b) * 2 + (h)) * HTB)
#define PG8_SB(b, h) ((4 + (b) * 2 + (h)) * HTB)
#define PG8_STAGE(bufoff, gbase, voff) do { _Pragma("unroll") for (int _i = 0; _i < 2; ++_i) \
        __builtin_amdgcn_global_load_lds((const unsigned*)((const char*)(gbase) + (voff)[_i]), (PG8_LAS unsigned*)(lds + (bufoff) + ldsw + _i * 8192), 16, 0, 0); } while (0)
#define PG8_LDA(dst, b, h) do { _Pragma("unroll") for (int m = 0; m < 4; ++m) _Pragma("unroll") for (int k = 0; k < 2; ++k) dst[m][k] = *(const PG8_LAS bf16x8*)(lds + PG8_SA(b, h) + aoff + m * 2048 + k * 1024); } while (0)
#define PG8_LDB(dst, b, h) do { _Pragma("unroll") for (int n = 0; n < 2; ++n) _Pragma("unroll") for (int k = 0; k < 2; ++k) dst[n][k] = *(const PG8_LAS bf16x8*)(lds + PG8_SB(b, h) + boff + n * 2048 + k * 1024); } while (0)
#define PG8_MMA(ai, bj, At, Bt) do { __builtin_amdgcn_s_setprio(1); _Pragma("unroll") for (int m = 0; m < 4; ++m) _Pragma("unroll") for (int n = 0; n < 2; ++n) _Pragma("unroll") for (int k = 0; k < 2; ++k) \
        acc[ai][bj][m][n] = __builtin_amdgcn_mfma_f32_16x16x32_bf16(Bt[n][k], At[m][k], acc[ai][bj][m][n], 0, 0, 0); __builtin_amdgcn_s_setprio(0); } while (0)
#define PG8_WAIT_V(n) asm volatile("s_waitcnt vmcnt(" #n ")" ::: "memory")
#define PG8_WAIT_L(n) asm volatile("s_waitcnt lgkmcnt(" #n ")" ::: "memory")
#define PG8_BAR __builtin_amdgcn_s_barrier()
#define PG8_SCHED __builtin_amdgcn_sched_barrier(0)
    Unit cur, nxt; int ui = 0;
    if (!S.next(0, cur)) return;
    f32x4 acc[2][2][4][2];
#pragma unroll
    for (int a = 0; a < 2; ++a)
#pragma unroll
        for (int b = 0; b < 2; ++b)
#pragma unroll
            for (int m = 0; m < 4; ++m)
#pragma unroll
                for (int n = 0; n < 2; ++n) acc[a][b][m][n] = (f32x4){0.f, 0.f, 0.f, 0.f};
    bf16x8 At[4][2], B0[2][2], B1[2][2];
    const char* cA = (const char*)g.A + (size_t)cur.pm * tstep; const char* cB = (const char*)g.Bt + (size_t)cur.pn * tstep;
    S.a_ready(cur);
    if constexpr (SP2) {
        PG8_STAGE(PG8_SB(0, 0), cB, voffB); PG8_STAGE(PG8_SB(0, 1), cB + hstep, voffB); PG8_STAGE(PG8_SA(0, 0), cA, voffA); PG8_STAGE(PG8_SA(0, 1), cA + hstep, voffA);
        if (wr == 1) PG8_BAR;
        PG8_WAIT_V(2); PG8_BAR;
        PG8_STAGE(PG8_SB(1, 0), cB + kstep, voffB); PG8_STAGE(PG8_SA(1, 0), cA + kstep, voffA); PG8_STAGE(PG8_SB(1, 1), cB + hstep + kstep, voffB);
        PG8_WAIT_V(6); PG8_BAR;
    } else {
        PG8_STAGE(PG8_SB(0, 0), cB, voffB); PG8_STAGE(PG8_SA(0, 0), cA, voffA); PG8_STAGE(PG8_SB(0, 1), cB + hstep, voffB); PG8_STAGE(PG8_SA(0, 1), cA + hstep, voffA);
        if (wr == 1) PG8_BAR;
        PG8_WAIT_V(4); PG8_BAR;
        PG8_STAGE(PG8_SB(1, 0), cB + kstep, voffB); PG8_STAGE(PG8_SA(1, 0), cA + kstep, voffA); PG8_STAGE(PG8_SB(1, 1), cB + hstep + kstep, voffB);
        PG8_WAIT_V(6); PG8_BAR;
    }
    for (;;) {
        const bool has_next = S.next(ui + 1, nxt);
        const char* nA = has_next ? (const char*)g.A + (size_t)nxt.pm * tstep : cA; const char* nB = has_next ? (const char*)g.Bt + (size_t)nxt.pn * tstep : cB;
        for (int t = 0; t < nt; t += 2) {
            const bool last = (t == nt - 2);
            const char* a1 = cA + (size_t)(t + 1) * kstep;
            const char* a2 = last ? nA : cA + (size_t)(t + 2) * kstep; const char* b2 = last ? nB : cB + (size_t)(t + 2) * kstep;
            const char* a3 = a2 + kstep; const char* b3 = b2 + kstep;
            if (last && has_next) S.a_ready(nxt);
            if constexpr (SP2) {
            PG8_LDB(B0, 0, 0); PG8_LDB(B1, 0, 1); PG8_SCHED; PG8_LDA(At, 0, 0); PG8_STAGE(PG8_SA(1, 1), a1 + hstep, voffA);
            PG8_WAIT_V(8); PG8_WAIT_L(0); PG8_BAR; PG8_MMA(0, 0, At, B0); PG8_MMA(0, 1, At, B1); PG8_BAR; PG8_SCHED;
            PG8_LDA(At, 0, 1); PG8_STAGE(PG8_SB(0, 0), b2, voffB); PG8_STAGE(PG8_SB(0, 1), b2 + hstep, voffB); PG8_STAGE(PG8_SA(0, 0), a2, voffA);
            PG8_WAIT_V(8); PG8_WAIT_L(0); PG8_BAR; PG8_MMA(1, 0, At, B0); PG8_MMA(1, 1, At, B1); PG8_BAR; PG8_SCHED;
            PG8_LDB(B0, 1, 0); PG8_LDB(B1, 1, 1); PG8_SCHED; PG8_LDA(At, 1, 0); PG8_STAGE(PG8_SA(0, 1), a2 + hstep, voffA);
            PG8_WAIT_V(8); PG8_WAIT_L(0); PG8_BAR; PG8_MMA(0, 0, At, B0); PG8_MMA(0, 1, At, B1); PG8_BAR; PG8_SCHED;
            PG8_LDA(At, 1, 1); PG8_STAGE(PG8_SB(1, 0), b3, voffB); PG8_STAGE(PG8_SB(1, 1), b3 + hstep, voffB); PG8_STAGE(PG8_SA(1, 0), a3, voffA);
            PG8_WAIT_V(8); PG8_WAIT_L(0); PG8_BAR; PG8_MMA(1, 0, At, B0); PG8_MMA(1, 1, At, B1); PG8_BAR; PG8_SCHED;
            } else {
            PG8_LDB(B0, 0, 0); PG8_SCHED; PG8_LDA(At, 0, 0); PG8_STAGE(PG8_SA(1, 1), a1 + hstep, voffA);
            PG8_WAIT_L(8); PG8_BAR; PG8_WAIT_L(0); PG8_MMA(0, 0, At, B0); PG8_BAR; PG8_SCHED;
            PG8_LDB(B1, 0, 1); PG8_STAGE(PG8_SB(0, 0), b2, voffB);
            PG8_BAR; PG8_WAIT_L(0); PG8_MMA(0, 1, At, B1); PG8_BAR;
            PG8_LDA(At, 0, 1); PG8_STAGE(PG8_SA(0, 0), a2, voffA);
            PG8_BAR; PG8_WAIT_L(0); PG8_MMA(1, 0, At, B0); PG8_BAR; PG8_SCHED;
            PG8_STAGE(PG8_SB(0, 1), b2 + hstep, voffB);
            PG8_WAIT_V(6); PG8_BAR; PG8_MMA(1, 1, At, B1); PG8_BAR;
            PG8_LDB(B0, 1, 0); PG8_SCHED; PG8_LDA(At, 1, 0); PG8_STAGE(PG8_SA(0, 1), a2 + hstep, voffA);
            PG8_WAIT_L(8); PG8_BAR; PG8_WAIT_L(0); PG8_MMA(0, 0, At, B0); PG8_BAR; PG8_SCHED;
            PG8_LDB(B1, 1, 1); PG8_STAGE(PG8_SB(1, 0), b3, voffB);
            PG8_BAR; PG8_WAIT_L(0); PG8_MMA(0, 1, At, B1); PG8_BAR;
            PG8_LDA(At, 1, 1); PG8_STAGE(PG8_SA(1, 0), a3, voffA);
            PG8_BAR; PG8_WAIT_L(0); PG8_MMA(1, 0, At, B0); PG8_BAR; PG8_SCHED;
            PG8_STAGE(PG8_SB(1, 1), b3 + hstep, voffB);
            PG8_WAIT_V(6); PG8_BAR; PG8_MMA(1, 1, At, B1); PG8_BAR;
            }
        }
        if constexpr (ALIGN_EPI) { if (wr == 0) PG8_BAR; }
        if constexpr (!Epi::AFTER_DRAIN) { E(acc, cur, wr, wc, fr, fq); S.done(cur); }
        if (!has_next) break;
#pragma unroll
        for (int a = 0; a < 2; ++a)
#pragma unroll
            for (int b = 0; b < 2; ++b)
#pragma unroll
                for (int m = 0; m < 4; ++m)
#pragma unroll
                    for (int n = 0; n < 2; ++n) acc[a][b][m][n] = (f32x4){0.f, 0.f, 0.f, 0.f};
        cur = nxt; cA = nA; cB = nB; ++ui;
        if constexpr (ALIGN_EPI) { if (wr == 1) PG8_BAR; }
    }
    PG8_WAIT_V(0);
    if constexpr (!ALIGN_EPI) { if (wr == 0) PG8_BAR; }
    PG8_BAR;
    if constexpr (Epi::AFTER_DRAIN) { E.fused(acc, cur, wr, wc, fr, fq, lds, wid, lane); S.done(cur); }
#undef PG8_SA
#undef PG8_SB
#undef PG8_STAGE
#undef PG8_LDA
#undef PG8_LDB
#undef PG8_MMA
#undef PG8_WAIT_V
#undef PG8_WAIT_L
#undef PG8_BAR
#undef PG8_SCHED
}
}
#define GAS __attribute__((address_space(1)))
#define LAS __attribute__((address_space(3)))
typedef unsigned short bf16;
typedef unsigned v4u __attribute__((ext_vector_type(4)));
typedef float f32x4 __attribute__((ext_vector_type(4)));
typedef short bf16x8 __attribute__((ext_vector_type(8)));
typedef GAS unsigned gu32;
typedef GAS unsigned long long gu64;
#define RLX_AGENT __ATOMIC_RELAXED, __HIP_MEMORY_SCOPE_AGENT
#define LDS_WAIT() asm volatile("s_waitcnt lgkmcnt(0)" ::: "memory")
#define VM_WAIT() asm volatile("s_waitcnt vmcnt(0)" ::: "memory")
__device__ __forceinline__ unsigned long long rt() { return __builtin_amdgcn_s_memrealtime(); }
__device__ __forceinline__ unsigned f2bf(float f) { unsigned u = __builtin_bit_cast(unsigned, f); return (u + 0x7fffu + ((u >> 16) & 1u)) >> 16; }
__device__ __forceinline__ unsigned pk2(float lo, float hi) { return f2bf(lo) | (f2bf(hi) << 16); }
#define XB_TMO      128
#define XB_XCNT(j)  (256  + 64 * (j))
#define XB_XSUB(j)  (1280 + 64 * (j))
#define XB_XGEN(j)  (2304 + 64 * (j))
#define XB_TOP      3328
#define XB_TOPGEN   3392
#define XCD_BAR_WORDS 3456
#define XB_SPIN_CAP (1u << 18)

__device__ __forceinline__ unsigned xb_ld(unsigned* p)              { return __hip_atomic_load(p, __ATOMIC_RELAXED, __HIP_MEMORY_SCOPE_AGENT); }
__device__ __forceinline__ unsigned xb_add(unsigned* p, unsigned v) { return __hip_atomic_fetch_add(p, v, __ATOMIC_RELAXED, __HIP_MEMORY_SCOPE_AGENT); }
__device__ __forceinline__ unsigned xb_xcc_id() { return (unsigned)__builtin_amdgcn_s_getreg((3 << 11) | 20) & 0xFu; }
#define XB_SPIN(cond, bar) do { unsigned _sp = 0; while (cond) { __builtin_amdgcn_s_sleep(1); \
    if ((++_sp & 255u) == 0u) { if (xb_ld(&(bar)[XB_TMO])) break; if (_sp > XB_SPIN_CAP) { atomicAdd(&(bar)[XB_TMO], 1u); break; } } } } while (0)

struct XcdBarrier {
    unsigned* bar; unsigned x;
    volatile LAS unsigned* st;
};

__device__ __forceinline__ XcdBarrier xcd_barrier_post(unsigned* bar, volatile LAS unsigned* st) {
    XcdBarrier b; b.bar = bar; b.x = xb_xcc_id(); b.st = st;
    if (threadIdx.x == 0) (void)xb_add(&bar[XB_XCNT(b.x)], 1u);
    return b;
}
__device__ __forceinline__ void xcd_barrier_complete(unsigned* bar, unsigned x, unsigned& nloc, unsigned& nx) {
    const unsigned G = gridDim.x * gridDim.y * gridDim.z;
    unsigned sum, cnt, mine, sp = 0u;
    for (;;) {
        sum = 0u; cnt = 0u; mine = 0u;
#pragma unroll
        for (unsigned j = 0; j < 16; ++j) { const unsigned c = xb_ld(&bar[XB_XCNT(j)]); sum += c; cnt += (c > 0u) ? 1u : 0u; mine = (j == x) ? c : mine; }
        if (sum == G) break;
        __builtin_amdgcn_s_sleep(1);
        if ((++sp & 255u) == 0u) { if (xb_ld(&bar[XB_TMO])) break; if (sp > XB_SPIN_CAP) { atomicAdd(&bar[XB_TMO], 1u); break; } }
    }
    nloc = mine > 0u ? mine : 1u; nx = cnt > 0u ? cnt : 1u;
}

__device__ __forceinline__ void xcd_barrier(const XcdBarrier& b) {
    asm volatile("s_waitcnt vmcnt(0)" ::: "memory");
    __syncthreads();
    if (threadIdx.x == 0) {
        unsigned* bar = b.bar;
        __builtin_amdgcn_s_waitcnt(0);
        unsigned nloc = b.st[0], nx = b.st[1];
        if (nloc == 0u) { xcd_barrier_complete(bar, b.x, nloc, nx); b.st[0] = nloc; b.st[1] = nx; }
        const unsigned old = xb_add(&bar[XB_XSUB(b.x)], 1u);
        const unsigned gen = old / nloc;
        if (old + 1u == (gen + 1u) * nloc) {
            __builtin_amdgcn_fence(__ATOMIC_RELEASE, "agent");
            asm volatile("s_waitcnt vmcnt(0)" ::: "memory");
            const unsigned og = xb_add(&bar[XB_TOP], 1u);
            const unsigned tg = og / nx;
            if (og + 1u == (tg + 1u) * nx) xb_add(&bar[XB_TOPGEN], 1u);
            else XB_SPIN(xb_ld(&bar[XB_TOPGEN]) == tg, bar);
            __builtin_amdgcn_fence(__ATOMIC_ACQUIRE, "agent");
            xb_add(&bar[XB_XGEN(b.x)], 1u);
            asm volatile("s_waitcnt vmcnt(0)" ::: "memory");
        } else {
            XB_SPIN(xb_ld(&bar[XB_XGEN(b.x)]) == gen, bar);
            __builtin_amdgcn_fence(__ATOMIC_ACQUIRE, "agent");
            asm volatile("s_waitcnt vmcnt(0)" ::: "memory");
        }
    }
    __syncthreads();
}

typedef float f32x16 __attribute__((ext_vector_type(16)));
typedef short s16x4 __attribute__((ext_vector_type(4)));
typedef unsigned u32x2 __attribute__((ext_vector_type(2)));
using pg8::bflo; using pg8::bfhi; using pg8::sigmoidf_;

struct Args { const float* in[24]; float* out; unsigned char* ws; int ph_lo, ph_hi; };

struct Frame {
    LAS unsigned char* lds;
    unsigned char* ldsg;
    volatile LAS unsigned* MISC;
    gu32* ctl;
    int tid, lane, wave, vcu, G;
    const float* const* in_dummy;
    unsigned char* ws; float* out;
    const float *x, *c, *ctx, *c_ctx, *w_ada, *b_ada, *norm1_g, *norm2_g, *w_in, *ml_gate_b, *ml_conv_w, *ml_norm_g, *cv_conv_w, *da_lam, *da_subln_g,
                *w_da, *w_ml, *w_cv, *w_o, *peer_wq, *peer_keys, *peer_u, *peer_v, *final_g;
};

#define PHASE_FRAME Frame F = F0; { int t_ = F0.tid; asm volatile("" : "+v"(t_)); F.tid = t_; F.lane = t_ & 63; unsigned char* w_ = F0.ws; asm volatile("" : "+s"(w_)); F.ws = w_; }
__device__ __forceinline__ float wave_sum(float v) {
#pragma unroll
    for (int o = 1; o < 64; o <<= 1) v += __shfl_xor(v, o);
    return v;
}
__device__ __forceinline__ float wave_max(float v) {
#pragma unroll
    for (int o = 1; o < 64; o <<= 1) v = fmaxf(v, __shfl_xor(v, o));
    return v;
}
__device__ __forceinline__ float reduce16(const float (&p)[16], int lane) {
    float q8[8], q4[4], q2[2];
    { const bool up = (lane & 32) != 0;
#pragma unroll
      for (int i = 0; i < 8; ++i) { const float keep = up ? p[i + 8] : p[i], send = up ? p[i] : p[i + 8]; q8[i] = keep + __shfl_xor(send, 32); } }
    { const bool up = (lane & 16) != 0;
#pragma unroll
      for (int i = 0; i < 4; ++i) { const float keep = up ? q8[i + 4] : q8[i], send = up ? q8[i] : q8[i + 4]; q4[i] = keep + __shfl_xor(send, 16); } }
    { const bool up = (lane & 8) != 0;
#pragma unroll
      for (int i = 0; i < 2; ++i) { const float keep = up ? q4[i + 2] : q4[i], send = up ? q4[i] : q4[i + 2]; q2[i] = keep + __shfl_xor(send, 8); } }
    float v;
    { const bool up = (lane & 4) != 0; const float keep = up ? q2[1] : q2[0], send = up ? q2[0] : q2[1]; v = keep + __shfl_xor(send, 4); }
    v += __shfl_xor(v, 2); v += __shfl_xor(v, 1);
    return v;
}
__device__ __forceinline__ int red16_index(int lane) { return ((lane >> 5) & 1) * 8 + ((lane >> 4) & 1) * 4 + ((lane >> 3) & 1) * 2 + ((lane >> 2) & 1); }
__device__ __forceinline__ int red16_lane(int e) { return ((e >> 3) & 1) * 32 + ((e >> 2) & 1) * 16 + ((e >> 1) & 1) * 8 + (e & 1) * 4; }

__device__ __forceinline__ float siluf_(float x) { return x / (1.0f + __expf(-x)); }
__device__ __forceinline__ float bf2f(bf16 b) { return __builtin_bit_cast(float, (unsigned)b << 16); }
__device__ __forceinline__ float log_sigmoidf_(float x) { return fminf(x, 0.f) - log1pf(__expf(-fabsf(x))); }
__device__ __forceinline__ float gelu_exact(float v) { return 0.5f * v * (1.0f + erff(v * 0.70710678118654752f)); }
__device__ __forceinline__ void unpack8(const v4u w, float (&f)[8]) {
    f[0] = bflo(w.x); f[1] = bfhi(w.x); f[2] = bflo(w.y); f[3] = bfhi(w.y); f[4] = bflo(w.z); f[5] = bfhi(w.z); f[6] = bflo(w.w); f[7] = bfhi(w.w);
}
__device__ __forceinline__ void ld8f(const float* p, float (&f)[8]) { const f32x4 a = *(const f32x4*)p, b = *(const f32x4*)(p + 4); f[0] = a.x; f[1] = a.y; f[2] = a.z; f[3] = a.w; f[4] = b.x; f[5] = b.y; f[6] = b.z; f[7] = b.w; }
__device__ __forceinline__ v4u pack8(const float (&f)[8]) { v4u w; w.x = pk2(f[0], f[1]); w.y = pk2(f[2], f[3]); w.z = pk2(f[4], f[5]); w.w = pk2(f[6], f[7]); return w; }

__device__ __forceinline__ void transpose_item(const float* W, int ldw, int k0, int nsrc0, bf16* WT, int K, int ndst0, LAS float* scr, int lane) {
#pragma unroll 8
    for (int i = 0; i < 32; ++i) { const int kk = 2 * i + (lane >> 5); scr[kk * 33 + (lane & 31)] = W[(size_t)(k0 + kk) * ldw + nsrc0 + (lane & 31)]; }
    LDS_WAIT(); asm volatile("" ::: "memory");
    const int c = lane & 7;
#pragma unroll
    for (int j = 0; j < 4; ++j) { const int n = (lane >> 3) + 8 * j; const LAS float* s = scr + (8 * c) * 33 + n;
        v4u o; o.x = pk2(s[0 * 33], s[1 * 33]); o.y = pk2(s[2 * 33], s[3 * 33]); o.z = pk2(s[4 * 33], s[5 * 33]); o.w = pk2(s[6 * 33], s[7 * 33]);
        *(GAS v4u*)(WT + (size_t)(ndst0 + n) * K + k0 + 8 * c) = o; }
    LDS_WAIT(); asm volatile("" ::: "memory");
}

#define WSP(T, off) ((T*)(F.ws + (off)))
#define MISCF (WSP(float, WS_MISC))

__device__ __forceinline__ void phase_prologue(Frame& F0) {
    PHASE_FRAME;
    const int gw = F.vcu * NWAVES + F.wave, NGW = F.G * NWAVES;
    {
        LAS float* keysS = (LAS float*)F.lds;
        LAS float* wqS = keysS + 128 * 129;
        for (int it = blockIdx.x; it < 512; it += F.G) {
            const int l = it >> 8, hp = (it >> 4) & 15, kb = it & 15;
            const float* keys = F.peer_keys + ((size_t)l * 16 + hp) * 16384;
            const float* wq = F.peer_wq + (size_t)l * 1024 * 2048 + (size_t)(kb * 64) * 2048 + hp * 128;
            for (int e = F.tid; e < 16384; e += NTHR) keysS[(e >> 7) * 129 + (e & 127)] = keys[e];
            for (int e = F.tid; e < 8192; e += NTHR) wqS[(e >> 7) * 129 + (e & 127)] = wq[(size_t)(e >> 7) * 2048 + (e & 127)];
            __syncthreads();
            const int kkl = F.tid & 63, kg = F.wave;
            float acc[16];
#pragma unroll
            for (int i = 0; i < 16; ++i) acc[i] = 0.f;
            for (int d = 0; d < 128; ++d) { const float w = wqS[kkl * 129 + d];
#pragma unroll
                for (int i = 0; i < 16; ++i) acc[i] += keysS[(kg * 16 + i) * 129 + d] * w; }
            bf16* o = WSP(bf16, WS_WQK) + (size_t)l * 2048 * 1024 + (size_t)(hp * 128 + kg * 16) * 1024 + kb * 64 + kkl;
#pragma unroll
            for (int i = 0; i < 16; ++i) o[(size_t)i * 1024] = (bf16)f2bf(acc[i]);
            __syncthreads();
        }
    }
    {
        LAS float* sc = (LAS float*)F.lds;
        LAS float* red = sc + 9 * 1024;
        for (int e = F.tid; e < 9 * 1024; e += NTHR) { const int r = e >> 10, k = e & 1023; const float v = r < 8 ? F.c[r * 1024 + k] : F.c_ctx[k]; sc[e] = siluf_(v); }
        __syncthreads();
        for (int it = blockIdx.x; it < 192; it += F.G) {
            const int l = it / 96, cb = it % 96;
            const float* W = F.w_ada + (size_t)l * 1024 * 6144 + cb * 64 + F.lane;
            float a[9];
#pragma unroll
            for (int r = 0; r < 9; ++r) a[r] = 0.f;
            const int k0 = F.wave * 128;
#pragma unroll 4
            for (int k = k0; k < k0 + 128; ++k) { const float w = W[(size_t)k * 6144];
#pragma unroll
                for (int r = 0; r < 9; ++r) a[r] += sc[r * 1024 + k] * w; }
#pragma unroll
            for (int r = 0; r < 9; ++r) red[(F.wave * 9 + r) * 64 + F.lane] = a[r];
            __syncthreads();
            for (int o = F.tid; o < 576; o += NTHR) { const int r = o >> 6, j = o & 63; float s = 0.f;
#pragma unroll
                for (int w = 0; w < 8; ++w) s += red[(w * 9 + r) * 64 + j];
                WSP(float, WS_MOD)[(size_t)(l * 9 + r) * 6144 + cb * 64 + j] = s + F.b_ada[l * 6144 + cb * 64 + j]; }
            __syncthreads();
        }
    }
    {
        const int gt = F.vcu * NTHR + F.tid, NGT = F.G * NTHR;
        for (int e = gt; e < 2 * 16 * 1024; e += NGT) { const int l = e >> 14, j = (e >> 10) & 15, k = e & 1023;
            WSP(float, WS_WG)[e] = F.w_in[(size_t)l * 1024 * DIN + (size_t)k * DIN + ORIG_GATE_COL + j]; }
        for (int e = gt; e < 64 * 16; e += NGT) { const int pos = e >> 4, i = e & 15;
            const float inv = exp2f(-(float)i * (13.287712379549449f / 16.0f));
            const float ang = (float)pos * inv;
            const float n = rintf(ang * 0.15915494309189535f);
            float r = fmaf(-n, 6.28318548202514648f, ang); r = fmaf(-n, -1.7484555e-7f, r);
            MISCF[MISC_COS + e] = __cosf(r); MISCF[MISC_SIN + e] = __sinf(r); }
        if (gt < 2) { const float* lv = F.da_lam + gt * 256; float s01 = 0.f, s23 = 0.f;
            for (int i = 0; i < 64; ++i) { s01 += lv[i] * lv[64 + i]; s23 += lv[128 + i] * lv[192 + i]; }
            const float lam_init = 0.8f - 0.6f * expf(-0.3f * (float)gt);
            MISCF[MISC_LAM + gt] = expf(s01) - expf(s23) + lam_init; }
    }
    {
        LAS float* scr = (LAS float*)(F.lds + F.wave * 16384);
        constexpr int PER_L = 4096 + 768 + 512;
        for (int it = gw; it < 2 * PER_L; it += NGW) {
            const int l = it / PER_L; int r = it % PER_L;
            if (r < 4096) { const int kb = r >> 8, n0 = (r & 255) * 32, nsrc = n0 + (n0 >= ORIG_GATE_COL ? 16 : 0);
                transpose_item(F.w_in + (size_t)l * 1024 * DIN, DIN, kb * 64, nsrc, WSP(bf16, WS_WIN) + (size_t)l * ZW * 1024, 1024, n0, scr, F.lane); }
            else if (r < 4864) { r -= 4096; const int br = r >> 8; r &= 255; const int kb = r >> 5, nb = r & 31;
                bf16* dst = WSP(bf16, WS_WBR) + (size_t)(l * 3 + br) * 1024 * 512; const size_t lo = (size_t)l * 512 * 1024;
                if (br == 0) transpose_item(F.w_da + lo, 1024, kb * 64, nb * 32, dst, 512, nb * 32, scr, F.lane);
                else if (br == 1) transpose_item(F.w_ml + lo, 1024, kb * 64, nb * 32, dst, 512, nb * 32, scr, F.lane);
                else transpose_item(F.w_cv + lo, 1024, kb * 64, nb * 32, dst, 512, nb * 32, scr, F.lane); }
            else { r -= 4864; const int kb = r >> 5, nb = r & 31;
                transpose_item(F.w_o + (size_t)l * 1024 * 1024, 1024, kb * 64, nb * 32, WSP(bf16, WS_WO) + (size_t)l * 1024 * 1024, 1024, nb * 32, scr, F.lane); }
        }
    }
}

__device__ __forceinline__ void phase_norm(Frame& F0, int l, int which) {
    PHASE_FRAME;
    const int gw = F.vcu * NWAVES + F.wave, NGW = F.G * NWAVES;
    LAS float* wg = (LAS float*)F.lds;
    if (which == 0) {
        const float* src = WSP(float, WS_WG) + (size_t)l * 16384;
        for (int e = F.tid * 4; e < 16384; e += NTHR * 4) *(LAS f32x4*)(wg + e) = *(const f32x4*)(src + e);
        __syncthreads();
    }
    const float* xl_src = (l == 0 && which == 0) ? F.x : F.out;
    const float* xc_src = (l == 0 && which == 0) ? F.ctx : WSP(float, WS_XC);
    const float* gn1 = F.norm1_g, * gn2 = F.norm2_g; const float* gn = (which ? gn2 : gn1) + l * 1024;
    const int nrows = (which == 1 && l == 1) ? NLAT : NROW;
    bf16* H = WSP(bf16, WS_H);
    for (int row = gw; row < nrows; row += NGW) {
        const bool lat = row < NLAT;
        const float* xr = lat ? xl_src + (size_t)row * 1024 : xc_src + (size_t)(row - NLAT) * 1024;
        const float* mod = WSP(float, WS_MOD) + (size_t)(l * 9 + (lat ? (row >> 11) : 8)) * 6144 + (which ? 3072 : 0);
        f32x4 v[4]; float ss = 0.f;
#pragma unroll
        for (int j = 0; j < 4; ++j) { v[j] = *(const f32x4*)(xr + F.lane * 4 + 256 * j); ss += (v[j].x * v[j].x + v[j].y * v[j].y) + (v[j].z * v[j].z + v[j].w * v[j].w); }
        const float rstd = 1.0f / sqrtf(wave_sum(ss) * (1.0f / 1024.0f) + EPS);
#pragma unroll
        for (int j = 0; j < 4; ++j) { const int c = F.lane * 4 + 256 * j;
            const f32x4 g = *(const f32x4*)(gn + c), sh = *(const f32x4*)(mod + c), sc = *(const f32x4*)(mod + 1024 + c);
            v[j] = (v[j] * rstd * g) * (sc + 1.0f) + sh;
            u32x2 w; w.x = pk2(v[j].x, v[j].y); w.y = pk2(v[j].z, v[j].w);
            *(u32x2*)(H + (size_t)row * 1024 + c) = w; }
        if (which == 0) {
            float p[16];
#pragma unroll
            for (int jj = 0; jj < 16; ++jj) { float s = 0.f;
#pragma unroll
                for (int j = 0; j < 4; ++j) { const f32x4 w = *(LAS f32x4*)(wg + jj * 1024 + F.lane * 4 + 256 * j); s += (v[j].x * w.x + v[j].y * w.y) + (v[j].z * w.z + v[j].w * w.w); }
                p[jj] = s; if ((jj & 3) == 3) __builtin_amdgcn_sched_barrier(0); }
            const float tot = reduce16(p, F.lane);
            if ((F.lane & 3) == 0) WSP(float, WS_G)[(size_t)row * 16 + red16_index(F.lane)] = tot;
        }
    }
    if (which == 1) {
        const size_t n8 = (size_t)PEER_NEXP * 1024 / 8;
        const float* su = F.peer_u + (size_t)l * PEER_NEXP * 1024; const float* sv = F.peer_v + (size_t)l * PEER_NEXP * 1024;
        bf16* du = WSP(bf16, WS_TU); bf16* dv = WSP(bf16, WS_TV);
        for (size_t i = (size_t)F.vcu * NTHR + F.tid; i < 2 * n8; i += (size_t)F.G * NTHR) {
            const bool isu = i < n8; const size_t j = isu ? i : i - n8;
            const float* s = (isu ? su : sv) + j * 8; const f32x4 a = *(const f32x4*)s, b = *(const f32x4*)(s + 4);
            v4u w; w.x = pk2(a.x, a.y); w.y = pk2(a.z, a.w); w.z = pk2(b.x, b.y); w.w = pk2(b.z, b.w);
            *(v4u*)((isu ? du : dv) + j * 8) = w; }
    }
}

__device__ __forceinline__ void phase_rope(Frame& F0) {
    PHASE_FRAME;
    const int gw = F.vcu * NWAVES + F.wave, NGW = F.G * NWAVES;
    const float* cosT = MISCF + MISC_COS; const float* sinT = MISCF + MISC_SIN;
    bf16* Z = WSP(bf16, WS_Z);
    for (int row = gw; row < NROW; row += NGW) {
        bf16* zr = Z + (size_t)row * ZW;
        if (row < NLAT) {
            const int t = row & 2047, pr = t >> 6, pc = t & 63;
#pragma unroll
            for (int tensor = 0; tensor < 2; ++tensor) { const int base = tensor ? ZK : ZQ; const float scale = tensor ? 1.0f : QSCALE;
#pragma unroll
                for (int it = 0; it < 4; ++it) { const int idx = F.lane + 64 * it, hm = idx >> 5, p = idx & 31, i = p & 15, isc = p >> 4, pos = isc ? pc : pr;
                    const int ca = base + hm * 64 + isc * 32 + i, cb = ca + 16;
                    const float c = cosT[pos * 16 + i], s = sinT[pos * 16 + i], xa = bf2f(zr[ca]), xb = bf2f(zr[cb]);
                    zr[ca] = (bf16)f2bf((xa * c - xb * s) * scale); zr[cb] = (bf16)f2bf((xa * s + xb * c) * scale); } }
        } else {
            float f[8]; unpack8(*(const v4u*)(zr + ZQ + F.lane * 8), f);
#pragma unroll
            for (int i = 0; i < 8; ++i) f[i] *= QSCALE;
            *(v4u*)(zr + ZQ + F.lane * 8) = pack8(f);
        }
    }
}
__device__ __forceinline__ void phase_convbranch(Frame& F0, int l) {
    PHASE_FRAME;
    const int nrows = l == 0 ? NROW : NLAT; const int total = nrows * 64;
    const bf16* Z = WSP(bf16, WS_Z); bf16* Y = WSP(bf16, WS_Y) + (size_t)2 * NROW * 512;
    const float* cw = F.cv_conv_w + l * 3 * 512;
    for (int e = F.vcu * NTHR + F.tid; e < total; e += F.G * NTHR) {
        const int row = e >> 6, c0 = (e & 63) * 8; const bool lat = row < NLAT;
        const int t = lat ? (row & 2047) : ((row - NLAT) & 255), L = lat ? 2048 : 256;
        const bf16* zr = Z + (size_t)row * ZW;
        float acc[8], a[8], b[8], w[8];
        unpack8(*(const v4u*)(zr + ZCG + c0), a); unpack8(*(const v4u*)(zr + ZXV + c0), b);
        ld8f(cw + 512 + c0, w);
#pragma unroll
        for (int i = 0; i < 8; ++i) acc[i] = w[i] * (a[i] * b[i]);
        if (t > 0) { unpack8(*(const v4u*)(zr - ZW + ZCG + c0), a); unpack8(*(const v4u*)(zr - ZW + ZXV + c0), b);
            ld8f(cw + c0, w);
#pragma unroll
            for (int i = 0; i < 8; ++i) acc[i] += w[i] * (a[i] * b[i]); }
        if (t < L - 1) { unpack8(*(const v4u*)(zr + ZW + ZCG + c0), a); unpack8(*(const v4u*)(zr + ZW + ZXV + c0), b);
            ld8f(cw + 1024 + c0, w);
#pragma unroll
            for (int i = 0; i < 8; ++i) acc[i] += w[i] * (a[i] * b[i]); }
        unpack8(*(const v4u*)(zr + ZBG + c0), a);
#pragma unroll
        for (int i = 0; i < 8; ++i) acc[i] *= a[i] * ABLF(l, 2);
        *(v4u*)(Y + (size_t)row * 512 + c0) = pack8(acc);
    }
}

constexpr int MLP = 136;
constexpr int GS_LF = 0, GS_IG = 256, GS_DEC = 512, GS_E = 768, GS_SC = 1024;
typedef float f32x4m __attribute__((ext_vector_type(4)));
#define MFMA16(a, b, c) __builtin_amdgcn_mfma_f32_16x16x32_bf16((a), (b), (c), 0, 0, 0)

struct MlItem { int b, h, ci, row0, t0, L; };
__device__ __forceinline__ MlItem ml_decode(int b, int h, int ci) {
    MlItem m; m.b = b; m.h = h; m.ci = ci;
    if (ci < 2) { m.row0 = NLAT + b * 256 + ci * 128; m.t0 = ci * 128; m.L = 256; }
    else { m.row0 = b * 2048 + (ci - 2) * 128; m.t0 = (ci - 2) * 128; m.L = 2048; }
    return m;
}
__device__ __forceinline__ int ml_sidx(int b, int h, int dir, int ci) { return ((b * 4 + h) * 2 + dir) * NCHUNK + ci; }

__device__ __forceinline__ void ml_gates(Frame& F, int l, const MlItem& m, LAS float* gs) {
    if (F.tid < 128) {
        const float* gr = WSP(float, WS_G) + (size_t)(m.row0 + F.tid) * 16; const float* gb = F.ml_gate_b + l * 16;
        gs[GS_IG + F.tid] = gr[m.h] + gb[m.h];
        gs[GS_LF + F.tid] = log_sigmoidf_(gr[4 + m.h] + gb[4 + m.h]);
        gs[GS_IG + 128 + F.tid] = gr[8 + m.h] + gb[8 + m.h];
        gs[GS_LF + 128 + F.tid] = log_sigmoidf_(gr[12 + m.h] + gb[12 + m.h]);
    }
    __syncthreads();
    if (F.wave < 2) {
        const int d = F.wave, s0 = 2 * F.lane, s1 = s0 + 1;
        const float a = gs[GS_LF + d * 128 + s0], b = gs[GS_LF + d * 128 + s1], pair = a + b;
        float incl = pair;
#pragma unroll
        for (int o = 1; o < 64; o <<= 1) { const float t = __shfl_up(incl, o); if (F.lane >= o) incl += t; }
        const float total = __shfl(incl, 63);
        const float P0 = incl - b, P1 = incl;
        const float D0 = d == 0 ? P0 : total - P0 + a, D1 = d == 0 ? P1 : total - P1 + b;
        const float a0 = gs[GS_IG + d * 128 + s0] - D0, a1 = gs[GS_IG + d * 128 + s1] - D1;
        const float M = wave_max(fmaxf(a0, a1));
        gs[GS_DEC + d * 128 + s0] = D0; gs[GS_DEC + d * 128 + s1] = D1;
        gs[GS_E + d * 128 + s0] = __expf(a0 - M); gs[GS_E + d * 128 + s1] = __expf(a1 - M);
        if (F.lane == 0) { gs[GS_SC + 2 * d] = M; gs[GS_SC + 2 * d + 1] = total; }
    }
    __syncthreads();
}
__device__ __forceinline__ void ml_conv8(const bf16* zr, int zc, const float* cw, int t, int L, float scale, float (&o)[8]) {
    float x[8], w[8];
    unpack8(*(const v4u*)(zr + zc), x); ld8f(cw + 1024, w);
#pragma unroll
    for (int i = 0; i < 8; ++i) o[i] = w[i] * x[i];
    if (t > 0) { unpack8(*(const v4u*)(zr - ZW + zc), x); ld8f(cw, w);
#pragma unroll
        for (int i = 0; i < 8; ++i) o[i] += w[i] * x[i]; }
    if (t < L - 1) { unpack8(*(const v4u*)(zr + ZW + zc), x); ld8f(cw + 2048, w);
#pragma unroll
        for (int i = 0; i < 8; ++i) o[i] += w[i] * x[i]; }
#pragma unroll
    for (int i = 0; i < 8; ++i) o[i] = siluf_(o[i]) * scale;
}
__device__ __forceinline__ void ml_fill_vt(Frame& F, const MlItem& m, LAS bf16* Vt) {
    const bf16* Z = WSP(bf16, WS_Z);
#pragma unroll 1
    for (int k = 0; k < 4; ++k) { const int task = F.tid + NTHR * k, s = task & 127, c0 = (task >> 7) * 8;
        const v4u w = *(const v4u*)(Z + (size_t)(m.row0 + s) * ZW + ZMV + m.h * 128 + c0);
        Vt[(c0 + 0) * MLP + s] = (bf16)(w.x & 0xffff); Vt[(c0 + 1) * MLP + s] = (bf16)(w.x >> 16); Vt[(c0 + 2) * MLP + s] = (bf16)(w.y & 0xffff); Vt[(c0 + 3) * MLP + s] = (bf16)(w.y >> 16);
        Vt[(c0 + 4) * MLP + s] = (bf16)(w.z & 0xffff); Vt[(c0 + 5) * MLP + s] = (bf16)(w.z >> 16); Vt[(c0 + 6) * MLP + s] = (bf16)(w.w & 0xffff); Vt[(c0 + 7) * MLP + s] = (bf16)(w.w >> 16); }
    for (int e = F.tid; e < 16 * 128; e += NTHR) { const int r = e >> 7, s = e & 127; Vt[(128 + r) * MLP + s] = r == 0 ? (bf16)0x3F80 : (bf16)0; }
}

__device__ __forceinline__ void phase_ml_a(Frame& F0, int l) {
    PHASE_FRAME;
    LAS bf16* Vt = (LAS bf16*)F.lds;
    LAS bf16* KtF = Vt + STW * MLP;
    LAS bf16* KtB = KtF + 128 * MLP;
    LAS float* gs = (LAS float*)(KtB + 128 * MLP);
    const bf16* Z = WSP(bf16, WS_Z);
    for (int item = blockIdx.x; item < NBATCH * 4 * NCHUNK; item += F.G) {
        int lane_ = F.lane; asm volatile("" : "+v"(lane_));
        const int g = lane_ >> 4, fr = lane_ & 15;
        const MlItem m = ml_decode(item / 72, (item / NCHUNK) % 4, item % NCHUNK);
        ml_gates(F, l, m, gs);
        ml_fill_vt(F, m, Vt);
#pragma unroll 1
        for (int k = 0; k < 4; ++k) { const int task = F.tid + NTHR * k, s = task & 127, c0 = (task >> 7) * 8;
            float kc[8];
            ml_conv8(Z + (size_t)(m.row0 + s) * ZW, ZMK + m.h * 128 + c0, F.ml_conv_w + (size_t)l * 3072 + 512 + m.h * 128 + c0, m.t0 + s, m.L, 0.08838834764831845f, kc);
            const float ef = gs[GS_E + s], eb = gs[GS_E + 128 + s];
#pragma unroll
            for (int i = 0; i < 8; ++i) { KtF[(c0 + i) * MLP + s] = (bf16)f2bf(kc[i] * ef); KtB[(c0 + i) * MLP + s] = (bf16)f2bf(kc[i] * eb); } }
        __syncthreads();
#pragma unroll 1
        for (int dir = 0; dir < 2; ++dir) {
            const LAS bf16* Kt = dir ? KtB : KtF;
            f32x4 acc[9];
#pragma unroll
            for (int mt = 0; mt < 9; ++mt) acc[mt] = (f32x4){0.f, 0.f, 0.f, 0.f};
#pragma unroll
            for (int kk = 0; kk < 4; ++kk) {
                const bf16x8 bfr = *(const LAS bf16x8*)(Kt + (16 * F.wave + fr) * MLP + 32 * kk + 8 * g);
#pragma unroll
                for (int mt = 0; mt < 9; ++mt) { const bf16x8 afr = *(const LAS bf16x8*)(Vt + (16 * mt + fr) * MLP + 32 * kk + 8 * g); acc[mt] = MFMA16(afr, bfr, acc[mt]); }
                __builtin_amdgcn_sched_barrier(0);
            }
            const float M = gs[GS_SC + 2 * dir], tot = gs[GS_SC + 2 * dir + 1], scale = __expf(tot + M);
            const int si = ml_sidx(m.b, m.h, dir, m.ci);
            bf16* st = WSP(bf16, WS_ST) + (size_t)si * (STW * 128);
#pragma unroll
            for (int mt = 0; mt < 9; ++mt)
#pragma unroll
                for (int r = 0; r < 4; ++r) st[(16 * mt + 4 * g + r) * 128 + 16 * F.wave + fr] = (bf16)f2bf(acc[mt][r] * scale);
            if (F.tid == 0) MISCF[MISC_DEC + si] = __expf(tot);
        }
        __syncthreads();
    }
}
__device__ __forceinline__ void phase_ml_b(Frame& F0) {
    PHASE_FRAME;
    constexpr int NV = STW * 128 / 8;
    for (int e = F.vcu * NTHR + F.tid; e < 64 * NV; e += F.G * NTHR) {
        const int chain = e / NV, vec = e % NV, dir = chain & 1;
        bf16* base = WSP(bf16, WS_ST) + (size_t)chain * NCHUNK * (STW * 128) + vec * 8;
        const float* dec = MISCF + MISC_DEC + chain * NCHUNK;
        float c[8];
#pragma unroll
        for (int i = 0; i < 8; ++i) c[i] = 0.f;
#pragma unroll 1
        for (int step = 0; step < NCHUNK; ++step) {
            const int ci = dir == 0 ? step : (step < 2 ? 1 - step : 19 - step);
            bf16* p = base + (size_t)ci * (STW * 128);
            float t[8]; unpack8(*(const v4u*)p, t);
            *(v4u*)p = pack8(c);
            const float d = dec[ci];
#pragma unroll
            for (int i = 0; i < 8; ++i) c[i] = d * c[i] + t[i];
        }
    }
}
__device__ __forceinline__ void phase_ml_c(Frame& F0, int l) {
    PHASE_FRAME;
    LAS bf16* Qi = (LAS bf16*)F.lds;
    LAS bf16* Ki = Qi + 128 * MLP;
    LAS bf16* Vt = Ki + 128 * MLP;
    LAS float* gs = (LAS float*)(Vt + STW * MLP);
    const bf16* Z = WSP(bf16, WS_Z); bf16* Yml = WSP(bf16, WS_Y) + (size_t)NROW * 512;
    const int w = F.wave;
    const int nitems = l == 0 ? NBATCH * 4 * NCHUNK : NBATCH * 4 * 16;
    for (int item = blockIdx.x; item < nitems; item += F.G) {
        const MlItem m = l == 0 ? ml_decode(item / 72, (item / NCHUNK) % 4, item % NCHUNK) : ml_decode(item / 64, (item / 16) % 4, 2 + (item % 16));
        ml_gates(F, l, m, gs);
        ml_fill_vt(F, m, Vt);
#pragma unroll 1
        for (int k = 0; k < 4; ++k) { const int task = F.tid + NTHR * k, s = task & 127, c0 = (task >> 7) * 8;
            const bf16* zr = Z + (size_t)(m.row0 + s) * ZW; const float* cw = F.ml_conv_w + (size_t)l * 3072 + m.h * 128 + c0;
            float qc[8], kc[8];
            ml_conv8(zr, ZMQ + m.h * 128 + c0, cw, m.t0 + s, m.L, 1.0f, qc);
            ml_conv8(zr, ZMK + m.h * 128 + c0, cw + 512, m.t0 + s, m.L, 0.08838834764831845f, kc);
            *(LAS v4u*)(Qi + s * MLP + c0) = pack8(qc); *(LAS v4u*)(Ki + s * MLP + c0) = pack8(kc); }
        __syncthreads();
        int lane_ = F.lane; asm volatile("" : "+v"(lane_));
        const int g = lane_ >> 4, fr = lane_ & 15;
        bf16x8 aq[4];
#pragma unroll
        for (int kk = 0; kk < 4; ++kk) aq[kk] = *(const LAS bf16x8*)(Qi + (16 * w + fr) * MLP + 32 * kk + 8 * g);
        f32x4 hs[8];
#pragma unroll
        for (int ct = 0; ct < 8; ++ct) hs[ct] = (f32x4){0.f, 0.f, 0.f, 0.f};
        LAS bf16* Pw = Qi + 16 * w * MLP;
#pragma unroll 1
        for (int dir = 0; dir < 2; ++dir) {
            f32x4 S[8];
#pragma unroll
            for (int nt = 0; nt < 8; ++nt) { f32x4 a = (f32x4){0.f, 0.f, 0.f, 0.f};
#pragma unroll
                for (int kk = 0; kk < 4; ++kk) { const bf16x8 bk = *(const LAS bf16x8*)(Ki + (16 * nt + fr) * MLP + 32 * kk + 8 * g); a = MFMA16(aq[kk], bk, a); }
                S[nt] = a; if (nt & 1) __builtin_amdgcn_sched_barrier(0); }
#pragma unroll
            for (int nt = 0; nt < 8; ++nt) { const int s = 16 * nt + fr; const float es = gs[GS_E + dir * 128 + s];
#pragma unroll
                for (int r = 0; r < 4; ++r) {
                    const bool full = dir == 0 ? (nt < w) : (nt > w), diag = nt == w, dk = dir == 0 ? (fr <= 4 * g + r) : (fr >= 4 * g + r);
                    const bool keep = full || (diag && dk);
                    Pw[(4 * g + r) * MLP + s] = (bf16)f2bf(keep ? S[nt][r] * es : 0.f); } }
            bf16x8 ap[4];
#pragma unroll
            for (int kk = 0; kk < 4; ++kk) ap[kk] = *(const LAS bf16x8*)(Pw + fr * MLP + 32 * kk + 8 * g);
            const bf16* st = WSP(bf16, WS_ST) + (size_t)ml_sidx(m.b, m.h, dir, m.ci) * (STW * 128);
            f32x4 ai[9], ac[9];
#pragma unroll
            for (int ct = 0; ct < 9; ++ct) { ai[ct] = (f32x4){0.f, 0.f, 0.f, 0.f}; ac[ct] = (f32x4){0.f, 0.f, 0.f, 0.f}; }
#pragma unroll
            for (int kk = 0; kk < 4; ++kk) {
#pragma unroll
                for (int ct = 0; ct < 9; ++ct) {
                    const bf16x8 bv = *(const LAS bf16x8*)(Vt + (16 * ct + fr) * MLP + 32 * kk + 8 * g); ai[ct] = MFMA16(ap[kk], bv, ai[ct]);
                    const bf16x8 bc = *(const bf16x8*)(st + (16 * ct + fr) * 128 + 32 * kk + 8 * g); ac[ct] = MFMA16(aq[kk], bc, ac[ct]);
                    if (ct % 3 == 2) __builtin_amdgcn_sched_barrier(0); } }
            const float eM = __expf(gs[GS_SC + 2 * dir]);
#pragma unroll
            for (int r = 0; r < 4; ++r) { const int t = 16 * w + 4 * g + r; const float rs = __expf(gs[GS_DEC + dir * 128 + t]);
                const float denl = rs * (eM * ai[8][r] + ac[8][r]);
                const float den = __shfl(denl, F.lane & 48);
                const float inv = 1.0f / fmaxf(fabsf(den), 1.0f);
#pragma unroll
                for (int ct = 0; ct < 8; ++ct) hs[ct][r] += rs * (eM * ai[ct][r] + ac[ct][r]) * inv; }
        }
        const float* ng = F.ml_norm_g + l * 512 + m.h * 128;
#pragma unroll
        for (int r = 0; r < 4; ++r) { float ss = 0.f;
#pragma unroll
            for (int ct = 0; ct < 8; ++ct) ss += hs[ct][r] * hs[ct][r];
            ss += __shfl_xor(ss, 1); ss += __shfl_xor(ss, 2); ss += __shfl_xor(ss, 4); ss += __shfl_xor(ss, 8);
            const float rstd = 1.0f / sqrtf(ss * (1.0f / 128.0f) + EPS);
            const size_t row = (size_t)(m.row0 + 16 * w + 4 * g + r);
#pragma unroll
            for (int ct = 0; ct < 8; ++ct) { const int col = 16 * ct + fr;
                const float og = sigmoidf_(bf2f(Z[row * ZW + ZMO + m.h * 128 + col]));
                Yml[row * 512 + m.h * 128 + col] = (bf16)f2bf(hs[ct][r] * rstd * ng[col] * og * ABLF(l, 1)); } }
        __syncthreads();
    }
}

constexpr int AT_SHM_V = 64 * 128 * 2, AT_SHM_K = 64 * 128 * 2;
#define KSWZ(row, colB) ((row) * 256 + ((colB) ^ (((row) & 7) << 4)))
#define SBAR() __builtin_amdgcn_sched_barrier(0)
__device__ __forceinline__ int crow(int r, int hi) { return (r & 3) + 8 * (r >> 2) + 4 * hi; }
__device__ __forceinline__ unsigned cvtpk(float lo, float hi) { unsigned r; asm volatile("v_cvt_pk_bf16_f32 %0, %1, %2" : "=v"(r) : "v"(lo), "v"(hi)); return r; }
__device__ __forceinline__ int v_st(int k, int c) { const int kk = (k & ~0xC) | ((k & 4) << 1) | ((k & 8) >> 1); return ((kk >> 3) * 4 + (c >> 5)) * 512 + ((kk & 7) * 32 + (c & 31)) * 2; }
__device__ __forceinline__ int v_rd_base(int lane) { return ((lane & 3) << 3) | (((lane >> 2) & 3) << 6) | (((lane >> 4) & 1) << 5) | (((lane >> 5) & 1) << 8); }
constexpr int v_rd_off(int d0, int ks, int half) { return d0 * 512 + ks * 4096 + half * 2048; }
template <int OFF> __device__ __forceinline__ s16x4 tr_read(int vb) { s16x4 r; asm volatile("ds_read_b64_tr_b16 %0, %1 offset:%2" : "=&v"(r) : "v"(vb), "i"(OFF) : "memory"); return r; }
template <int D0> __device__ __forceinline__ void pv_one(f32x16& od, int vb, bf16x8 pa0, bf16x8 pa1, bf16x8 pa2, bf16x8 pa3) {
    const s16x4 l0 = tr_read<v_rd_off(D0, 0, 0)>(vb), h0 = tr_read<v_rd_off(D0, 0, 1)>(vb), l1 = tr_read<v_rd_off(D0, 1, 0)>(vb), h1 = tr_read<v_rd_off(D0, 1, 1)>(vb);
    const s16x4 l2 = tr_read<v_rd_off(D0, 2, 0)>(vb), h2 = tr_read<v_rd_off(D0, 2, 1)>(vb), l3 = tr_read<v_rd_off(D0, 3, 0)>(vb), h3 = tr_read<v_rd_off(D0, 3, 1)>(vb);
    asm volatile("s_waitcnt lgkmcnt(0)" ::: "memory"); SBAR();
#define PK(L, H) (bf16x8){L[0], L[1], L[2], L[3], H[0], H[1], H[2], H[3]}
    od = __builtin_amdgcn_mfma_f32_32x32x16_bf16(pa0, PK(l0, h0), od, 0, 0, 0);
    od = __builtin_amdgcn_mfma_f32_32x32x16_bf16(pa1, PK(l1, h1), od, 0, 0, 0);
    od = __builtin_amdgcn_mfma_f32_32x32x16_bf16(pa2, PK(l2, h2), od, 0, 0, 0);
    od = __builtin_amdgcn_mfma_f32_32x32x16_bf16(pa3, PK(l3, h3), od, 0, 0, 0);
#undef PK
}
template <int MAP> __device__ __forceinline__ void qkt_map(f32x16& p0, f32x16& p1, const LAS char* Ks, const bf16x8* qr, int r32, int hi) {
    p0 = f32x16{}; p1 = f32x16{};
#pragma unroll
    for (int d0 = 4 * MAP; d0 < 4 * MAP + 4; ++d0) { const int cb = (d0 * 16 + hi * 8) * 2;
        const bf16x8 b0 = *(const LAS bf16x8*)(Ks + KSWZ(r32, cb));
        const bf16x8 b1 = *(const LAS bf16x8*)(Ks + KSWZ(32 + r32, cb));
        p0 = __builtin_amdgcn_mfma_f32_32x32x16_bf16(b0, qr[d0], p0, 0, 0, 0);
        p1 = __builtin_amdgcn_mfma_f32_32x32x16_bf16(b1, qr[d0], p1, 0, 0, 0); }
}
template <int HALF> __device__ __forceinline__ void qkt_half(f32x16& pm, f32x16& qm, const LAS char* Ks, const bf16x8* qr, int r32, int hi) {
    pm = f32x16{}; qm = f32x16{};
#pragma unroll
    for (int d0 = 0; d0 < 4; ++d0) {
        const bf16x8 b0 = *(const LAS bf16x8*)(Ks + KSWZ(32 * HALF + r32, (d0 * 16 + hi * 8) * 2));
        const bf16x8 b1 = *(const LAS bf16x8*)(Ks + KSWZ(32 * HALF + r32, ((4 + d0) * 16 + hi * 8) * 2));
        pm = __builtin_amdgcn_mfma_f32_32x32x16_bf16(b0, qr[d0], pm, 0, 0, 0);
        qm = __builtin_amdgcn_mfma_f32_32x32x16_bf16(b1, qr[4 + d0], qm, 0, 0, 0); }
}
__device__ __forceinline__ float swap_max(float v) { auto rr = __builtin_amdgcn_permlane32_swap(__float_as_uint(v), __float_as_uint(v), false, false); return fmaxf(__uint_as_float(rr[0]), __uint_as_float(rr[1])); }
__device__ __forceinline__ float swap_sum(float v) { auto rr = __builtin_amdgcn_permlane32_swap(__float_as_uint(v), __float_as_uint(v), false, false); return __uint_as_float(rr[0]) + __uint_as_float(rr[1]); }
__device__ __forceinline__ void online_ml(const f32x16& p0, const f32x16& p1, float& m, float& l) {
    float mx = p0[0];
#pragma unroll
    for (int r = 1; r < 16; ++r) mx = fmaxf(mx, p0[r]);
#pragma unroll
    for (int r = 0; r < 16; ++r) mx = fmaxf(mx, p1[r]);
    mx = swap_max(mx);
    const float mn = fmaxf(m, mx); float s = 0.f;
#pragma unroll
    for (int r = 0; r < 16; ++r) s += __builtin_amdgcn_exp2f(p0[r] - mn);
#pragma unroll
    for (int r = 0; r < 16; ++r) s += __builtin_amdgcn_exp2f(p1[r] - mn);
    l = l * __builtin_amdgcn_exp2f(m - mn) + s; m = mn;
}

__device__ __forceinline__ void attn_item(Frame& F, int l, int b, int h, int qb, float lam, float postscale) {
    const int tid = F.tid, wid = F.wave, lane = F.lane, r32 = lane & 31, hi = lane >> 5;
    const bool ctxq = qb < 0; const int NT = ctxq ? 4 : 36;
    const int qrow0 = ctxq ? NLAT + b * 256 : b * 2048 + qb * 256;
    const bf16* Z = WSP(bf16, WS_Z);
    LAS char* V_lds = (LAS char*)F.lds; LAS char* K_lds = V_lds + 2 * AT_SHM_V;
    bf16x8 qr[8];
    { const bf16* Qw = Z + (size_t)(qrow0 + wid * 32 + r32) * ZW + ZQ + h * 128 + hi * 8;
#pragma unroll
      for (int d0 = 0; d0 < 8; ++d0) qr[d0] = *(const bf16x8*)(Qw + d0 * 16); }
    const int sr = tid >> 4, sc = (tid & 15) * 8, vst0 = v_st(sr, sc), vst1 = v_st(32 + sr, sc), kc = sc * 2;
    const int vb0 = (int)(uintptr_t)V_lds + v_rd_base(lane);
#define KROW(j, r) ((size_t)((j) < 4 ? NLAT + b * 256 + (j) * 64 + (r) : b * 2048 + ((j) - 4) * 64 + (r)))
    float m0 = -1e30f, l0 = 0.f, m1 = -1e30f, l1 = 0.f;
    {
        bf16x8 ks0 = *(const bf16x8*)(Z + KROW(0, sr) * ZW + ZK + h * 128 + sc), ks1 = *(const bf16x8*)(Z + KROW(0, 32 + sr) * ZW + ZK + h * 128 + sc);
        *(LAS bf16x8*)(K_lds + KSWZ(sr, kc)) = ks0; *(LAS bf16x8*)(K_lds + KSWZ(32 + sr, kc)) = ks1;
        __syncthreads();
        for (int j = 0; j < NT; ++j) {
            const int cur = j & 1; const bool more = j + 1 < NT;
            if (more) { ks0 = *(const bf16x8*)(Z + KROW(j + 1, sr) * ZW + ZK + h * 128 + sc); ks1 = *(const bf16x8*)(Z + KROW(j + 1, 32 + sr) * ZW + ZK + h * 128 + sc); }
            const LAS char* Kc = K_lds + cur * AT_SHM_K;
            f32x16 p0, p1;
            qkt_map<0>(p0, p1, Kc, qr, r32, hi); online_ml(p0, p1, m0, l0);
            qkt_map<1>(p0, p1, Kc, qr, r32, hi); online_ml(p0, p1, m1, l1);
            if (more) { LAS char* Kn = K_lds + (cur ^ 1) * AT_SHM_K; *(LAS bf16x8*)(Kn + KSWZ(sr, kc)) = ks0; *(LAS bf16x8*)(Kn + KSWZ(32 + sr, kc)) = ks1; }
            __syncthreads();
        }
    }
    l0 = swap_sum(l0); l1 = swap_sum(l1);
    const float il0 = 1.0f / l0, il1 = lam / l1;
    f32x16 o[4]; o[0] = f32x16{}; o[1] = f32x16{}; o[2] = f32x16{}; o[3] = f32x16{};
    {
        bf16x8 ks0 = *(const bf16x8*)(Z + KROW(0, sr) * ZW + ZK + h * 128 + sc), ks1 = *(const bf16x8*)(Z + KROW(0, 32 + sr) * ZW + ZK + h * 128 + sc);
        bf16x8 vs0 = *(const bf16x8*)(Z + KROW(0, sr) * ZW + ZV + h * 128 + sc), vs1 = *(const bf16x8*)(Z + KROW(0, 32 + sr) * ZW + ZV + h * 128 + sc);
        *(LAS bf16x8*)(K_lds + KSWZ(sr, kc)) = ks0; *(LAS bf16x8*)(K_lds + KSWZ(32 + sr, kc)) = ks1;
        *(LAS bf16x8*)(V_lds + vst0) = vs0; *(LAS bf16x8*)(V_lds + vst1) = vs1;
        __syncthreads();
        for (int j = 0; j < NT; ++j) {
            const int cur = j & 1; const bool more = j + 1 < NT;
            const LAS char* Kc = K_lds + cur * AT_SHM_K;
            bf16x8 pa0, pa1, pa2, pa3;
#define PK4(P, BASE, OUT) do { unsigned a0 = cvtpk(P[BASE + 0], P[BASE + 1]), a1 = cvtpk(P[BASE + 2], P[BASE + 3]);   \
    unsigned b0 = cvtpk(P[BASE + 4], P[BASE + 5]), b1 = cvtpk(P[BASE + 6], P[BASE + 7]);                              \
    auto r0 = __builtin_amdgcn_permlane32_swap(a0, b0, false, false); auto r1 = __builtin_amdgcn_permlane32_swap(a1, b1, false, false); \
    v4u w_ = {r0[0], r1[0], r0[1], r1[1]}; OUT = __builtin_bit_cast(bf16x8, w_); } while (0)
            SBAR();
            { f32x16 pw, qw; qkt_half<0>(pw, qw, Kc, qr, r32, hi);
#pragma unroll
              for (int r = 0; r < 16; ++r) pw[r] = __builtin_amdgcn_exp2f(pw[r] - m0) * il0 - __builtin_amdgcn_exp2f(qw[r] - m1) * il1;
              PK4(pw, 0, pa0); PK4(pw, 8, pa1); }
            SBAR();
            { f32x16 pw, qw; qkt_half<1>(pw, qw, Kc, qr, r32, hi);
#pragma unroll
              for (int r = 0; r < 16; ++r) pw[r] = __builtin_amdgcn_exp2f(pw[r] - m0) * il0 - __builtin_amdgcn_exp2f(qw[r] - m1) * il1;
              PK4(pw, 0, pa2); PK4(pw, 8, pa3); }
#undef PK4
            SBAR();
            if (more) { ks0 = *(const bf16x8*)(Z + KROW(j + 1, sr) * ZW + ZK + h * 128 + sc); ks1 = *(const bf16x8*)(Z + KROW(j + 1, 32 + sr) * ZW + ZK + h * 128 + sc);
                        vs0 = *(const bf16x8*)(Z + KROW(j + 1, sr) * ZW + ZV + h * 128 + sc); vs1 = *(const bf16x8*)(Z + KROW(j + 1, 32 + sr) * ZW + ZV + h * 128 + sc); }
            SBAR();
            const int vb = vb0 + cur * AT_SHM_V;
            pv_one<0>(o[0], vb, pa0, pa1, pa2, pa3); pv_one<1>(o[1], vb, pa0, pa1, pa2, pa3); pv_one<2>(o[2], vb, pa0, pa1, pa2, pa3); pv_one<3>(o[3], vb, pa0, pa1, pa2, pa3);
            if (more) { LAS char* Kn = K_lds + (cur ^ 1) * AT_SHM_K; LAS char* Vn = V_lds + (cur ^ 1) * AT_SHM_V;
                *(LAS bf16x8*)(Kn + KSWZ(sr, kc)) = ks0; *(LAS bf16x8*)(Kn + KSWZ(32 + sr, kc)) = ks1;
                *(LAS bf16x8*)(Vn + vst0) = vs0; *(LAS bf16x8*)(Vn + vst1) = vs1; }
            __syncthreads();
        }
    }
#undef KROW
    const float* sg = F.da_subln_g + l * 128;
    bf16* Yda = WSP(bf16, WS_Y);
    float g4[4];
#pragma unroll
    for (int d0 = 0; d0 < 4; ++d0) g4[d0] = sg[32 * d0 + r32] * postscale * ABLF(l, 0);
#pragma unroll
    for (int r = 0; r < 16; ++r) {
        float ss = (o[0][r] * o[0][r] + o[1][r] * o[1][r]) + (o[2][r] * o[2][r] + o[3][r] * o[3][r]);
        ss += __shfl_xor(ss, 1); ss += __shfl_xor(ss, 2); ss += __shfl_xor(ss, 4); ss += __shfl_xor(ss, 8); ss += __shfl_xor(ss, 16);
        const float rstd = 1.0f / sqrtf(ss * (1.0f / 128.0f) + EPS);
        bf16* yr = Yda + (size_t)(qrow0 + wid * 32 + crow(r, hi)) * 512 + h * 128 + r32;
#pragma unroll
        for (int d0 = 0; d0 < 4; ++d0) yr[32 * d0] = (bf16)f2bf(o[d0][r] * rstd * g4[d0]);
    }
}
__device__ __forceinline__ void phase_attn(Frame& F0, int l) {
    PHASE_FRAME;
    const float lam = MISCF[MISC_LAM + l]; const float lam_init = 0.8f - 0.6f * expf(-0.3f * (float)l);
    const int nitems = l == 0 ? 288 : 256;
    for (int it = F.vcu; it < nitems; it += F.G) {
        if (it < 256) attn_item(F, l, it >> 5, (it >> 3) & 3, it & 7, lam, 1.0f - lam_init);
        else { const int j = it - 256; attn_item(F, l, j >> 2, j & 3, -1, lam, 1.0f - lam_init); }
    }
}

__device__ __forceinline__ unsigned fkey(float f) { const unsigned b = __float_as_uint(f); return (b & 0x80000000u) ? ~b : (b | 0x80000000u); }
__device__ __forceinline__ float funkey(unsigned k) { return __uint_as_float((k & 0x80000000u) ? (k & 0x7fffffffu) : ~k); }
__device__ __forceinline__ void ins16(unsigned (&lst)[16], unsigned v) {
#pragma unroll
    for (int i = 0; i < 16; ++i) { const unsigned hi = lst[i] > v ? lst[i] : v; v = lst[i] > v ? v : lst[i]; lst[i] = hi; }
}
__device__ __forceinline__ void phase_peer_topk(Frame& F0, int l) {
    PHASE_FRAME;
    const int nprob = (l == 0 ? NROW : NLAT) * 8;
    const _Float16* SC = WSP(_Float16, WS_SC);
    typedef _Float16 h8 __attribute__((ext_vector_type(8)));
    for (int pidx = F.vcu * NTHR + F.tid; pidx < nprob; pidx += F.G * NTHR) {
        const int row = pidx >> 3, hh = pidx & 7;
        const _Float16* sp = SC + (size_t)row * 2048 + hh * 256;
        unsigned l0[16], l1[16];
#pragma unroll
        for (int i = 0; i < 16; ++i) { l0[i] = 0u; l1[i] = 0u; }
#pragma unroll 2
        for (int c8 = 0; c8 < 16; ++c8) { const h8 a = *(const h8*)(sp + c8 * 8), b = *(const h8*)(sp + 128 + c8 * 8);
#pragma unroll
            for (int e = 0; e < 8; ++e) { const unsigned idx = (unsigned)(c8 * 8 + e);
                ins16(l0, (fkey((float)a[e]) & ~127u) | (127u - idx)); ins16(l1, (fkey((float)b[e]) & ~127u) | (127u - idx)); } }
        float v0[16], v1[16]; unsigned i0[16], i1[16];
#pragma unroll
        for (int i = 0; i < 16; ++i) { v0[i] = funkey(l0[i] & ~127u); i0[i] = 127u - (l0[i] & 127u); v1[i] = funkey(l1[i] & ~127u); i1[i] = 127u - (l1[i] & 127u); }
        unsigned best[16];
#pragma unroll
        for (int i = 0; i < 16; ++i) best[i] = 0u;
#pragma unroll
        for (int i = 0; i < 16; ++i)
#pragma unroll
            for (int j = 0; j < 16; ++j) if ((i + 1) * (j + 1) <= 16) ins16(best, (fkey(v0[i] + v1[j]) & ~255u) | (255u - (unsigned)(i * 16 + j)));
        float bs[16]; float mx = funkey(best[0] & ~255u), sum = 0.f;
#pragma unroll
        for (int r = 0; r < 16; ++r) { bs[r] = __expf(funkey(best[r] & ~255u) - mx); sum += bs[r]; }
        const float inv = 1.0f / sum;
        int* eo = WSP(int, WS_EIDX) + (size_t)row * 128 + hh * 16; float* go = WSP(float, WS_EGATE) + (size_t)row * 128 + hh * 16;
#pragma unroll
        for (int r = 0; r < 16; ++r) { const unsigned flat = 255u - (best[r] & 255u), ii = flat >> 4, jj = flat & 15u; unsigned e1 = 0u, e2 = 0u;
#pragma unroll
            for (int t = 0; t < 16; ++t) { e1 = ii == (unsigned)t ? i0[t] : e1; e2 = jj == (unsigned)t ? i1[t] : e2; }
            eo[r] = (int)(e1 * 128u + e2); go[r] = bs[r] * inv; }
    }
}

__device__ __forceinline__ void phase_peer_gather(Frame& F0, int l) {
    PHASE_FRAME;
    const int gw = F.vcu * NWAVES + F.wave, NGW = F.G * NWAVES;
    const int nrows = l == 0 ? NROW : NLAT;
    const bf16* H = WSP(bf16, WS_H); const bf16* TU = WSP(bf16, WS_TU); const bf16* TV = WSP(bf16, WS_TV);
    const int* EI = WSP(int, WS_EIDX); const float* EG = WSP(float, WS_EGATE);
    const int lane = F.lane, myi = red16_index(lane);
    for (int row = gw; row < nrows; row += NGW) {
        float hf[16];
        { float t[8]; unpack8(*(const v4u*)(H + (size_t)row * 1024 + lane * 8), t);
#pragma unroll
          for (int i = 0; i < 8; ++i) hf[i] = t[i];
          unpack8(*(const v4u*)(H + (size_t)row * 1024 + 512 + lane * 8), t);
#pragma unroll
          for (int i = 0; i < 8; ++i) hf[8 + i] = t[i]; }
        float y[16];
#pragma unroll
        for (int i = 0; i < 16; ++i) y[i] = 0.f;
#pragma unroll 1
        for (int kb = 0; kb < 128; kb += 16) {
            const int mye = EI[(size_t)row * 128 + kb + myi]; const float myg = EG[(size_t)row * 128 + kb + myi];
            float p[16];
#pragma unroll
            for (int i = 0; i < 16; ++i) { const int e = __shfl(mye, red16_lane(i)); const bf16* ur = TU + (size_t)e * 1024;
                float a[8], b[8]; unpack8(*(const v4u*)(ur + lane * 8), a); unpack8(*(const v4u*)(ur + 512 + lane * 8), b);
                float s = 0.f;
#pragma unroll
                for (int q = 0; q < 8; ++q) s += a[q] * hf[q] + b[q] * hf[8 + q];
                p[i] = s; }
            const float act = reduce16(p, lane);
            const float wv = myg * gelu_exact(act) * ABLF(l, 3);
#pragma unroll
            for (int i = 0; i < 16; ++i) { const int e = __shfl(mye, red16_lane(i)); const float wi = __shfl(wv, red16_lane(i)); const bf16* vr = TV + (size_t)e * 1024;
                float a[8], b[8]; unpack8(*(const v4u*)(vr + lane * 8), a); unpack8(*(const v4u*)(vr + 512 + lane * 8), b);
#pragma unroll
                for (int q = 0; q < 8; ++q) { y[q] += wi * a[q]; y[8 + q] += wi * b[q]; } }
        }
        const bool lat = row < NLAT;
        float* xr = lat ? F.out + (size_t)row * 1024 : WSP(float, WS_XC) + (size_t)(row - NLAT) * 1024;
        const float* g2 = WSP(float, WS_MOD) + (size_t)(l * 9 + (lat ? (row >> 11) : 8)) * 6144 + 5 * 1024;
        float xo[16], gg[8], xx[8];
        ld8f(xr + lane * 8, xx); ld8f(g2 + lane * 8, gg);
#pragma unroll
        for (int q = 0; q < 8; ++q) xo[q] = xx[q] + gg[q] * y[q];
        ld8f(xr + 512 + lane * 8, xx); ld8f(g2 + 512 + lane * 8, gg);
#pragma unroll
        for (int q = 0; q < 8; ++q) xo[8 + q] = xx[q] + gg[q] * y[8 + q];
        if (l == DEPTH - 1) {
            float ss = 0.f;
#pragma unroll
            for (int q = 0; q < 16; ++q) ss += xo[q] * xo[q];
            const float rstd = 1.0f / sqrtf(wave_sum(ss) * (1.0f / 1024.0f) + EPS);
            ld8f(F.final_g + lane * 8, gg);
#pragma unroll
            for (int q = 0; q < 8; ++q) xo[q] = xo[q] * rstd * gg[q];
            ld8f(F.final_g + 512 + lane * 8, gg);
#pragma unroll
            for (int q = 0; q < 8; ++q) xo[8 + q] = xo[8 + q] * rstd * gg[q];
        }
        *(f32x4*)(xr + lane * 8) = (f32x4){xo[0], xo[1], xo[2], xo[3]}; *(f32x4*)(xr + lane * 8 + 4) = (f32x4){xo[4], xo[5], xo[6], xo[7]};
        *(f32x4*)(xr + 512 + lane * 8) = (f32x4){xo[8], xo[9], xo[10], xo[11]}; *(f32x4*)(xr + 512 + lane * 8 + 4) = (f32x4){xo[12], xo[13], xo[14], xo[15]};
    }
}

#ifndef PG8_SP2
#define PG8_SP2 true
#endif
#ifndef PG8_ALIGN
#define PG8_ALIGN true
#endif
__device__ __forceinline__ void phase_gemm_in(Frame& F0, int l) {
    PHASE_FRAME;
    pg8::Gemm g{(const pg8::bf16_t*)WSP(bf16, WS_H), (const pg8::bf16_t*)(WSP(bf16, WS_WIN) + (size_t)l * ZW * 1024), NROW, ZW, 1024};
    pg8::StaticOrder S; S.init(NROW, ZW, F.G, (int)blockIdx.x);
    pg8::EpiStore16<false> E{(pg8::bf16_t*)WSP(bf16, WS_Z), ZW};
    pg8::gemm_phase<pg8::EpiStore16<false>, pg8::StaticOrder, PG8_ALIGN, PG8_SP2>(F.lds, g, S, E);
}
__device__ __forceinline__ void phase_gemm_merge(Frame& F0, int l) {
    PHASE_FRAME;
    const int nrows = l == 0 ? NROW : NLAT;
    pg8::Gemm g{(const pg8::bf16_t*)WSP(bf16, WS_Y), (const pg8::bf16_t*)(WSP(bf16, WS_WBR) + (size_t)l * 3 * 1024 * 512), 3 * NROW, 3 * 1024, 512};
    pg8::MergeOrder S{(nrows / 256) * 4, F.G, F.vcu, NROW / 256};
    pg8::EpiMerge E{(const pg8::bf16_t*)WSP(bf16, WS_Z), (pg8::bf16_t*)WSP(bf16, WS_H), NROW / 256, ZW, ZGT};
    pg8::gemm_phase<pg8::EpiMerge, pg8::MergeOrder, PG8_ALIGN, PG8_SP2>(F.lds, g, S, E);
}
__device__ __forceinline__ void phase_gemm_out(Frame& F0, int l) {
    PHASE_FRAME;
    const int nrows = l == 0 ? NROW : NLAT;
    pg8::Gemm g{(const pg8::bf16_t*)WSP(bf16, WS_H), (const pg8::bf16_t*)(WSP(bf16, WS_WO) + (size_t)l * 1024 * 1024), nrows, 1024, 1024};
    pg8::StaticOrder S; S.init(nrows, 1024, F.G, (int)blockIdx.x);
    pg8::EpiRes E{l == 0 ? F.x : F.out, F.out, l == 0 ? F.ctx : WSP(float, WS_XC), WSP(float, WS_XC), WSP(float, WS_MOD) + (size_t)l * 9 * 6144, 2 * 1024, NLAT};
    pg8::gemm_phase<pg8::EpiRes, pg8::StaticOrder, PG8_ALIGN, PG8_SP2>(F.lds, g, S, E);
}
__device__ __forceinline__ void phase_gemm_peerq(Frame& F0, int l) {
    PHASE_FRAME;
    const int nrows = l == 0 ? NROW : NLAT;
    pg8::Gemm g{(const pg8::bf16_t*)WSP(bf16, WS_H), (const pg8::bf16_t*)(WSP(bf16, WS_WQK) + (size_t)l * 2048 * 1024), nrows, 2048, 1024};
    pg8::StaticOrder S; S.init(nrows, 2048, F.G, (int)blockIdx.x);
    pg8::EpiStore16<true> E{(pg8::bf16_t*)WSP(bf16, WS_SC), 2048};
    pg8::gemm_phase<pg8::EpiStore16<true>, pg8::StaticOrder, PG8_ALIGN, PG8_SP2>(F.lds, g, S, E);
}

#ifndef MK_ONE_LAUNCH
#define MK_ONE_LAUNCH 1
#endif
#ifndef ENMASK
#define ENMASK 0xFFFFFFFFu
#endif
#define EN(i, stmt) do { if (ENMASK & (1u << (i))) { stmt; } } while (0)
constexpr int PH_PER_LAYER = 11, N_PHASES = 1 + DEPTH * PH_PER_LAYER;
__global__ void __launch_bounds__(NTHR, 2) fwd_kernel(Args args) {
    extern __shared__ __attribute__((aligned(16))) unsigned char lds[];
    Frame F;
    F.lds = (LAS unsigned char*)lds; F.ldsg = lds;
    F.MISC = (volatile LAS unsigned*)(F.lds + LDSCTL_OFF);
    F.tid = threadIdx.x; F.lane = F.tid & 63; F.wave = __builtin_amdgcn_readfirstlane(F.tid >> 6);
    F.G = gridDim.x; { const int bx = blockIdx.x; F.vcu = (F.G % 8 == 0) ? (bx % 8) * (F.G / 8) + bx / 8 : bx; }
    F.ws = args.ws; F.out = args.out; F.ctl = (gu32*)(args.ws + WS_CTL);
    F.x = args.in[0]; F.c = args.in[1]; F.ctx = args.in[2]; F.c_ctx = args.in[3]; F.w_ada = args.in[4]; F.b_ada = args.in[5]; F.norm1_g = args.in[6]; F.norm2_g = args.in[7];
    F.w_in = args.in[8]; F.ml_gate_b = args.in[9]; F.ml_conv_w = args.in[10]; F.ml_norm_g = args.in[11]; F.cv_conv_w = args.in[12]; F.da_lam = args.in[13]; F.da_subln_g = args.in[14];
    F.w_da = args.in[15]; F.w_ml = args.in[16]; F.w_cv = args.in[17]; F.w_o = args.in[18]; F.peer_wq = args.in[19]; F.peer_keys = args.in[20]; F.peer_u = args.in[21]; F.peer_v = args.in[22];
    F.final_g = args.in[23];
    for (int u = F.tid; u < (LDS_BYTES - LDSCTL_OFF) / 4; u += NTHR) ((LAS unsigned*)(F.lds + LDSCTL_OFF))[u] = 0u;
    __syncthreads();
    XcdBarrier bar; bar.bar = (unsigned*)(F.ctl + CW_BAR); bar.x = 0; bar.st = nullptr;
    const int lo = args.ph_lo, hi = args.ph_hi;
    if (hi - lo > 1) bar = xcd_barrier_post((unsigned*)(F.ctl + CW_BAR), F.MISC + 8);
#define IN(k) (lo <= (k) && (k) < hi)
#define SEAM(k) do { if (IN(k) && IN((k) + 1)) xcd_barrier(bar); } while (0)
    if (IN(0)) { EN(0, phase_prologue(F)); } SEAM(0);
#pragma unroll 1
    for (int l = 0; l < DEPTH; ++l) {
        const int pb = 1 + l * PH_PER_LAYER;
        if (IN(pb + 0)) { EN(1, phase_norm(F, l, 0)); } SEAM(pb + 0);
        if (IN(pb + 1)) { EN(2, phase_gemm_in(F, l)); } SEAM(pb + 1);
        if (IN(pb + 2)) { EN(3, phase_rope(F)); EN(4, phase_convbranch(F, l)); EN(5, phase_ml_a(F, l)); } SEAM(pb + 2);
        if (IN(pb + 3)) { EN(6, phase_ml_b(F)); EN(7, phase_attn(F, l)); } SEAM(pb + 3);
        if (IN(pb + 4)) { EN(8, phase_ml_c(F, l)); } SEAM(pb + 4);
        if (IN(pb + 5)) { EN(9, phase_gemm_merge(F, l)); } SEAM(pb + 5);
        if (IN(pb + 6)) { EN(10, phase_gemm_out(F, l)); } SEAM(pb + 6);
        if (IN(pb + 7)) { EN(11, phase_norm(F, l, 1)); } SEAM(pb + 7);
        if (IN(pb + 8)) { EN(12, phase_gemm_peerq(F, l)); } SEAM(pb + 8);
        if (IN(pb + 9)) { EN(13, phase_peer_topk(F, l)); } SEAM(pb + 9);
        if (IN(pb + 10)) { EN(14, phase_peer_gather(F, l)); } SEAM(pb + 10);
    }
#undef IN
#undef SEAM
}

extern "C" void kernel_launch(void* const* d_in, const int* in_sizes, int n_in, void* d_out, int out_size, void* d_ws, size_t ws_size, hipStream_t stream) {
    static int grid = 0;
    if (grid == 0) {
        if (n_in != 24 || in_sizes[0] != NLAT * DM || out_size != NLAT * DM || ws_size < WS_END) {
            fprintf(stderr, "kernel_launch: shape mismatch n_in %d in0 %d out %d ws %zu (need %zu)\n", n_in, n_in > 0 ? in_sizes[0] : -1, out_size, ws_size, (size_t)WS_END); grid = -1; return; }
        int dev = 0, cus = 0;
        if (hipGetDevice(&dev) != hipSuccess || hipDeviceGetAttribute(&cus, hipDeviceAttributeMultiprocessorCount, dev) != hipSuccess) { grid = -1; return; }
        if (hipFuncSetAttribute((const void*)fwd_kernel, hipFuncAttributeMaxDynamicSharedMemorySize, LDS_BYTES) != hipSuccess) { fprintf(stderr, "kernel_launch: hipFuncSetAttribute failed\n"); grid = -1; return; }
        int per_cu = 0;
        if (hipOccupancyMaxActiveBlocksPerMultiprocessor(&per_cu, (const void*)fwd_kernel, NTHR, LDS_BYTES) != hipSuccess || per_cu < 1) { fprintf(stderr, "kernel_launch: occupancy query says %d\n", per_cu); }
        (void)hipGetLastError();
        grid = cus;
    }
    if (grid < 0) return;
    (void)hipMemsetAsync((char*)d_ws + WS_CTL, 0, CTL_ZERO_BYTES, stream);
    Args a{};
    for (int i = 0; i < 24; ++i) a.in[i] = (const float*)d_in[i];
    a.out = (float*)d_out; a.ws = (unsigned char*)d_ws;
#if MK_ONE_LAUNCH
    a.ph_lo = 0; a.ph_hi = N_PHASES;
    hipLaunchKernelGGL(fwd_kernel, dim3(grid), dim3(NTHR), LDS_BYTES, stream, a);
#else
    for (int p = 0; p < N_PHASES; ++p) { a.ph_lo = p; a.ph_hi = p + 1; hipLaunchKernelGGL(fwd_kernel, dim3(grid), dim3(NTHR), LDS_BYTES, stream, a); }
#endif
    const hipError_t le = hipPeekAtLastError();
    if (le != hipSuccess) fprintf(stderr, "kernel_launch: launch failed: %s\n", hipGetErrorName(le));
}
```

```cpp
#include <hip/hip_runtime.h>
#include <cstdio>
#include <cstdint>
#include <cmath>

constexpr int DM = 1024, NBATCH = 8, SEQ = 2048, CTXL = 256, DEPTH = 2;
constexpr int NLAT = NBATCH * SEQ, NCTX = NBATCH * CTXL, NROW = NLAT + NCTX;
constexpr int DIN = 8208;
constexpr int ZW = 8192;
constexpr int ZQ = 0, ZK = 512, ZV = 1024, ZMQ = 1536, ZMK = 2048, ZMV = 2560, ZMO = 3072, ZBG = 3584, ZCG = 4096, ZXV = 4608, ZGT = 5120;
constexpr int ORIG_GATE_COL = 3584;
constexpr int PEER_HEADS = 8, PEER_NK = 128, PEER_K = 16, PEER_NEXP = 16384, PEER_HK = PEER_HEADS * PEER_K;
constexpr float EPS = 1e-6f;
constexpr float PEER_SQ = 28.0f;
constexpr float PEER_USCALE = 64.0f, PEER_VSCALE = 4.0f;
constexpr int PEER_ROWB = 768;
constexpr float QSCALE = 0.125f * 1.4426950408889634f;
constexpr int NCHUNK = 18;
constexpr int STW = 144;

constexpr size_t MiB = 1u << 20;
constexpr size_t WS_CTL = 0, CTL_ZERO_BYTES = 1 * MiB;
constexpr size_t WS_MOD = 1 * MiB;
constexpr size_t WS_MISC = WS_MOD + 512 * 1024;
constexpr size_t WS_WG = WS_MOD + 768 * 1024;
constexpr size_t WS_WIN = 2 * MiB;
constexpr size_t WS_WINC = 18 * MiB;
constexpr size_t WS_WBR = 24 * MiB;
constexpr size_t WS_WO = 30 * MiB;
constexpr size_t WS_WQK = 34 * MiB;
constexpr size_t WS_H = 52 * MiB;
constexpr size_t WS_Y = 88 * MiB;
constexpr size_t WS_XC = 142 * MiB;
constexpr size_t WS_G = 150 * MiB;
constexpr size_t WS_ST = WS_G + 1152 * 1024;
constexpr size_t WS_Z = WS_ST + 41472 * 1024;
constexpr size_t WS_H8 = WS_Z + (size_t)NROW * ZW * 2;
constexpr size_t WS_TU = WS_H8 + 18 * MiB;
constexpr size_t WS_TV = 38 * MiB;
constexpr size_t WS_END = WS_TU + 12 * MiB;
constexpr size_t WS_SC = WS_Z;
constexpr size_t WS_EIDX = WS_ST;
constexpr size_t WS_EGATE = WS_ST + 9 * MiB;
static_assert(WS_EGATE + 9 * MiB <= WS_Z && WS_TV + 12 * MiB <= WS_H && WS_WQK + 4 * MiB <= WS_TV && WS_WINC + 6 * MiB <= WS_WBR && WS_END <= 512 * MiB, "workspace map");
constexpr int MISC_LAM = 0, MISC_COS = 64, MISC_SIN = 64 + 1024, MISC_DEC = 4096;
constexpr int CW_TMO = 0, CW_CODE = 1, CW_BAR = 4096, CW_TILE = 8192;

constexpr int LDS_BYTES = 147456;
constexpr int LDSCTL_OFF = LDS_BYTES - 512;
constexpr int SCR_BYTES = LDSCTL_OFF;
constexpr int NWAVES = 8, NTHR = 512;

#ifndef DEFER_PROLOGUE
#define DEFER_PROLOGUE 0
#endif
#ifndef ABL
#define ABL 0u
#endif
#define ABLF(l, k) ((ABL >> (4 * (l) + (k))) & 1u ? 0.0f : 1.0f)
#define MK_ONE_LAUNCH 1
namespace pg8 {
#define PG8_LAS __attribute__((address_space(3)))
typedef unsigned short bf16_t;
typedef short bf16x8 __attribute__((ext_vector_type(8)));
typedef float f32x4 __attribute__((ext_vector_type(4)));
typedef unsigned u32x4 __attribute__((ext_vector_type(4)));
typedef int i32x4 __attribute__((ext_vector_type(4)));
typedef int i32x8 __attribute__((ext_vector_type(8)));
__device__ __forceinline__ float bperm_(float v, int srclane) { return __int_as_float(__builtin_amdgcn_ds_bpermute(srclane << 2, __float_as_int(v))); }
constexpr int BM = 256, BK = 64, HALF = 128, HTB = HALF * BK * 2  , STAGE_BYTES = 8 * HTB, NXCD = 8, WGM = 8;

__host__ __device__ __forceinline__ int lds_byte(int r, int c) { const int st = (r >> 4) * 2 + (c >> 5), rr = r & 15, cc = c & 31, ob = rr * 64 + cc * 2; return st * 1024 + (ob ^ (((ob >> 9) & 1) << 5)); }
__host__ __device__ __forceinline__ void stage_rc(int b, int& R, int& C) { const int st = b / 1024, sb = b % 1024, swz = sb ^ (((sb >> 9) & 1) << 5); R = (st >> 1) * 16 + swz / 64; C = (st & 1) * 32 + (swz % 64) / 2; }
__host__ __device__ __forceinline__ int perm32(int rho) { const int n = rho >> 4, i = rho & 15; return 8 * (i >> 2) + 4 * n + (i & 3); }

struct Unit { int pm, pn; };
struct Gemm { const bf16_t* A; const bf16_t* Bt; int M, N, K; };

struct StaticOrder {
    int nM, nN, nwg, G, c;
    __host__ __device__ void init(int M, int N, int G_, int c_) { nM = M / BM; nN = N / BM; nwg = nM * nN; G = G_; c = c_; }
    __host__ __device__ bool next(int i, Unit& u) const {
        const long L = (long)i * G + c; if (L >= nwg) return false;
        int wgid = (int)L; { const int q = nwg / NXCD, r = nwg % NXCD, xcd = wgid % NXCD, off = wgid / NXCD; wgid = (xcd < r ? xcd * (q + 1) : r * (q + 1) + (xcd - r) * q) + off; }
        const int nig = WGM * nN, gid = wgid / nig, fm = gid * WGM, gsz = (nM - fm) < WGM ? (nM - fm) : WGM;
        u.pm = fm + ((wgid % nig) % gsz); u.pn = (wgid % nig) / gsz; return true;
    }
    __device__ __forceinline__ void a_ready(const Unit&) const {}
    __device__ __forceinline__ void done(const Unit&) const {}
};
struct SubOrder {
    StaticOrder S; int cut, skip, base;
    __host__ __device__ bool next(int i, Unit& u) const { if (!S.next(i, u)) return false; u.pn = (u.pn < cut ? u.pn : u.pn + skip) + base; return true; }
    __device__ __forceinline__ void a_ready(const Unit&) const {}
    __device__ __forceinline__ void done(const Unit&) const {}
};
__device__ __forceinline__ unsigned cvt_pk_bf16(float lo, float hi) { unsigned r; asm volatile("v_cvt_pk_bf16_f32 %0, %1, %2" : "=v"(r) : "v"(lo), "v"(hi)); return r; }
typedef unsigned u32x2 __attribute__((ext_vector_type(2)));
typedef _Float16 f16x2 __attribute__((ext_vector_type(2)));
__device__ __forceinline__ unsigned cvt_pk_f16(float lo, float hi) { f16x2 v = {(_Float16)lo, (_Float16)hi}; return __builtin_bit_cast(unsigned, v); }
__device__ __forceinline__ float bflo(unsigned w) { return __builtin_bit_cast(float, w << 16); }
__device__ __forceinline__ float bfhi(unsigned w) { return __builtin_bit_cast(float, w & 0xffff0000u); }
__device__ __forceinline__ float sigmoidf_(float x) { return __builtin_amdgcn_rcpf(1.0f + __builtin_amdgcn_exp2f(-1.4426950408889634f * x)); }

template <bool F16> struct EpiStore16 {
    static constexpr bool PERM = true, AFTER_DRAIN = false;
    bf16_t* O; int ldc;
    __device__ __forceinline__ void operator()(const f32x4 (&acc)[2][2][4][2], const Unit& u, int wr, int wc, int fr, int fq) const {
        const int row0 = u.pm * BM + wr * 64 + fr, col0 = u.pn * BM + wc * 32 + 8 * fq;
#pragma unroll
        for (int ai = 0; ai < 2; ++ai)
#pragma unroll
            for (int m = 0; m < 4; ++m) { bf16_t* rowp = O + (size_t)(row0 + ai * HALF + m * 16) * ldc + col0;
#pragma unroll
                for (int bj = 0; bj < 2; ++bj) { const f32x4 v0 = acc[ai][bj][m][0], v1 = acc[ai][bj][m][1]; u32x4 w;
                    if (F16) { w.x = cvt_pk_f16(v0[0], v0[1]); w.y = cvt_pk_f16(v0[2], v0[3]); w.z = cvt_pk_f16(v1[0], v1[1]); w.w = cvt_pk_f16(v1[2], v1[3]); }
                    else { w.x = cvt_pk_bf16(v0[0], v0[1]); w.y = cvt_pk_bf16(v0[2], v0[3]); w.z = cvt_pk_bf16(v1[0], v1[1]); w.w = cvt_pk_bf16(v1[2], v1[3]); }
                    *(u32x4*)(rowp + bj * HALF) = w; } }
    }
};

struct EpiStore8 {
    static constexpr bool PERM = true, AFTER_DRAIN = false;
    unsigned char* O; int ldc; float scale;
    __device__ __forceinline__ unsigned q8(float v) const { return (unsigned)__builtin_amdgcn_fmed3f(__builtin_fmaf(v, scale, 128.5f), 1.0f, 255.0f); }
    __device__ __forceinline__ void operator()(const f32x4 (&acc)[2][2][4][2], const Unit& u, int wr, int wc, int fr, int fq) const {
        typedef unsigned u32x2g __attribute__((ext_vector_type(2)));
        const int row0 = u.pm * BM + wr * 64 + fr, col0 = u.pn * BM + wc * 32 + 8 * fq;
#pragma unroll
        for (int ai = 0; ai < 2; ++ai)
#pragma unroll
            for (int m = 0; m < 4; ++m) { unsigned char* rowp = O + (size_t)(row0 + ai * HALF + m * 16) * ldc + col0;
#pragma unroll
                for (int bj = 0; bj < 2; ++bj) { const f32x4 v0 = acc[ai][bj][m][0], v1 = acc[ai][bj][m][1]; u32x2g w;
                    w.x = q8(v0[0]) | (q8(v0[1]) << 8) | (q8(v0[2]) << 16) | (q8(v0[3]) << 24); w.y = q8(v1[0]) | (q8(v1[1]) << 8) | (q8(v1[2]) << 16) | (q8(v1[3]) << 24);
                    *(u32x2g*)(rowp + bj * HALF) = w; } }
    }
};
struct EpiNull {
    static constexpr bool PERM = true, AFTER_DRAIN = false;
    bf16_t* O;
    __device__ __forceinline__ void operator()(const f32x4 (&acc)[2][2][4][2], const Unit& u, int wr, int wc, int fr, int fq) const {
        f32x4 s = {0.f, 0.f, 0.f, 0.f};
#pragma unroll
        for (int ai = 0; ai < 2; ++ai)
#pragma unroll
            for (int bj = 0; bj < 2; ++bj)
#pragma unroll
                for (int m = 0; m < 4; ++m) { s += acc[ai][bj][m][0]; s += acc[ai][bj][m][1]; }
        if ((s.x + s.y) + (s.z + s.w) == 1234.567f) O[u.pm + fr] = 1;
    }
};
struct EpiZ {
    static constexpr bool PERM = true, AFTER_DRAIN = false;
    bf16_t* O; int ldc; const float* cosT; const float* sinT; int nlat; float qscale;
    int z8_pn1;
    int gate_pn0;
    __device__ __forceinline__ void operator()(const f32x4 (&acc)[2][2][4][2], const Unit& u, int wr, int wc, int fr, int fq) const {
        const int row0 = u.pm * BM + wr * 64 + fr, col0 = u.pn * BM + wc * 32 + 8 * fq;
        const bool fragmaj = u.pn >= gate_pn0; int t16_ = ((wr * 4 + wc) * 64 + fq * 16 + fr) * 16; asm volatile("" : "+v"(t16_)); const int t16 = t16_;
        const bool qk = u.pn < 4, rope = qk && (u.pm * BM < nlat);
        const float sc = u.pn < 2 ? qscale : 1.0f;
        const int isc = wc & 1, i0 = 8 * (fq & 1);
        const float sgn = fq < 2 ? -1.0f : 1.0f;
#pragma unroll
        for (int ai = 0; ai < 2; ++ai)
#pragma unroll
            for (int m = 0; m < 4; ++m) { const int row = row0 + ai * HALF + m * 16; bf16_t* rowp = O + (size_t)row * ldc + col0;
                f32x4 c0 = {1.f, 1.f, 1.f, 1.f}, c1 = c0, s0 = {0.f, 0.f, 0.f, 0.f}, s1 = s0;
                if (rope) { const int t = row & 2047, pos = isc ? (t & 63) : (t >> 6);
                    c0 = *(const f32x4*)(cosT + pos * 16 + i0); c1 = *(const f32x4*)(cosT + pos * 16 + i0 + 4);
                    s0 = *(const f32x4*)(sinT + pos * 16 + i0) * sgn; s1 = *(const f32x4*)(sinT + pos * 16 + i0 + 4) * sgn; }
#pragma unroll
                for (int bj = 0; bj < 2; ++bj) { f32x4 v0 = acc[ai][bj][m][0], v1 = acc[ai][bj][m][1];
                    if (qk) {
                        if (rope) { f32x4 p0, p1;
                            const int pl = (fq * 16 + fr) ^ 32;
                            p0.x = bperm_(v0.x, pl); p0.y = bperm_(v0.y, pl); p0.z = bperm_(v0.z, pl); p0.w = bperm_(v0.w, pl);
                            p1.x = bperm_(v1.x, pl); p1.y = bperm_(v1.y, pl); p1.z = bperm_(v1.z, pl); p1.w = bperm_(v1.w, pl);
                            v0 = v0 * c0 + p0 * s0; v1 = v1 * c1 + p1 * s1; }
                        v0 = v0 * sc; v1 = v1 * sc; }
                    if (u.pn < z8_pn1) {
                        typedef unsigned u32x2g __attribute__((ext_vector_type(2)));
                        int g0 = __builtin_amdgcn_cvt_pk_fp8_f32(v0[0], v0[1], 0, false); g0 = __builtin_amdgcn_cvt_pk_fp8_f32(v0[2], v0[3], g0, true);
                        int g1 = __builtin_amdgcn_cvt_pk_fp8_f32(v1[0], v1[1], 0, false); g1 = __builtin_amdgcn_cvt_pk_fp8_f32(v1[2], v1[3], g1, true);
                        *(u32x2g*)((char*)(O + (size_t)row * ldc + u.pn * BM) + (wc * 32 + 8 * fq + bj * HALF)) = (u32x2g){(unsigned)g0, (unsigned)g1};
                        continue; }
                    u32x4 w; w.x = cvt_pk_bf16(v0[0], v0[1]); w.y = cvt_pk_bf16(v0[2], v0[3]); w.z = cvt_pk_bf16(v1[0], v1[1]); w.w = cvt_pk_bf16(v1[2], v1[3]);
                    if (fragmaj) {
                        typedef unsigned u32x2g __attribute__((ext_vector_type(2)));
                        const int L = ((ai * 4 + m) * 2 + bj) * 4096 + (t16 >> 1);
                        int g0 = __builtin_amdgcn_cvt_pk_fp8_f32(v0[0], v0[1], 0, false); g0 = __builtin_amdgcn_cvt_pk_fp8_f32(v0[2], v0[3], g0, true);
                        int g1 = __builtin_amdgcn_cvt_pk_fp8_f32(v1[0], v1[1], 0, false); g1 = __builtin_amdgcn_cvt_pk_fp8_f32(v1[2], v1[3], g1, true);
                        *(u32x2g*)((char*)(O + (size_t)(u.pm * BM + (L >> 9)) * ldc + u.pn * BM) + (L & 511)) = (u32x2g){(unsigned)g0, (unsigned)g1}; }
                    else *(u32x4*)(rowp + bj * HALF) = w; } }
    }
};

struct EpiMerge {
    static constexpr bool PERM = true, AFTER_DRAIN = false;
    const bf16_t* Z; bf16_t* MB; int nMs, zw, zgt;
    bf16_t* scr;
    unsigned* flags; int xrow0;
    template <int DST, bool HASIN> __device__ __forceinline__ void walk(const f32x4 (&acc)[2][2][4][2], int br, int pn, int pmt, int wr, int wc, int fr, int fq) const {
        typedef __attribute__((address_space(1))) char gch; typedef __attribute__((address_space(1))) u32x4 gv4; typedef __attribute__((address_space(1))) unsigned long long gq;
        const int row0 = pmt * BM + wr * 64 + fr, col0 = pn * BM + wc * 32 + 8 * fq;
        int t16_ = ((wr * 4 + wc) * 64 + fq * 16 + fr) * 16; asm volatile("" : "+v"(t16_)); const int t16 = t16_;
        const gch* Zt = (const gch*)(Z + (size_t)(pmt * BM) * zw + zgt + br * 1024 + pn * BM);
        const unsigned gofs = (unsigned)(((t16 >> 1) >> 9) * (zw * 2) + ((t16 >> 1) & 511));
        gch* sp = (gch*)scr + (size_t)(pmt * 4 + pn) * 131072;
#pragma unroll
        for (int ai = 0; ai < 2; ++ai) {
            typedef unsigned u32x2g __attribute__((ext_vector_type(2))); typedef __attribute__((address_space(1))) u32x2g gv2;
            u32x2g gw[4][2]; u32x4 ow[4][2];
#pragma unroll
            for (int m = 0; m < 4; ++m)
#pragma unroll
                for (int bj = 0; bj < 2; ++bj) { const size_t row = (size_t)(row0 + ai * HALF + m * 16); const int col = col0 + bj * HALF; const int q = (ai * 4 + m) * 2 + bj;
                    gw[m][bj] = *(const gv2*)(Zt + (gofs + (unsigned)(q * 8 * (zw * 2))));
                    if (!HASIN) ow[m][bj] = (u32x4){0u, 0u, 0u, 0u};
                    else if (DST == 2) { const gq* qp = (const gq*)(MB + row * 1024 + col);
                        const unsigned long long q0 = __hip_atomic_load(qp, __ATOMIC_RELAXED, __HIP_MEMORY_SCOPE_AGENT), q1 = __hip_atomic_load(qp + 1, __ATOMIC_RELAXED, __HIP_MEMORY_SCOPE_AGENT);
                        ow[m][bj] = (u32x4){(unsigned)q0, (unsigned)(q0 >> 32), (unsigned)q1, (unsigned)(q1 >> 32)}; }
                    else ow[m][bj] = *(const gv4*)(sp + (unsigned)(t16 + q * 8192)); }
#pragma unroll
            for (int m = 0; m < 4; ++m)
#pragma unroll
                for (int bj = 0; bj < 2; ++bj) { const size_t row = (size_t)(row0 + ai * HALF + m * 16); const int col = col0 + bj * HALF; const int q = (ai * 4 + m) * 2 + bj;
                    const u32x2g g = gw[m][bj]; const u32x4 o = ow[m][bj]; const f32x4 v0 = acc[ai][bj][m][0], v1 = acc[ai][bj][m][1];
                    typedef float f32x2g __attribute__((ext_vector_type(2)));
                    const f32x2g ga = __builtin_amdgcn_cvt_pk_f32_fp8((int)g.x, false), gb = __builtin_amdgcn_cvt_pk_f32_fp8((int)g.x, true), gc = __builtin_amdgcn_cvt_pk_f32_fp8((int)g.y, false), gd = __builtin_amdgcn_cvt_pk_f32_fp8((int)g.y, true);
                    float r[8];
                    r[0] = v0[0] * sigmoidf_(ga.x) + bflo(o.x); r[1] = v0[1] * sigmoidf_(ga.y) + bfhi(o.x); r[2] = v0[2] * sigmoidf_(gb.x) + bflo(o.y); r[3] = v0[3] * sigmoidf_(gb.y) + bfhi(o.y);
                    r[4] = v1[0] * sigmoidf_(gc.x) + bflo(o.z); r[5] = v1[1] * sigmoidf_(gc.y) + bfhi(o.z); r[6] = v1[2] * sigmoidf_(gd.x) + bflo(o.w); r[7] = v1[3] * sigmoidf_(gd.y) + bfhi(o.w);
                    u32x4 w; w.x = cvt_pk_bf16(r[0], r[1]); w.y = cvt_pk_bf16(r[2], r[3]); w.z = cvt_pk_bf16(r[4], r[5]); w.w = cvt_pk_bf16(r[6], r[7]);
                    if (DST == 2) { gq* qp = (gq*)(MB + row * 1024 + col);
                        __hip_atomic_store(qp, ((unsigned long long)w.y << 32) | w.x, __ATOMIC_RELAXED, __HIP_MEMORY_SCOPE_AGENT); __hip_atomic_store(qp + 1, ((unsigned long long)w.w << 32) | w.z, __ATOMIC_RELAXED, __HIP_MEMORY_SCOPE_AGENT); }
                    else if (DST == 0) *(gv4*)(sp + (unsigned)(t16 + q * 8192)) = w;
                    else *(u32x4*)(MB + row * 1024 + col) = w; }
        }
    }
    __device__ __forceinline__ void operator()(const f32x4 (&acc)[2][2][4][2], const Unit& u, int wr, int wc, int fr, int fq) const {
        const int br = u.pn >> 2, pn = u.pn & 3, pmt = u.pm - br * nMs;
        const bool xt = xrow0 >= 0 && pmt >= xrow0;
        unsigned* fl = flags + 64 * ((pmt - xrow0) * 4 + pn);
        if (xt && br > 0) {
            const unsigned need = 8u * (unsigned)br; unsigned sp = 0;
            while (__hip_atomic_load(fl, __ATOMIC_RELAXED, __HIP_MEMORY_SCOPE_AGENT) < need && ++sp < (1u << 22)) __builtin_amdgcn_s_sleep(2);
        }
        if (xt) { if (br > 0) walk<2, true>(acc, br, pn, pmt, wr, wc, fr, fq); else walk<2, false>(acc, br, pn, pmt, wr, wc, fr, fq); }
        else if (br == 2) walk<1, true>(acc, br, pn, pmt, wr, wc, fr, fq);
        else if (br == 1) walk<0, true>(acc, br, pn, pmt, wr, wc, fr, fq);
        else walk<0, false>(acc, br, pn, pmt, wr, wc, fr, fq);
        if (xt && br < 2) { asm volatile("s_waitcnt vmcnt(0)" ::: "memory"); if (fr == 0 && fq == 0) __hip_atomic_fetch_add(fl, 1u, __ATOMIC_RELAXED, __HIP_MEMORY_SCOPE_AGENT); }
    }
};
struct MergeOrder {
    int ntile, G, c, nMs, nbr, br0;
    int xc0, xn, xt0;
    __device__ __forceinline__ bool next(int i, Unit& u) const {
        int t = (i / nbr) * G + c, br = br0 + i % nbr;
        if (t >= ntile) { const int nown = c < ntile ? (ntile - 1 - c) / G + 1 : 0, k = c - xc0; if (i != nown * nbr || k < 0 || k >= xn) return false; t = xt0 + k / nbr; br = br0 + k % nbr; }
        u.pm = br * nMs + (t >> 2); u.pn = br * 4 + (t & 3); return true; }
    __device__ __forceinline__ void a_ready(const Unit&) const {}
    __device__ __forceinline__ void done(const Unit&) const {}
};

struct EpiRes {
    static constexpr bool PERM = false, AFTER_DRAIN = false;
    const float* base_lat; float* dst_lat; const float* base_ctx; float* dst_ctx; const float* mod; int goff, nlat; bool base_lat_f32;
    __device__ __forceinline__ void operator()(const f32x4 (&acc)[2][2][4][2], const Unit& u, int wr, int wc, int fr, int fq) const {
        const int rowt = u.pm * BM; const bool lat = rowt < nlat;
        const float* g = mod + (lat ? (rowt >> 11) : 8) * 6144 + goff;
        const int col0 = u.pn * BM + wc * 32 + 4 * fq;
        f32x4 gv[2][2];
#pragma unroll
        for (int bj = 0; bj < 2; ++bj)
#pragma unroll
            for (int n = 0; n < 2; ++n) gv[bj][n] = *(const f32x4*)(g + col0 + bj * HALF + n * 16);
        if (lat) {
            typedef __attribute__((address_space(1))) char gch; typedef __attribute__((address_space(1))) u32x2 gv2; typedef __attribute__((address_space(1))) f32x4 gf4;
            const gch* bb = (const gch*)base_lat + (size_t)rowt * 4096; gch* db = (gch*)dst_lat + (size_t)rowt * 4096; const gch* bf = (const gch*)(base_lat + (size_t)rowt * 1024);
            int fr_ = fr; asm volatile("" : "+v"(fr_));
            const unsigned lo = (unsigned)((wr * 64 + fr_) * 4096 + col0 * 2), lo4 = (unsigned)((wr * 64 + fr_) * 4096 + col0 * 4);
#pragma unroll
            for (int ai = 0; ai < 2; ++ai) {
                f32x4 bs[4][2][2];
#pragma unroll
                for (int m = 0; m < 4; ++m)
#pragma unroll
                    for (int bj = 0; bj < 2; ++bj)
#pragma unroll
                        for (int n = 0; n < 2; ++n) { const unsigned o_ = lo + (unsigned)((ai * HALF + m * 16) * 4096 + (bj * HALF + n * 16) * 2);
                            if (base_lat_f32) bs[m][bj][n] = *(const gf4*)(bf + (lo4 + (unsigned)((ai * HALF + m * 16) * 4096 + (bj * HALF + n * 16) * 4)));
                            else { const u32x2 w = *(const gv2*)(bb + o_);
                                bs[m][bj][n] = (f32x4){__uint_as_float(w.x << 16), __uint_as_float(w.x & 0xffff0000u), __uint_as_float(w.y << 16), __uint_as_float(w.y & 0xffff0000u)}; } }
#pragma unroll
                for (int m = 0; m < 4; ++m)
#pragma unroll
                    for (int bj = 0; bj < 2; ++bj)
#pragma unroll
                        for (int n = 0; n < 2; ++n) { const unsigned o_ = lo + (unsigned)((ai * HALF + m * 16) * 4096 + (bj * HALF + n * 16) * 2); const f32x4 r = bs[m][bj][n] + gv[bj][n] * acc[ai][bj][m][n];
                            u32x2 w; w.x = cvt_pk_bf16(r[0], r[1]); w.y = cvt_pk_bf16(r[2], r[3]);
                            *(gv2*)(db + o_) = w; }
            }
            return;
        }
        {
            typedef __attribute__((address_space(1))) char gch; typedef __attribute__((address_space(1))) f32x4 gf4;
            const gch* bc = (const gch*)(base_ctx + (size_t)(rowt - nlat) * 1024); gch* dc = (gch*)(dst_ctx + (size_t)(rowt - nlat) * 1024);
            int fr_ = fr; asm volatile("" : "+v"(fr_));
            const unsigned lo4 = (unsigned)((wr * 64 + fr_) * 4096 + col0 * 4);
#pragma unroll
            for (int ai = 0; ai < 2; ++ai) {
                f32x4 bs[4][2][2];
#pragma unroll
                for (int m = 0; m < 4; ++m)
#pragma unroll
                    for (int bj = 0; bj < 2; ++bj)
#pragma unroll
                        for (int n = 0; n < 2; ++n) bs[m][bj][n] = *(const gf4*)(bc + (lo4 + (unsigned)((ai * HALF + m * 16) * 4096 + (bj * HALF + n * 16) * 4)));
#pragma unroll
                for (int m = 0; m < 4; ++m)
#pragma unroll
                    for (int bj = 0; bj < 2; ++bj)
#pragma unroll
                        for (int n = 0; n < 2; ++n) *(gf4*)(dc + (lo4 + (unsigned)((ai * HALF + m * 16) * 4096 + (bj * HALF + n * 16) * 4))) = bs[m][bj][n] + gv[bj][n] * acc[ai][bj][m][n];
            }
        }
    }
};
template <class Epi, class Sched, bool ALIGN_EPI = false, bool SP2 = false, bool FP8 = false>
__device__ __forceinline__ void gemm_phase(PG8_LAS unsigned char* lds, const Gemm g, const Sched& S, const Epi& E, int wave_id) {
    int tid_ = (int)__builtin_amdgcn_mbcnt_hi(~0u, __builtin_amdgcn_mbcnt_lo(~0u, 0u)); asm volatile("" : "+v"(tid_)); tid_ += 64 * wave_id;
    const int tid = tid_, wid = __builtin_amdgcn_readfirstlane(tid >> 6), lane = tid & 63, wr = wid >> 2, wc = wid & 3, fr = lane & 15, fq = lane >> 4;
    const int K = g.K; int nt_ = K / BK; if constexpr (FP8) asm volatile("" : "+s"(nt_)); const int nt = nt_;
    unsigned voffA[2], voffB[2];
#pragma unroll
    for (int i = 0; i < 2; ++i) { int R, C; stage_rc(tid * 16 + i * 8192, R, C); const int Rb = Epi::PERM ? ((R & ~31) + perm32(R & 31)) : R;
        voffA[i] = (unsigned)(R * K + C) * 2u; voffB[i] = (unsigned)(Rb * K + C) * 2u; }
    const size_t kstep = (size_t)(BK * 2);
    const size_t hstep = (size_t)HALF * K * 2;
    const size_t tstep = 2 * hstep;
    const unsigned ldsw = (unsigned)wid * 1024u;
    const int aoff = lds_byte(wr * 64 + fr, fq * 8), boff = lds_byte(wc * 32 + fr, fq * 8);
#define PG8_SA(b, h) (((b) * 2 + (h)) * HTB)
#define PG8_SB(b, h) ((4 + (b) * 2 + (h)) * HTB)
#define PG8_STAGE(bufoff, gbase, voff) do { _Pragma("unroll") for (int _i = 0; _i < 2; ++_i) \
        __builtin_amdgcn_global_load_lds((const unsigned*)((const char*)(gbase) + (voff)[_i]), (PG8_LAS unsigned*)(lds + (bufoff) + ldsw + _i * 8192), 16, 0, 0); } while (0)
#define PG8_LDA(dst, b, h) do { _Pragma("unroll") for (int m = 0; m < 4; ++m) _Pragma("unroll") for (int k = 0; k < 2; ++k) dst[m][k] = *(const PG8_LAS bf16x8*)(lds + PG8_SA(b, h) + aoff + m * 2048 + k * 1024); } while (0)
#define PG8_LDB(dst, b, h) do { _Pragma("unroll") for (int n = 0; n < 2; ++n) _Pragma("unroll") for (int k = 0; k < 2; ++k) dst[n][k] = *(const PG8_LAS bf16x8*)(lds + PG8_SB(b, h) + boff + n * 2048 + k * 1024); } while (0)
#define PG8_MMA(ai, bj, At, Bt) do { __builtin_amdgcn_s_setprio(1); _Pragma("unroll") for (int m = 0; m < 4; ++m) _Pragma("unroll") for (int n = 0; n < 2; ++n) { \
        if constexpr (FP8) { const i32x8 wv = __builtin_shufflevector(__builtin_bit_cast(i32x4, Bt[n][0]), __builtin_bit_cast(i32x4, Bt[n][1]), 0, 1, 2, 3, 4, 5, 6, 7); \
            const i32x8 av = __builtin_shufflevector(__builtin_bit_cast(i32x4, At[m][0]), __builtin_bit_cast(i32x4, At[m][1]), 0, 1, 2, 3, 4, 5, 6, 7); \
            asm volatile("v_mfma_scale_f32_16x16x128_f8f6f4 %0, %1, %2, %0, %3, %4 op_sel_hi:[0,0,0]" : "+v"(acc[ai][bj][m][n]) : "v"(wv), "v"(av), "v"(0x79797979), "v"(0x7f7f7f7f)); } \
        else { _Pragma("unroll") for (int k = 0; k < 2; ++k) acc[ai][bj][m][n] = __builtin_amdgcn_mfma_f32_16x16x32_bf16(Bt[n][k], At[m][k], acc[ai][bj][m][n], 0, 0, 0); } } \
        __builtin_amdgcn_s_setprio(0); } while (0)
#define PG8_WAIT_V(n) asm volatile("s_waitcnt vmcnt(" #n ")" ::: "memory")
#define PG8_WAIT_L(n) asm volatile("s_waitcnt lgkmcnt(" #n ")" ::: "memory")
#define PG8_BAR __builtin_amdgcn_s_barrier()
#define PG8_SCHED __builtin_amdgcn_sched_barrier(0)
    Unit cur, nxt; int ui = 0;
    if (!S.next(0, cur)) return;
    f32x4 acc[2][2][4][2];
#pragma unroll
    for (int a = 0; a < 2; ++a)
#pragma unroll
        for (int b = 0; b < 2; ++b)
#pragma unroll
            for (int m = 0; m < 4; ++m)
#pragma unroll
                for (int n = 0; n < 2; ++n) acc[a][b][m][n] = (f32x4){0.f, 0.f, 0.f, 0.f};
    bf16x8 At[4][2], B0[2][2], B1[2][2];
    const char* cA = (const char*)g.A + (size_t)cur.pm * tstep; const char* cB = (const char*)g.Bt + (size_t)cur.pn * tstep;
    S.a_ready(cur);
    if constexpr (SP2) {
        PG8_STAGE(PG8_SB(0, 0), cB, voffB); PG8_STAGE(PG8_SB(0, 1), cB + hstep, voffB); PG8_STAGE(PG8_SA(0, 0), cA, voffA); PG8_STAGE(PG8_SA(0, 1), cA + hstep, voffA);
        if (wr == 1) PG8_BAR;
        PG8_WAIT_V(2); PG8_BAR;
        PG8_STAGE(PG8_SB(1, 0), cB + kstep, voffB); PG8_STAGE(PG8_SA(1, 0), cA + kstep, voffA); PG8_STAGE(PG8_SB(1, 1), cB + hstep + kstep, voffB);
        PG8_WAIT_V(6); PG8_BAR;
    } else {
        PG8_STAGE(PG8_SB(0, 0), cB, voffB); PG8_STAGE(PG8_SA(0, 0), cA, voffA); PG8_STAGE(PG8_SB(0, 1), cB + hstep, voffB); PG8_STAGE(PG8_SA(0, 1), cA + hstep, voffA);
        if (wr == 1) PG8_BAR;
        PG8_WAIT_V(4); PG8_BAR;
        PG8_STAGE(PG8_SB(1, 0), cB + kstep, voffB); PG8_STAGE(PG8_SA(1, 0), cA + kstep, voffA); PG8_STAGE(PG8_SB(1, 1), cB + hstep + kstep, voffB);
        PG8_WAIT_V(6); PG8_BAR;
    }
    for (;;) {
        const bool has_next = S.next(ui + 1, nxt);
        const char* nA = has_next ? (const char*)g.A + (size_t)nxt.pm * tstep : cA; const char* nB = has_next ? (const char*)g.Bt + (size_t)nxt.pn * tstep : cB;
#pragma unroll 1
        for (int t = 0; t < nt; t += 2) {
            const bool last = (t == nt - 2);
            const char* a1 = cA + (size_t)(t + 1) * kstep;
            const char* a2 = last ? nA : cA + (size_t)(t + 2) * kstep; const char* b2 = last ? nB : cB + (size_t)(t + 2) * kstep;
            const char* a3 = a2 + kstep; const char* b3 = b2 + kstep;
            if (last && has_next) S.a_ready(nxt);
            if constexpr (SP2) {
            PG8_LDB(B0, 0, 0); PG8_LDB(B1, 0, 1); PG8_SCHED; PG8_LDA(At, 0, 0); PG8_STAGE(PG8_SA(1, 1), a1 + hstep, voffA);
            PG8_WAIT_V(8); PG8_WAIT_L(0); PG8_BAR; PG8_MMA(0, 0, At, B0); PG8_MMA(0, 1, At, B1); PG8_BAR; PG8_SCHED;
            PG8_LDA(At, 0, 1); PG8_STAGE(PG8_SB(0, 0), b2, voffB); PG8_STAGE(PG8_SB(0, 1), b2 + hstep, voffB); PG8_STAGE(PG8_SA(0, 0), a2, voffA);
            PG8_WAIT_V(8); PG8_WAIT_L(0); PG8_BAR; PG8_MMA(1, 0, At, B0); PG8_MMA(1, 1, At, B1); PG8_BAR; PG8_SCHED;
            PG8_LDB(B0, 1, 0); PG8_LDB(B1, 1, 1); PG8_SCHED; PG8_LDA(At, 1, 0); PG8_STAGE(PG8_SA(0, 1), a2 + hstep, voffA);
            PG8_WAIT_V(8); PG8_WAIT_L(0); PG8_BAR; PG8_MMA(0, 0, At, B0); PG8_MMA(0, 1, At, B1); PG8_BAR; PG8_SCHED;
            PG8_LDA(At, 1, 1); PG8_STAGE(PG8_SB(1, 0), b3, voffB); PG8_STAGE(PG8_SB(1, 1), b3 + hstep, voffB); PG8_STAGE(PG8_SA(1, 0), a3, voffA);
            PG8_WAIT_V(8); PG8_WAIT_L(0); PG8_BAR; PG8_MMA(1, 0, At, B0); PG8_MMA(1, 1, At, B1); PG8_BAR; PG8_SCHED;
            } else {
            PG8_LDB(B0, 0, 0); PG8_SCHED; PG8_LDA(At, 0, 0); PG8_STAGE(PG8_SA(1, 1), a1 + hstep, voffA);
            PG8_WAIT_L(8); PG8_BAR; PG8_WAIT_L(0); PG8_MMA(0, 0, At, B0); PG8_BAR; PG8_SCHED;
            PG8_LDB(B1, 0, 1); PG8_STAGE(PG8_SB(0, 0), b2, voffB);
            PG8_BAR; PG8_WAIT_L(0); PG8_MMA(0, 1, At, B1); PG8_BAR;
            PG8_LDA(At, 0, 1); PG8_STAGE(PG8_SA(0, 0), a2, voffA);
            PG8_BAR; PG8_WAIT_L(0); PG8_MMA(1, 0, At, B0); PG8_BAR; PG8_SCHED;
            PG8_STAGE(PG8_SB(0, 1), b2 + hstep, voffB);
            PG8_WAIT_V(6); PG8_BAR; PG8_MMA(1, 1, At, B1); PG8_BAR;
            PG8_LDB(B0, 1, 0); PG8_SCHED; PG8_LDA(At, 1, 0); PG8_STAGE(PG8_SA(0, 1), a2 + hstep, voffA);
            PG8_WAIT_L(8); PG8_BAR; PG8_WAIT_L(0); PG8_MMA(0, 0, At, B0); PG8_BAR; PG8_SCHED;
            PG8_LDB(B1, 1, 1); PG8_STAGE(PG8_SB(1, 0), b3, voffB);
            PG8_BAR; PG8_WAIT_L(0); PG8_MMA(0, 1, At, B1); PG8_BAR;
            PG8_LDA(At, 1, 1); PG8_STAGE(PG8_SA(1, 0), a3, voffA);
            PG8_BAR; PG8_WAIT_L(0); PG8_MMA(1, 0, At, B0); PG8_BAR; PG8_SCHED;
            PG8_STAGE(PG8_SB(1, 1), b3 + hstep, voffB);
            PG8_WAIT_V(6); PG8_BAR; PG8_MMA(1, 1, At, B1); PG8_BAR;
            }
        }
        if constexpr (FP8) asm volatile("s_nop 15\n\ts_nop 7" ::: "memory");
        if constexpr (ALIGN_EPI) { if (wr == 0) PG8_BAR; }
        if constexpr (!Epi::AFTER_DRAIN) { E(acc, cur, wr, wc, fr, fq); S.done(cur); }
        if (!has_next) break;
#pragma unroll
        for (int a = 0; a < 2; ++a)
#pragma unroll
            for (int b = 0; b < 2; ++b)
#pragma unroll
                for (int m = 0; m < 4; ++m)
#pragma unroll
                    for (int n = 0; n < 2; ++n) acc[a][b][m][n] = (f32x4){0.f, 0.f, 0.f, 0.f};
        cur = nxt; cA = nA; cB = nB; ++ui;
        if constexpr (ALIGN_EPI) { if (wr == 1) PG8_BAR; }
    }
    PG8_WAIT_V(0);
    if constexpr (!ALIGN_EPI) { if (wr == 0) PG8_BAR; }
    PG8_BAR;
    if constexpr (Epi::AFTER_DRAIN) { E.fused(acc, cur, wr, wc, fr, fq, lds, wid, lane); S.done(cur); }
#undef PG8_SA
#undef PG8_SB
#undef PG8_STAGE
#undef PG8_LDA
#undef PG8_LDB
#undef PG8_MMA
#undef PG8_WAIT_V
#undef PG8_WAIT_L
#undef PG8_BAR
#undef PG8_SCHED
}
}
#define GAS __attribute__((address_space(1)))
#define LAS __attribute__((address_space(3)))
typedef unsigned short bf16;
typedef unsigned v4u __attribute__((ext_vector_type(4)));
typedef float f32x4 __attribute__((ext_vector_type(4)));
typedef short bf16x8 __attribute__((ext_vector_type(8)));
typedef GAS unsigned gu32;
typedef GAS unsigned long long gu64;
#define RLX_AGENT __ATOMIC_RELAXED, __HIP_MEMORY_SCOPE_AGENT
#define LDS_WAIT() asm volatile("s_waitcnt lgkmcnt(0)" ::: "memory")
#define VM_WAIT() asm volatile("s_waitcnt vmcnt(0)" ::: "memory")
__device__ __forceinline__ unsigned long long rt() { return __builtin_amdgcn_s_memrealtime(); }
__device__ __forceinline__ unsigned f2bf(float f) { unsigned u = __builtin_bit_cast(unsigned, f); return (u + 0x7fffu + ((u >> 16) & 1u)) >> 16; }
__device__ __forceinline__ unsigned pk2(float lo, float hi) { return f2bf(lo) | (f2bf(hi) << 16); }
template <int PAT> __device__ __forceinline__ float swz(float v) { return __int_as_float(__builtin_amdgcn_ds_swizzle(__float_as_int(v), PAT)); }
__device__ __forceinline__ float bperm(float v, int srclane) { return __int_as_float(__builtin_amdgcn_ds_bpermute(srclane << 2, __float_as_int(v))); }
__device__ __forceinline__ float rlane(float v, int l) { return __int_as_float(__builtin_amdgcn_readlane(__float_as_int(v), l)); }
constexpr int Z8COLS = 3584;
__device__ __forceinline__ size_t z8off(size_t row, int col) { return row * (size_t)(ZW * 2) + (size_t)(col + (col & ~255)); }
__device__ __forceinline__ const unsigned char* z8p(const bf16* Z, size_t row, int col) { return (const unsigned char*)Z + z8off(row, col); }
typedef float f32x2p __attribute__((ext_vector_type(2)));
typedef unsigned u32x2z __attribute__((ext_vector_type(2)));
__device__ __forceinline__ v4u fp8x8_bf16(const u32x2z w) {
    const f32x2p a = __builtin_amdgcn_cvt_pk_f32_fp8((int)w.x, false), b = __builtin_amdgcn_cvt_pk_f32_fp8((int)w.x, true), c = __builtin_amdgcn_cvt_pk_f32_fp8((int)w.y, false), d = __builtin_amdgcn_cvt_pk_f32_fp8((int)w.y, true);
    v4u r; r.x = (__float_as_uint(a.x) >> 16) | (__float_as_uint(a.y) & 0xffff0000u); r.y = (__float_as_uint(b.x) >> 16) | (__float_as_uint(b.y) & 0xffff0000u);
    r.z = (__float_as_uint(c.x) >> 16) | (__float_as_uint(c.y) & 0xffff0000u); r.w = (__float_as_uint(d.x) >> 16) | (__float_as_uint(d.y) & 0xffff0000u); return r; }
__device__ __forceinline__ v4u ldz8(const unsigned char* p) { return fp8x8_bf16(*(const u32x2z*)p); }
__device__ __forceinline__ unsigned fp6code(float x) {
    const float a = fminf(fabsf(x), 7.5f);
    const float sc = a < 2.f ? 8.f : (a < 4.f ? 4.f : 2.f), k = a < 2.f ? 0.f : (a < 4.f ? 8.f : 16.f);
    return (unsigned)(k + rintf(a * sc)) | ((__float_as_uint(x) >> 26) & 32u);
}
__device__ __forceinline__ float clamp240(float x) { return fminf(fmaxf(x, -240.f), 240.f); }
__device__ __forceinline__ unsigned pk4fp8(float a, float b, float c, float d) { int pk = __builtin_amdgcn_cvt_pk_fp8_f32(clamp240(a), clamp240(b), 0, false); pk = __builtin_amdgcn_cvt_pk_fp8_f32(clamp240(c), clamp240(d), pk, true); return (unsigned)pk; }
__device__ __forceinline__ unsigned f2fp8(float a) { return (unsigned)__builtin_amdgcn_cvt_pk_fp8_f32(clamp240(a), 0.f, 0, false) & 0xffu; }
#define XB_TMO      128
#define XB_XCNT(j)  (256  + 64 * (j))
#define XB_XSUB(j)  (1280 + 64 * (j))
#define XB_XGEN(j)  (2304 + 64 * (j))
#define XB_TOP      3328
#define XB_TOPGEN   3392
#define XCD_BAR_WORDS 3456
#define XB_SPIN_CAP (1u << 18)

__device__ __forceinline__ unsigned xb_ld(unsigned* p)              { return __hip_atomic_load(p, __ATOMIC_RELAXED, __HIP_MEMORY_SCOPE_AGENT); }
__device__ __forceinline__ unsigned xb_add(unsigned* p, unsigned v) { return __hip_atomic_fetch_add(p, v, __ATOMIC_RELAXED, __HIP_MEMORY_SCOPE_AGENT); }
__device__ __forceinline__ unsigned xb_xcc_id() { return (unsigned)__builtin_amdgcn_s_getreg((3 << 11) | 20) & 0xFu; }
#define XB_SPIN(cond, bar) do { unsigned _sp = 0; while (cond) { __builtin_amdgcn_s_sleep(1); \
    if ((++_sp & 255u) == 0u) { if (xb_ld(&(bar)[XB_TMO])) break; if (_sp > XB_SPIN_CAP) { atomicAdd(&(bar)[XB_TMO], 1u); break; } } } } while (0)

struct XcdBarrier {
    bool leader;
    unsigned* bar; unsigned x;
    volatile LAS unsigned* st;
};

__device__ __forceinline__ XcdBarrier xcd_barrier_post(unsigned* bar, volatile LAS unsigned* st, bool leader) {
    XcdBarrier b; b.bar = bar; b.x = xb_xcc_id(); b.st = st; b.leader = leader;
    if (leader) (void)xb_add(&bar[XB_XCNT(b.x)], 1u);
    return b;
}
__device__ __forceinline__ void xcd_barrier_complete(unsigned* bar, unsigned x, unsigned& nloc, unsigned& nx) {
    const unsigned G = gridDim.x * gridDim.y * gridDim.z;
    unsigned sum, cnt, mine, sp = 0u;
    for (;;) {
        sum = 0u; cnt = 0u; mine = 0u;
#pragma unroll
        for (unsigned j = 0; j < 16; ++j) { const unsigned c = xb_ld(&bar[XB_XCNT(j)]); sum += c; cnt += (c > 0u) ? 1u : 0u; mine = (j == x) ? c : mine; }
        if (sum == G) break;
        __builtin_amdgcn_s_sleep(1);
        if ((++sp & 255u) == 0u) { if (xb_ld(&bar[XB_TMO])) break; if (sp > XB_SPIN_CAP) { atomicAdd(&bar[XB_TMO], 1u); break; } }
    }
    nloc = mine > 0u ? mine : 1u; nx = cnt > 0u ? cnt : 1u;
}

__device__ __forceinline__ void xcd_barrier(const XcdBarrier& b) {
    asm volatile("s_waitcnt vmcnt(0)" ::: "memory");
    __syncthreads();
    if ((int)__builtin_amdgcn_mbcnt_hi(~0u, __builtin_amdgcn_mbcnt_lo(~0u, 0u)) == 0 && b.leader) {
        unsigned* bar = b.bar; asm volatile("" : "+s"(bar));
        unsigned bx = b.x; asm volatile("" : "+s"(bx));
        __builtin_amdgcn_s_waitcnt(0);
        unsigned nloc = b.st[0], nx = b.st[1];
        if (nloc == 0u) { xcd_barrier_complete(bar, bx, nloc, nx); b.st[0] = nloc; b.st[1] = nx; }
        const unsigned old = xb_add(&bar[XB_XSUB(bx)], 1u);
        const unsigned gen = old / nloc;
        if (old + 1u == (gen + 1u) * nloc) {
            __builtin_amdgcn_fence(__ATOMIC_RELEASE, "agent");
            asm volatile("s_waitcnt vmcnt(0)" ::: "memory");
            const unsigned og = xb_add(&bar[XB_TOP], 1u);
            const unsigned tg = og / nx;
            if (og + 1u == (tg + 1u) * nx) xb_add(&bar[XB_TOPGEN], 1u);
            else XB_SPIN(xb_ld(&bar[XB_TOPGEN]) == tg, bar);
            __builtin_amdgcn_fence(__ATOMIC_ACQUIRE, "agent");
            xb_add(&bar[XB_XGEN(bx)], 1u);
            asm volatile("s_waitcnt vmcnt(0)" ::: "memory");
        } else {
            XB_SPIN(xb_ld(&bar[XB_XGEN(bx)]) == gen, bar);
            __builtin_amdgcn_fence(__ATOMIC_ACQUIRE, "agent");
            asm volatile("s_waitcnt vmcnt(0)" ::: "memory");
        }
    }
    __syncthreads();
}

typedef float f32x16 __attribute__((ext_vector_type(16)));
typedef short s16x4 __attribute__((ext_vector_type(4)));
typedef unsigned u32x2 __attribute__((ext_vector_type(2)));
using pg8::bflo; using pg8::bfhi; using pg8::sigmoidf_;

struct Args { const float* in[24]; float* out; unsigned char* ws; int ph_lo, ph_hi; };

struct Frame {
    LAS unsigned char* lds;
    unsigned char* ldsg;
    volatile LAS unsigned* MISC;
    gu32* ctl;
    int tid, lane, wave, vcu, G;
    const float* const* in_dummy;
    GAS unsigned char* ws; float* out;
    const float *x, *c, *ctx, *c_ctx, *w_ada, *b_ada, *norm1_g, *norm2_g, *w_in, *ml_gate_b, *ml_conv_w, *ml_norm_g, *cv_conv_w, *da_lam, *da_subln_g,
                *w_da, *w_ml, *w_cv, *w_o, *peer_wq, *peer_keys, *peer_u, *peer_v, *final_g;
};

#define PHASE_FRAME Frame F = F0; { int l_ = (int)__builtin_amdgcn_mbcnt_hi(~0u, __builtin_amdgcn_mbcnt_lo(~0u, 0u)); asm volatile("" : "+v"(l_)); int wv_ = F0.wave; asm volatile("" : "+s"(wv_)); F.wave = wv_; F.lane = l_; F.tid = wv_ * 64 + l_; GAS unsigned char* w_ = F0.ws; asm volatile("" : "+s"(w_)); F.ws = w_; \
    const __attribute__((address_space(4))) Args* ap_ = (const __attribute__((address_space(4))) Args*)__builtin_amdgcn_kernarg_segment_ptr(); asm volatile("" : "+s"(ap_)); \
    F.x = ap_->in[0]; F.c = ap_->in[1]; F.ctx = ap_->in[2]; F.c_ctx = ap_->in[3]; F.w_ada = ap_->in[4]; F.b_ada = ap_->in[5]; F.norm1_g = ap_->in[6]; F.norm2_g = ap_->in[7]; F.w_in = ap_->in[8]; F.ml_gate_b = ap_->in[9]; \
    F.ml_conv_w = ap_->in[10]; F.ml_norm_g = ap_->in[11]; F.cv_conv_w = ap_->in[12]; F.da_lam = ap_->in[13]; F.da_subln_g = ap_->in[14]; F.w_da = ap_->in[15]; F.w_ml = ap_->in[16]; F.w_cv = ap_->in[17]; F.w_o = ap_->in[18]; \
    F.peer_wq = ap_->in[19]; F.peer_keys = ap_->in[20]; F.peer_u = ap_->in[21]; F.peer_v = ap_->in[22]; F.final_g = ap_->in[23]; F.out = ap_->out; }
__device__ __forceinline__ float wave_sum(float v) {
    v += swz<0x041F>(v); v += swz<0x081F>(v); v += swz<0x101F>(v); v += swz<0x201F>(v); v += swz<0x401F>(v);
    return rlane(v, 0) + rlane(v, 32);
}
__device__ __forceinline__ float wave_max(float v) {
    v = fmaxf(v, swz<0x041F>(v)); v = fmaxf(v, swz<0x081F>(v)); v = fmaxf(v, swz<0x101F>(v)); v = fmaxf(v, swz<0x201F>(v)); v = fmaxf(v, swz<0x401F>(v));
    return fmaxf(rlane(v, 0), rlane(v, 32));
}
__device__ __forceinline__ float reduce16(const float (&p)[16], int lane) {
    float q8[8], q4[4], q2[2];
    { const bool up = (lane & 32) != 0;
#pragma unroll
      for (int i = 0; i < 8; ++i) { const float keep = up ? p[i + 8] : p[i], send = up ? p[i] : p[i + 8]; q8[i] = keep + bperm(send, lane ^ 32); } }
    { const bool up = (lane & 16) != 0;
#pragma unroll
      for (int i = 0; i < 4; ++i) { const float keep = up ? q8[i + 4] : q8[i], send = up ? q8[i] : q8[i + 4]; q4[i] = keep + swz<0x401F>(send); } }
    { const bool up = (lane & 8) != 0;
#pragma unroll
      for (int i = 0; i < 2; ++i) { const float keep = up ? q4[i + 2] : q4[i], send = up ? q4[i] : q4[i + 2]; q2[i] = keep + swz<0x201F>(send); } }
    float v;
    { const bool up = (lane & 4) != 0; const float keep = up ? q2[1] : q2[0], send = up ? q2[0] : q2[1]; v = keep + swz<0x101F>(send); }
    v += swz<0x081F>(v); v += swz<0x041F>(v);
    return v;
}
__device__ __forceinline__ int red16_index(int lane) { return ((lane >> 5) & 1) * 8 + ((lane >> 4) & 1) * 4 + ((lane >> 3) & 1) * 2 + ((lane >> 2) & 1); }
__device__ __forceinline__ int red16_lane(int e) { return ((e >> 3) & 1) * 32 + ((e >> 2) & 1) * 16 + ((e >> 1) & 1) * 8 + (e & 1) * 4; }

__device__ __forceinline__ float siluf_(float x) { return x / (1.0f + __expf(-x)); }
__device__ __forceinline__ float bf2f(bf16 b) { return __builtin_bit_cast(float, (unsigned)b << 16); }
__device__ __forceinline__ float log_sigmoidf_(float x) { return fminf(x, 0.f) - log1pf(__expf(-fabsf(x))); }
__device__ __forceinline__ float gelu_exact(float v) { return 0.5f * v * (1.0f + erff(v * 0.70710678118654752f)); }
__device__ __forceinline__ void unpack8(const v4u w, float (&f)[8]) {
    f[0] = bflo(w.x); f[1] = bfhi(w.x); f[2] = bflo(w.y); f[3] = bfhi(w.y); f[4] = bflo(w.z); f[5] = bfhi(w.z); f[6] = bflo(w.w); f[7] = bfhi(w.w);
}
__device__ __forceinline__ void ld8f(const float* p, float (&f)[8]) { const f32x4 a = *(const f32x4*)p, b = *(const f32x4*)(p + 4); f[0] = a.x; f[1] = a.y; f[2] = a.z; f[3] = a.w; f[4] = b.x; f[5] = b.y; f[6] = b.z; f[7] = b.w; }
__device__ __forceinline__ v4u pack8(const float (&f)[8]) { v4u w; w.x = pk2(f[0], f[1]); w.y = pk2(f[2], f[3]); w.z = pk2(f[4], f[5]); w.w = pk2(f[6], f[7]); return w; }

__device__ __forceinline__ void transpose_item(const float* W, int ldw, int k0, int nsrc0, bf16* WT, int K, int ndst0, LAS float* scr, int lane) {
#pragma unroll 8
    for (int i = 0; i < 32; ++i) { const int kk = 2 * i + (lane >> 5); scr[kk * 33 + (lane & 31)] = W[(size_t)(k0 + kk) * ldw + nsrc0 + (lane & 31)]; }
    LDS_WAIT(); asm volatile("" ::: "memory");
    const int c = lane & 7;
#pragma unroll
    for (int j = 0; j < 4; ++j) { const int n = (lane >> 3) + 8 * j; const LAS float* s = scr + (8 * c) * 33 + n;
        v4u o; o.x = pk2(s[0 * 33], s[1 * 33]); o.y = pk2(s[2 * 33], s[3 * 33]); o.z = pk2(s[4 * 33], s[5 * 33]); o.w = pk2(s[6 * 33], s[7 * 33]);
        *(GAS v4u*)(WT + (size_t)(ndst0 + n) * K + k0 + 8 * c) = o; }
    LDS_WAIT(); asm volatile("" ::: "memory");
}
__device__ __forceinline__ void transpose_item8(const float* W, int ldw, int k0, int nsrc0, unsigned char* WT, int K, int ndst0, LAS float* scr, int lane) {
#pragma unroll 8
    for (int i = 0; i < 32; ++i) { const int kk = 2 * i + (lane >> 5); scr[kk * 33 + (lane & 31)] = W[(size_t)(k0 + kk) * ldw + nsrc0 + (lane & 31)]; }
    LDS_WAIT(); asm volatile("" ::: "memory");
    const int c = lane & 7;
#pragma unroll
    for (int j = 0; j < 4; ++j) { const int n = (lane >> 3) + 8 * j; const LAS float* s = scr + (8 * c) * 33 + n;
        u32x2 o; o.x = pk4fp8(s[0 * 33] * 64.f, s[1 * 33] * 64.f, s[2 * 33] * 64.f, s[3 * 33] * 64.f); o.y = pk4fp8(s[4 * 33] * 64.f, s[5 * 33] * 64.f, s[6 * 33] * 64.f, s[7 * 33] * 64.f);
        *(GAS u32x2*)(WT + (size_t)(ndst0 + n) * K + k0 + 8 * c) = o; }
    LDS_WAIT(); asm volatile("" ::: "memory");
}

#define WSP(T, off) ((T*)(GAS T*)(F.ws + (off)))
#define MISCF (WSP(float, WS_MISC))

__device__ __forceinline__ void prologue_wqk(Frame& F, int first, int stride) {
    LAS float* keysS = (LAS float*)F.lds;
    LAS float* wqS = keysS + 128 * 129;
    for (int it = first; it < 512; it += stride) {
        const int l = it >> 8, hp = (it >> 4) & 15, kb = it & 15;
        const float* keys = F.peer_keys + ((size_t)l * 16 + hp) * 16384;
        const float* wq = F.peer_wq + (size_t)l * 1024 * 2048 + (size_t)(kb * 64) * 2048 + hp * 128;
        for (int e = F.tid; e < 16384; e += NTHR) keysS[(e >> 7) * 129 + (e & 127)] = keys[e];
        for (int e = F.tid; e < 8192; e += NTHR) wqS[(e >> 7) * 129 + (e & 127)] = wq[(size_t)(e >> 7) * 2048 + (e & 127)];
        __syncthreads();
        const int kkl = F.tid & 63, kg = F.wave;
        float acc[16];
#pragma unroll
        for (int i = 0; i < 16; ++i) acc[i] = 0.f;
        for (int d = 0; d < 128; ++d) { const float w = wqS[kkl * 129 + d];
#pragma unroll
            for (int i = 0; i < 16; ++i) acc[i] += keysS[(kg * 16 + i) * 129 + d] * w; }
        unsigned char* o = WSP(unsigned char, WS_WQK) + (size_t)l * 2048 * 1024 + (size_t)(hp * 128 + kg * 16) * 1024 + kb * 64 + kkl;
#pragma unroll
        for (int i = 0; i < 16; ++i) o[(size_t)i * 1024] = (unsigned char)f2fp8(acc[i] * 64.0f);
        __syncthreads();
    }
}
__device__ __forceinline__ void prologue_transposes(Frame& F, int l, int first, int stride) {
    LAS float* scr = (LAS float*)(F.lds + F.wave * 16384);
    constexpr int PER_L = 4096 + 768 + 512;
    for (int it = first; it < PER_L; it += stride) {
        int r = it;
        if (r < 4096) { const int kb = r >> 8, n0 = (r & 255) * 32, nsrc = n0 + (n0 >= ORIG_GATE_COL ? 16 : 0);
            if (n0 >= ZBG && n0 < ZGT) transpose_item(F.w_in + (size_t)l * 1024 * DIN, DIN, kb * 64, nsrc, WSP(bf16, WS_WINC) + (size_t)l * (ZGT - ZBG) * 1024, 1024, n0 - ZBG, scr, F.lane);
            else transpose_item8(F.w_in + (size_t)l * 1024 * DIN, DIN, kb * 64, nsrc, WSP(unsigned char, WS_WIN) + (size_t)l * ZW * 1024, 1024, n0, scr, F.lane); }
        else if (r < 4864) { r -= 4096; const int br = r >> 8; r &= 255; const int kb = r >> 5, nb = r & 31;
            bf16* dst = WSP(bf16, WS_WBR) + (size_t)(l * 3 + br) * 1024 * 512; const size_t lo = (size_t)l * 512 * 1024;
            unsigned char* dst8 = WSP(unsigned char, WS_WBR) + (size_t)l * 3 * 1024 * 512 * 2 + (size_t)br * 1024 * 512;
            if (br == 0) transpose_item8(F.w_da + lo, 1024, kb * 64, nb * 32, dst8, 512, nb * 32, scr, F.lane);
            else if (br == 1) transpose_item8(F.w_ml + lo, 1024, kb * 64, nb * 32, dst8, 512, nb * 32, scr, F.lane);
            else transpose_item(F.w_cv + lo, 1024, kb * 64, nb * 32, dst, 512, nb * 32, scr, F.lane); }
        else { r -= 4864; const int kb = r >> 5, nb = r & 31;
            transpose_item(F.w_o + (size_t)l * 1024 * 1024, 1024, kb * 64, nb * 32, WSP(bf16, WS_WO) + (size_t)l * 1024 * 1024, 1024, nb * 32, scr, F.lane); }
    }
}
__device__ __forceinline__ void phase_prologue(Frame& F0) {
    PHASE_FRAME;
    const int gw = F.vcu * NWAVES + F.wave, NGW = F.G * NWAVES;
    if (!(DEFER_PROLOGUE && F.G == 256)) prologue_wqk(F, (int)blockIdx.x, F.G);
    {
        LAS float* sc = (LAS float*)F.lds;
        LAS float* red = sc + 9 * 1024;
        for (int e = F.tid; e < 9 * 1024; e += NTHR) { const int r = e >> 10, k = e & 1023; const float v = r < 8 ? F.c[r * 1024 + k] : F.c_ctx[k]; sc[e] = siluf_(v); }
        __syncthreads();
        for (int it = blockIdx.x; it < 192; it += F.G) {
            const int l = it / 96, cb = it % 96;
            const float* W = F.w_ada + (size_t)l * 1024 * 6144 + cb * 64 + F.lane;
            float a[9];
#pragma unroll
            for (int r = 0; r < 9; ++r) a[r] = 0.f;
            const int k0 = F.wave * 128;
#pragma unroll 4
            for (int k = k0; k < k0 + 128; ++k) { const float w = W[(size_t)k * 6144];
#pragma unroll
                for (int r = 0; r < 9; ++r) a[r] += sc[r * 1024 + k] * w; }
#pragma unroll
            for (int r = 0; r < 9; ++r) red[(F.wave * 9 + r) * 64 + F.lane] = a[r];
            __syncthreads();
            for (int o = F.tid; o < 576; o += NTHR) { const int r = o >> 6, j = o & 63; float s = 0.f;
#pragma unroll
                for (int w = 0; w < 8; ++w) s += red[(w * 9 + r) * 64 + j];
                WSP(float, WS_MOD)[(size_t)(l * 9 + r) * 6144 + cb * 64 + j] = s + F.b_ada[l * 6144 + cb * 64 + j]; }
            __syncthreads();
        }
    }
    {
        const int gt = F.vcu * NTHR + F.tid, NGT = F.G * NTHR;
        for (int e = gt; e < 2 * 16 * 1024; e += NGT) { const int l = e >> 14, j = (e >> 10) & 15, k = e & 1023;
            WSP(float, WS_WG)[e] = F.w_in[(size_t)l * 1024 * DIN + (size_t)k * DIN + ORIG_GATE_COL + j]; }
        for (int e = gt; e < 64 * 16; e += NGT) { const int pos = e >> 4, i = e & 15;
            const float inv = exp2f(-(float)i * (13.287712379549449f / 16.0f));
            const float ang = (float)pos * inv;
            const float n = rintf(ang * 0.15915494309189535f);
            float r = fmaf(-n, 6.28318548202514648f, ang); r = fmaf(-n, -1.7484555e-7f, r);
            MISCF[MISC_COS + e] = __cosf(r); MISCF[MISC_SIN + e] = __sinf(r); }
        if (gt < 2) { const float* lv = F.da_lam + gt * 256; float s01 = 0.f, s23 = 0.f;
            for (int i = 0; i < 64; ++i) { s01 += lv[i] * lv[64 + i]; s23 += lv[128 + i] * lv[192 + i]; }
            const float lam_init = 0.8f - 0.6f * expf(-0.3f * (float)gt);
            MISCF[MISC_LAM + gt] = expf(s01) - expf(s23) + lam_init; }
    }
    prologue_transposes(F, 0, gw, NGW);
    if (!(DEFER_PROLOGUE && F.G == 256)) prologue_transposes(F, 1, gw, NGW);
}

__device__ __forceinline__ void peer_table_convert(Frame& F, int l, size_t me, size_t nme) {
    typedef float v16f __attribute__((ext_vector_type(16))); typedef unsigned v6u_ __attribute__((ext_vector_type(6)));
    const size_t n32 = (size_t)PEER_NEXP * 1024 / 32;
    const float* su = F.peer_u + (size_t)l * PEER_NEXP * 1024; const float* sv = F.peer_v + (size_t)l * PEER_NEXP * 1024;
    unsigned char* du = WSP(unsigned char, WS_TU); unsigned char* dv = WSP(unsigned char, WS_TV);
#pragma unroll 1
    for (size_t i = me; i < 2 * n32; i += nme) {
        const bool isu = i < n32; const size_t j = isu ? i : i - n32; const float sc = isu ? PEER_USCALE : PEER_VSCALE;
        const float* s = (isu ? su : sv) + j * 32;
        f32x4 t[8];
#pragma unroll
        for (int q = 0; q < 8; ++q) t[q] = *(const f32x4*)(s + 4 * q);
        v16f a, b;
#pragma unroll
        for (int q = 0; q < 8; ++q) { a[2 * q] = t[q].x * sc; b[2 * q] = t[q].y * sc; a[2 * q + 1] = t[q].z * sc; b[2 * q + 1] = t[q].w * sc; }
        const v6u_ w = __builtin_amdgcn_cvt_scalef32_2xpk16_fp6_f32(a, b, 1.0f);
        unsigned* o = (unsigned*)((isu ? du : dv) + j * 24);
        *(u32x2*)o = (u32x2){w[0], w[1]}; *(u32x2*)(o + 2) = (u32x2){w[2], w[3]}; *(u32x2*)(o + 4) = (u32x2){w[4], w[5]};
    }
}
__device__ __forceinline__ void phase_norm(Frame& F0, int l, int which) {
    PHASE_FRAME;
    const int gw = F.vcu * NWAVES + F.wave, NGW = F.G * NWAVES;
    LAS float* wg = (LAS float*)F.lds;
    if (which == 0) {
        const float* src = WSP(float, WS_WG) + (size_t)l * 16384;
        for (int e = F.tid * 4; e < 16384; e += NTHR * 4) *(LAS f32x4*)(wg + e) = *(const f32x4*)(src + e);
        __syncthreads();
    }
    const float* xl_src = (l == 0 && which == 0) ? F.x : F.out;
    const float* xc_src = (l == 0 && which == 0) ? F.ctx : WSP(float, WS_XC);
    const float* gn1 = F.norm1_g, * gn2 = F.norm2_g; const float* gn = (which ? gn2 : gn1) + l * 1024;
    const int nrows = (which == 1 && l == 1) ? NLAT : NROW;
    bf16* H = WSP(bf16, WS_H);
    for (int row = gw; row < nrows; row += NGW) {
        const bool lat = row < NLAT;
        const float* xr = lat ? xl_src + (size_t)row * 1024 : xc_src + (size_t)(row - NLAT) * 1024;
        const float* mod = WSP(float, WS_MOD) + (size_t)(l * 9 + (lat ? (row >> 11) : 8)) * 6144 + (which ? 3072 : 0);
        f32x4 v[4]; float ss = 0.f;
#pragma unroll
        for (int j = 0; j < 4; ++j) {
            if (lat && which == 1) { const u32x2 w = *(const u32x2*)((const char*)F.out + (size_t)row * 4096 + (F.lane * 4 + 256 * j) * 2);
                v[j] = (f32x4){__uint_as_float(w.x << 16), __uint_as_float(w.x & 0xffff0000u), __uint_as_float(w.y << 16), __uint_as_float(w.y & 0xffff0000u)}; }
            else v[j] = *(const f32x4*)(xr + F.lane * 4 + 256 * j);
            ss += (v[j].x * v[j].x + v[j].y * v[j].y) + (v[j].z * v[j].z + v[j].w * v[j].w); }
        const float rstd = 1.0f / sqrtf(wave_sum(ss) * (1.0f / 1024.0f) + EPS);
#pragma unroll
        for (int j = 0; j < 4; ++j) { const int c = F.lane * 4 + 256 * j;
            const f32x4 g = *(const f32x4*)(gn + c), sh = *(const f32x4*)(mod + c), sc = *(const f32x4*)(mod + 1024 + c);
            v[j] = (v[j] * rstd * g) * (sc + 1.0f) + sh;
            if (which == 0) { u32x2 w; w.x = pk2(v[j].x, v[j].y); w.y = pk2(v[j].z, v[j].w);
                *(u32x2*)(H + (size_t)row * 1024 + c) = w; }
            *(unsigned*)(WSP(unsigned char, WS_H8) + (size_t)row * 1024 + c) = pk4fp8(v[j].x, v[j].y, v[j].z, v[j].w); }
        if (which == 0) {
            float p[16];
#pragma unroll
            for (int jj = 0; jj < 16; ++jj) { float s = 0.f;
#pragma unroll
                for (int j = 0; j < 4; ++j) { const f32x4 w = *(LAS f32x4*)(wg + jj * 1024 + F.lane * 4 + 256 * j); s += (v[j].x * w.x + v[j].y * w.y) + (v[j].z * w.z + v[j].w * w.w); }
                p[jj] = s; if ((jj & 3) == 3) __builtin_amdgcn_sched_barrier(0); }
            const float tot = reduce16(p, F.lane);
            if ((F.lane & 3) == 0) WSP(float, WS_G)[(size_t)row * 16 + red16_index(F.lane)] = tot;
        }
    }
}

__device__ __forceinline__ void phase_rope(Frame& F0) {
    PHASE_FRAME;
    const int gw = F.vcu * NWAVES + F.wave, NGW = F.G * NWAVES;
    const float* cosT = MISCF + MISC_COS; const float* sinT = MISCF + MISC_SIN;
    bf16* Z = WSP(bf16, WS_Z);
    for (int row = gw; row < NROW; row += NGW) {
        bf16* zr = Z + (size_t)row * ZW;
        if (row < NLAT) {
            const int t = row & 2047, pr = t >> 6, pc = t & 63;
#pragma unroll
            for (int tensor = 0; tensor < 2; ++tensor) { const int base = tensor ? ZK : ZQ; const float scale = tensor ? 1.0f : QSCALE;
#pragma unroll
                for (int it = 0; it < 4; ++it) { const int idx = F.lane + 64 * it, hm = idx >> 5, p = idx & 31, i = p & 15, isc = p >> 4, pos = isc ? pc : pr;
                    const int ca = base + hm * 64 + isc * 32 + i, cb = ca + 16;
                    const float c = cosT[pos * 16 + i], s = sinT[pos * 16 + i], xa = bf2f(zr[ca]), xb = bf2f(zr[cb]);
                    zr[ca] = (bf16)f2bf((xa * c - xb * s) * scale); zr[cb] = (bf16)f2bf((xa * s + xb * c) * scale); } }
        } else {
            float f[8]; unpack8(*(const v4u*)(zr + ZQ + F.lane * 8), f);
#pragma unroll
            for (int i = 0; i < 8; ++i) f[i] *= QSCALE;
            *(v4u*)(zr + ZQ + F.lane * 8) = pack8(f);
        }
    }
}
__device__ __forceinline__ void phase_convbranch(Frame& F0, int l, int r0, int r1, int wg0) {
    PHASE_FRAME;
    const int nwg = F.G - wg0;
    if ((int)blockIdx.x < wg0) return;
    const int total = r1 * 64;
    const bf16* Z = WSP(bf16, WS_Z); bf16* Y = WSP(bf16, WS_Y) + (size_t)2 * NROW * 512;
    const float* cw = F.cv_conv_w + l * 3 * 512;
    for (int e = r0 * 64 + ((int)blockIdx.x - wg0) * NTHR + F.tid; e < total; e += nwg * NTHR) {
        const int row = e >> 6, c0 = (e & 63) * 8; const bool lat = row < NLAT;
        const int t = lat ? (row & 2047) : ((row - NLAT) & 255), L = lat ? 2048 : 256;
        const bf16* zr = Z + (size_t)row * ZW;
        float acc[8], a[8], b[8], w[8];
        unpack8(*(const v4u*)(zr + ZCG + c0), a); unpack8(*(const v4u*)(zr + ZXV + c0), b);
        ld8f(cw + 512 + c0, w);
#pragma unroll
        for (int i = 0; i < 8; ++i) acc[i] = w[i] * (a[i] * b[i]);
        if (t > 0) { unpack8(*(const v4u*)(zr - ZW + ZCG + c0), a); unpack8(*(const v4u*)(zr - ZW + ZXV + c0), b);
            ld8f(cw + c0, w);
#pragma unroll
            for (int i = 0; i < 8; ++i) acc[i] += w[i] * (a[i] * b[i]); }
        if (t < L - 1) { unpack8(*(const v4u*)(zr + ZW + ZCG + c0), a); unpack8(*(const v4u*)(zr + ZW + ZXV + c0), b);
            ld8f(cw + 1024 + c0, w);
#pragma unroll
            for (int i = 0; i < 8; ++i) acc[i] += w[i] * (a[i] * b[i]); }
        unpack8(*(const v4u*)(zr + ZBG + c0), a);
#pragma unroll
        for (int i = 0; i < 8; ++i) acc[i] *= a[i] * ABLF(l, 2);
        *(v4u*)(Y + (size_t)row * 512 + c0) = pack8(acc);
    }
}

constexpr int MLP = 136;
constexpr int GS_LF = 0, GS_IG = 256, GS_DEC = 512, GS_E = 768, GS_SC = 1024;
typedef float f32x4m __attribute__((ext_vector_type(4)));
#define MFMA16(a, b, c) __builtin_amdgcn_mfma_f32_16x16x32_bf16((a), (b), (c), 0, 0, 0)

struct MlItem { int b, h, ci, row0, t0, L; };
__device__ __forceinline__ MlItem ml_decode(int b, int h, int ci) {
    MlItem m; m.b = b; m.h = h; m.ci = ci;
    if (ci < 2) { m.row0 = NLAT + b * 256 + ci * 128; m.t0 = ci * 128; m.L = 256; }
    else { m.row0 = b * 2048 + (ci - 2) * 128; m.t0 = (ci - 2) * 128; m.L = 2048; }
    return m;
}
__device__ __forceinline__ int ml_sidx(int b, int h, int dir, int ci) { return ((b * 4 + h) * 2 + dir) * NCHUNK + ci; }

__device__ __forceinline__ void ml_gates(Frame& F, int l, const MlItem& m, LAS float* gs) {
    if (F.tid < 128) {
        const float* gr = WSP(float, WS_G) + (size_t)(m.row0 + F.tid) * 16; const float* gb = F.ml_gate_b + l * 16;
        gs[GS_IG + F.tid] = gr[m.h] + gb[m.h];
        gs[GS_LF + F.tid] = log_sigmoidf_(gr[4 + m.h] + gb[4 + m.h]);
        gs[GS_IG + 128 + F.tid] = gr[8 + m.h] + gb[8 + m.h];
        gs[GS_LF + 128 + F.tid] = log_sigmoidf_(gr[12 + m.h] + gb[12 + m.h]);
    }
    __syncthreads();
    if (F.wave < 2) {
        const int d = F.wave, s0 = 2 * F.lane, s1 = s0 + 1;
        const float a = gs[GS_LF + d * 128 + s0], b = gs[GS_LF + d * 128 + s1], pair = a + b;
        float incl = pair;
#pragma unroll
        for (int o = 1; o < 64; o <<= 1) { const float t = bperm(incl, F.lane - o); if (F.lane >= o) incl += t; }
        const float total = rlane(incl, 63);
        const float P0 = incl - b, P1 = incl;
        const float D0 = d == 0 ? P0 : total - P0 + a, D1 = d == 0 ? P1 : total - P1 + b;
        const float a0 = gs[GS_IG + d * 128 + s0] - D0, a1 = gs[GS_IG + d * 128 + s1] - D1;
        const float M = wave_max(fmaxf(a0, a1));
        gs[GS_DEC + d * 128 + s0] = D0; gs[GS_DEC + d * 128 + s1] = D1;
        gs[GS_E + d * 128 + s0] = __expf(a0 - M); gs[GS_E + d * 128 + s1] = __expf(a1 - M);
        if (F.lane == 0) { gs[GS_SC + 2 * d] = M; gs[GS_SC + 2 * d + 1] = total; }
    }
    __syncthreads();
}
__device__ __forceinline__ void ml_conv_strip(const unsigned char* zc, int s_base, int t_base, int L, const float* cw, float scale, float (&o)[4][8]) {
    u32x2 xw[6];
    const u32x2 zero = {0u, 0u};
    xw[0] = t_base > 0 ? *(const u32x2*)(zc + (ptrdiff_t)(s_base - 1) * (ZW * 2)) : zero;
#pragma unroll
    for (int j = 1; j < 5; ++j) xw[j] = *(const u32x2*)(zc + (ptrdiff_t)(s_base + j - 1) * (ZW * 2));
    xw[5] = t_base + 4 < L ? *(const u32x2*)(zc + (ptrdiff_t)(s_base + 4) * (ZW * 2)) : zero;
    v4u xr[6];
#pragma unroll
    for (int j = 0; j < 6; ++j) xr[j] = fp8x8_bf16(xw[j]);
    float w0[8], w1[8], w2[8]; ld8f(cw, w0); ld8f(cw + 1024, w1); ld8f(cw + 2048, w2);
    float x0[8], x1[8], x2[8];
    unpack8(xr[0], x0); unpack8(xr[1], x1);
#pragma unroll
    for (int k = 0; k < 4; ++k) {
        unpack8(xr[k + 2], x2);
#pragma unroll
        for (int i = 0; i < 8; ++i) { o[k][i] = siluf_(w0[i] * x0[i] + w1[i] * x1[i] + w2[i] * x2[i]) * scale; x0[i] = x1[i]; x1[i] = x2[i]; }
    }
}
__device__ __forceinline__ void ml_fill_vt(Frame& F, const MlItem& m, LAS bf16* Vt, bool ext_rows) {
    const bf16* Z = WSP(bf16, WS_Z);
    const int sq = F.tid & 31, c0 = (F.tid >> 5) * 8, s_base = 4 * sq;
    v4u xr[4];
#pragma unroll
    for (int k = 0; k < 4; ++k) xr[k] = ldz8(z8p(Z, (size_t)(m.row0 + s_base + k), ZMV + m.h * 128 + c0));
#pragma unroll
    for (int q = 0; q < 4; ++q) {
        u32x2 lo, hi;
        lo.x = (xr[0][q] & 0xffffu) | (xr[1][q] << 16); lo.y = (xr[2][q] & 0xffffu) | (xr[3][q] << 16);
        hi.x = (xr[0][q] >> 16) | (xr[1][q] & 0xffff0000u); hi.y = (xr[2][q] >> 16) | (xr[3][q] & 0xffff0000u);
        *(LAS u32x2*)(Vt + (c0 + 2 * q) * MLP + s_base) = lo; *(LAS u32x2*)(Vt + (c0 + 2 * q + 1) * MLP + s_base) = hi; }
    if (ext_rows) { const int r = F.tid >> 5, s4 = (F.tid & 31) * 4; u32x2 v; v.x = r == 0 ? 0x3F803F80u : 0u; v.y = v.x; *(LAS u32x2*)(Vt + (128 + r) * MLP + s4) = v; }
}

__device__ __forceinline__ void phase_ml_a(Frame& F0, int l) {
    PHASE_FRAME;
    LAS bf16* Vt = (LAS bf16*)F.lds;
    LAS bf16* KtF = Vt + STW * MLP;
    LAS bf16* KtB = KtF + 128 * MLP;
    LAS float* gs = (LAS float*)(KtB + 128 * MLP);
    const bf16* Z = WSP(bf16, WS_Z);
    for (int item = blockIdx.x; item < NBATCH * 4 * NCHUNK; item += F.G) {
        int lane_ = F.lane; asm volatile("" : "+v"(lane_));
        const int g = lane_ >> 4, fr = lane_ & 15, w = F.wave;
        const MlItem m = ml_decode(item / 72, (item / NCHUNK) % 4, item % NCHUNK);
        ml_gates(F, l, m, gs);
        ml_fill_vt(F, m, Vt, true);
        { const int sq = F.tid & 31, c0 = (F.tid >> 5) * 8, s_base = 4 * sq;
          float kc[4][8];
          ml_conv_strip(z8p(Z, (size_t)m.row0, ZMK + m.h * 128 + c0), s_base, m.t0 + s_base, m.L, F.ml_conv_w + (size_t)l * 3072 + 512 + m.h * 128 + c0, 0.08838834764831845f, kc);
          const f32x4 ef = *(const LAS f32x4*)(gs + GS_E + s_base), eb = *(const LAS f32x4*)(gs + GS_E + 128 + s_base);
#pragma unroll
          for (int i = 0; i < 8; ++i) { u32x2 a, b;
              a.x = pk2(kc[0][i] * ef[0], kc[1][i] * ef[1]); a.y = pk2(kc[2][i] * ef[2], kc[3][i] * ef[3]);
              b.x = pk2(kc[0][i] * eb[0], kc[1][i] * eb[1]); b.y = pk2(kc[2][i] * eb[2], kc[3][i] * eb[3]);
              *(LAS u32x2*)(KtF + (c0 + i) * MLP + s_base) = a; *(LAS u32x2*)(KtB + (c0 + i) * MLP + s_base) = b; } }
        __syncthreads();
#pragma unroll 1
        for (int dir = 0; dir < 2; ++dir) {
            const LAS bf16* Kt = dir ? KtB : KtF;
            f32x4 acc[9];
#pragma unroll
            for (int ct = 0; ct < 9; ++ct) acc[ct] = (f32x4){0.f, 0.f, 0.f, 0.f};
#pragma unroll
            for (int kk = 0; kk < 4; ++kk) {
                const bf16x8 afr = *(const LAS bf16x8*)(Kt + (16 * w + fr) * MLP + 32 * kk + 8 * g);
#pragma unroll
                for (int ct = 0; ct < 9; ++ct) { const bf16x8 bfr = *(const LAS bf16x8*)(Vt + (16 * ct + fr) * MLP + 32 * kk + 8 * g); acc[ct] = MFMA16(afr, bfr, acc[ct]); }
                __builtin_amdgcn_sched_barrier(0);
            }
            const float M = gs[GS_SC + 2 * dir], tot = gs[GS_SC + 2 * dir + 1], scale = __expf(tot + M);
            const int si = ml_sidx(m.b, m.h, dir, m.ci);
            bf16* st = WSP(bf16, WS_ST) + (size_t)si * (STW * 128);
#pragma unroll
            for (int ct = 0; ct < 9; ++ct) { u32x2 v; v.x = pk2(acc[ct][0] * scale, acc[ct][1] * scale); v.y = pk2(acc[ct][2] * scale, acc[ct][3] * scale);
                *(u32x2*)(st + (16 * ct + fr) * 128 + 16 * w + 4 * g) = v; }
            if (F.tid == 0) MISCF[MISC_DEC + si] = __expf(tot);
        }
        __syncthreads();
    }
}
__device__ __forceinline__ void phase_ml_b(Frame& F0) {
    PHASE_FRAME;
    constexpr int NV = STW * 128 / 8;
    const int stride = F.G * NTHR;
    for (int e = F.vcu * NTHR + F.tid; e < 64 * NV; e += 2 * stride) {
        const int e2 = e + stride; const bool two = e2 < 64 * NV;
        const int chA = e / NV, vecA = e % NV, dirA = chA & 1, chB = two ? e2 / NV : chA, vecB = two ? e2 % NV : vecA, dirB = chB & 1;
        bf16* baseA = WSP(bf16, WS_ST) + (size_t)chA * NCHUNK * (STW * 128) + vecA * 8; bf16* baseB = WSP(bf16, WS_ST) + (size_t)chB * NCHUNK * (STW * 128) + vecB * 8;
        const float* decA = MISCF + MISC_DEC + chA * NCHUNK; const float* decB = MISCF + MISC_DEC + chB * NCHUNK;
        v4u tA[NCHUNK], tB[NCHUNK]; float dA[NCHUNK], dB[NCHUNK];
#pragma unroll
        for (int step = 0; step < NCHUNK; ++step) { const int ci = dirA == 0 ? step : (step < 2 ? 1 - step : 19 - step); tA[step] = *(const v4u*)(baseA + (size_t)ci * (STW * 128)); dA[step] = decA[ci]; }
        if (two) {
#pragma unroll
            for (int step = 0; step < NCHUNK; ++step) { const int ci = dirB == 0 ? step : (step < 2 ? 1 - step : 19 - step); tB[step] = *(const v4u*)(baseB + (size_t)ci * (STW * 128)); dB[step] = decB[ci]; } }
        { float c[8];
#pragma unroll
          for (int i = 0; i < 8; ++i) c[i] = 0.f;
#pragma unroll
          for (int step = 0; step < NCHUNK; ++step) { const int ci = dirA == 0 ? step : (step < 2 ? 1 - step : 19 - step);
              float tf[8]; unpack8(tA[step], tf);
              *(v4u*)(baseA + (size_t)ci * (STW * 128)) = pack8(c);
#pragma unroll
              for (int i = 0; i < 8; ++i) c[i] = dA[step] * c[i] + tf[i]; } }
        if (two) { float c[8];
#pragma unroll
          for (int i = 0; i < 8; ++i) c[i] = 0.f;
#pragma unroll
          for (int step = 0; step < NCHUNK; ++step) { const int ci = dirB == 0 ? step : (step < 2 ? 1 - step : 19 - step);
              float tf[8]; unpack8(tB[step], tf);
              *(v4u*)(baseB + (size_t)ci * (STW * 128)) = pack8(c);
#pragma unroll
              for (int i = 0; i < 8; ++i) c[i] = dB[step] * c[i] + tf[i]; } }
    }
}
__device__ __forceinline__ void phase_ml_c(Frame& F0, int l) {
    PHASE_FRAME;
    LAS bf16* Qi = (LAS bf16*)F.lds;
    LAS bf16* Ki = Qi + 128 * MLP;
    LAS bf16* Vt = Ki + 128 * MLP;
    LAS bf16* STl = Vt + 128 * MLP;
    LAS float* gs = (LAS float*)(STl + 129 * MLP);
    const bf16* Z = WSP(bf16, WS_Z); unsigned char* Yml = WSP(unsigned char, WS_Y) + (size_t)NROW * 512;
    const int w = F.wave;
    const int nitems = l == 0 ? NBATCH * 4 * NCHUNK : NBATCH * 4 * 16;
    for (int item = blockIdx.x; item < nitems; item += F.G) {
        const MlItem m = l == 0 ? ml_decode(item / 72, (item / NCHUNK) % 4, item % NCHUNK) : ml_decode(item / 64, (item / 16) % 4, 2 + (item % 16));
        ml_gates(F, l, m, gs);
        const bf16* st0 = WSP(bf16, WS_ST) + (size_t)ml_sidx(m.b, m.h, 0, m.ci) * (STW * 128);
        const bf16* st1 = WSP(bf16, WS_ST) + (size_t)ml_sidx(m.b, m.h, 1, m.ci) * (STW * 128);
        v4u pre[5];
#pragma unroll
        for (int k = 0; k < 4; ++k) pre[k] = *(const v4u*)(st0 + (size_t)(F.tid + NTHR * k) * 8);
        pre[4] = F.tid < 16 ? *(const v4u*)(st0 + 128 * 128 + F.tid * 8) : (v4u){0u, 0u, 0u, 0u};
        ml_fill_vt(F, m, Vt, false);
        { const int sq = F.tid & 31, c0 = (F.tid >> 5) * 8, s_base = 4 * sq;
          const float* cw = F.ml_conv_w + (size_t)l * 3072 + m.h * 128 + c0;
          float qc[4][8];
          ml_conv_strip(z8p(Z, (size_t)m.row0, ZMQ + m.h * 128 + c0), s_base, m.t0 + s_base, m.L, cw, 1.0f, qc);
#pragma unroll
          for (int k = 0; k < 4; ++k) *(LAS v4u*)(Qi + (s_base + k) * MLP + c0) = pack8(qc[k]);
          ml_conv_strip(z8p(Z, (size_t)m.row0, ZMK + m.h * 128 + c0), s_base, m.t0 + s_base, m.L, cw + 512, 0.08838834764831845f, qc);
#pragma unroll
          for (int k = 0; k < 4; ++k) *(LAS v4u*)(Ki + (s_base + k) * MLP + c0) = pack8(qc[k]); }
#define ML_ST_WRITE() do { _Pragma("unroll") for (int k = 0; k < 4; ++k) { const int e_ = F.tid + NTHR * k; *(LAS v4u*)(STl + (e_ >> 4) * MLP + (e_ & 15) * 8) = pre[k]; } \
            if (F.tid < 16) *(LAS v4u*)(STl + 128 * MLP + F.tid * 8) = pre[4]; } while (0)
        ML_ST_WRITE();
        __syncthreads();
#pragma unroll
        for (int k = 0; k < 4; ++k) pre[k] = *(const v4u*)(st1 + (size_t)(F.tid + NTHR * k) * 8);
        pre[4] = F.tid < 16 ? *(const v4u*)(st1 + 128 * 128 + F.tid * 8) : (v4u){0u, 0u, 0u, 0u};
        int lane_ = F.lane; asm volatile("" : "+v"(lane_));
        const int g = lane_ >> 4, fr = lane_ & 15;
        bf16x8 bq[4];
#pragma unroll
        for (int kk = 0; kk < 4; ++kk) bq[kk] = *(const LAS bf16x8*)(Qi + (16 * w + fr) * MLP + 32 * kk + 8 * g);
        f32x4 hs[8];
#pragma unroll
        for (int ct = 0; ct < 8; ++ct) hs[ct] = (f32x4){0.f, 0.f, 0.f, 0.f};
        LAS bf16* Pw = Qi + 16 * w * MLP;
#pragma unroll 1
        for (int dir = 0; dir < 2; ++dir) {
            if (dir == 1) { __syncthreads(); ML_ST_WRITE(); __syncthreads(); }
#pragma unroll
            for (int nt = 0; nt < 8; ++nt) { f32x4 a = (f32x4){0.f, 0.f, 0.f, 0.f};
#pragma unroll
                for (int kk = 0; kk < 4; ++kk) { const bf16x8 ak = *(const LAS bf16x8*)(Ki + (16 * nt + fr) * MLP + 32 * kk + 8 * g); a = MFMA16(ak, bq[kk], a); }
                const f32x4 es = *(const LAS f32x4*)(gs + GS_E + dir * 128 + 16 * nt + 4 * g);
                const bool full = dir == 0 ? (nt < w) : (nt > w), diag = nt == w;
                float pv[4];
#pragma unroll
                for (int r = 0; r < 4; ++r) { const bool dk = dir == 0 ? (4 * g + r <= fr) : (4 * g + r >= fr); pv[r] = (full || (diag && dk)) ? a[r] * es[r] : 0.f; }
                u32x2 pw; pw.x = pk2(pv[0], pv[1]); pw.y = pk2(pv[2], pv[3]);
                *(LAS u32x2*)(Pw + fr * MLP + 16 * nt + 4 * g) = pw;
                if (nt & 1) __builtin_amdgcn_sched_barrier(0); }
            bf16x8 bp[4];
#pragma unroll
            for (int kk = 0; kk < 4; ++kk) bp[kk] = *(const LAS bf16x8*)(Pw + fr * MLP + 32 * kk + 8 * g);
            f32x4 ai[9], ac[9];
#pragma unroll
            for (int ct = 0; ct < 9; ++ct) { ai[ct] = (f32x4){0.f, 0.f, 0.f, 0.f}; ac[ct] = (f32x4){0.f, 0.f, 0.f, 0.f}; }
            const short one_ = fr == 0 ? (short)0x3F80 : (short)0;
            const bf16x8 ones = {one_, one_, one_, one_, one_, one_, one_, one_};
#pragma unroll
            for (int kk = 0; kk < 4; ++kk) {
#pragma unroll
                for (int ct = 0; ct < 8; ++ct) { const bf16x8 av = *(const LAS bf16x8*)(Vt + (16 * ct + fr) * MLP + 32 * kk + 8 * g); ai[ct] = MFMA16(av, bp[kk], ai[ct]); }
                ai[8] = MFMA16(ones, bp[kk], ai[8]);
#pragma unroll
                for (int ct = 0; ct < 8; ++ct) { const bf16x8 sv = *(const LAS bf16x8*)(STl + (16 * ct + fr) * MLP + 32 * kk + 8 * g); ac[ct] = MFMA16(sv, bq[kk], ac[ct]); }
                { bf16x8 sv = *(const LAS bf16x8*)(STl + 128 * MLP + 32 * kk + 8 * g); if (fr != 0) sv = (bf16x8){0, 0, 0, 0, 0, 0, 0, 0}; ac[8] = MFMA16(sv, bq[kk], ac[8]); }
                __builtin_amdgcn_sched_barrier(0); }
            const float eM = __expf(gs[GS_SC + 2 * dir]);
            const float rs = __expf(gs[GS_DEC + dir * 128 + 16 * w + fr]);
            const float denl = rs * (eM * ai[8][0] + ac[8][0]);
            const float den = bperm(denl, fr);
            const float inv = rs / fmaxf(fabsf(den), 1.0f);
#pragma unroll
            for (int ct = 0; ct < 8; ++ct) hs[ct] += (ai[ct] * eM + ac[ct]) * inv;
        }
        const float* ng = F.ml_norm_g + l * 512 + m.h * 128;
        float ss = 0.f;
#pragma unroll
        for (int ct = 0; ct < 8; ++ct) ss += (hs[ct][0] * hs[ct][0] + hs[ct][1] * hs[ct][1]) + (hs[ct][2] * hs[ct][2] + hs[ct][3] * hs[ct][3]);
        ss += swz<0x401F>(ss); ss += bperm(ss, lane_ ^ 32);
        const float rstd = 1.0f / sqrtf(ss * (1.0f / 128.0f) + EPS) * ABLF(l, 1);
        const size_t row = (size_t)(m.row0 + 16 * w + fr);
#pragma unroll
        for (int ct = 0; ct < 8; ++ct) { const int col = m.h * 128 + 16 * ct + 4 * g;
            const unsigned ow = *(const unsigned*)z8p(Z, row, ZMO + col); const f32x4 gv = *(const f32x4*)(ng + 16 * ct + 4 * g);
            const f32x2p oa = __builtin_amdgcn_cvt_pk_f32_fp8((int)ow, false), ob = __builtin_amdgcn_cvt_pk_f32_fp8((int)ow, true);
            *(unsigned*)(Yml + row * 512 + col) = pk4fp8(hs[ct][0] * rstd * gv[0] * sigmoidf_(oa.x), hs[ct][1] * rstd * gv[1] * sigmoidf_(oa.y),
                                                         hs[ct][2] * rstd * gv[2] * sigmoidf_(ob.x), hs[ct][3] * rstd * gv[3] * sigmoidf_(ob.y)); }
        __syncthreads();
    }
}

constexpr int AT_SHM_V = 64 * 128 * 2, AT_SHM_K = 64 * 128 * 2;
#define KSWZ(row, colB) ((row) * 256 + ((colB) ^ (((row) & 7) << 4)))
#define SBAR() __builtin_amdgcn_sched_barrier(0)
__device__ __forceinline__ int crow(int r, int hi) { return (r & 3) + 8 * (r >> 2) + 4 * hi; }
__device__ __forceinline__ unsigned cvtpk(float lo, float hi) { unsigned r; asm volatile("v_cvt_pk_bf16_f32 %0, %1, %2" : "=v"(r) : "v"(lo), "v"(hi)); return r; }
__device__ __forceinline__ int v_st(int k, int c) { const int kk = (k & ~0xC) | ((k & 4) << 1) | ((k & 8) >> 1); return ((kk >> 3) * 4 + (c >> 5)) * 512 + ((kk & 7) * 32 + (c & 31)) * 2; }
__device__ __forceinline__ int v_rd_base(int lane) { return ((lane & 3) << 3) | (((lane >> 2) & 3) << 6) | (((lane >> 4) & 1) << 5) | (((lane >> 5) & 1) << 8); }
constexpr int v_rd_off(int d0, int ks, int half) { return d0 * 512 + ks * 4096 + half * 2048; }
template <int OFF> __device__ __forceinline__ s16x4 tr_read(int vb) { s16x4 r; asm volatile("ds_read_b64_tr_b16 %0, %1 offset:%2" : "=&v"(r) : "v"(vb), "i"(OFF) : "memory"); return r; }
template <int D0> __device__ __forceinline__ void pv_one(f32x16& od, int vb, bf16x8 pa0, bf16x8 pa1, bf16x8 pa2, bf16x8 pa3) {
    const s16x4 l0 = tr_read<v_rd_off(D0, 0, 0)>(vb), h0 = tr_read<v_rd_off(D0, 0, 1)>(vb), l1 = tr_read<v_rd_off(D0, 1, 0)>(vb), h1 = tr_read<v_rd_off(D0, 1, 1)>(vb);
    const s16x4 l2 = tr_read<v_rd_off(D0, 2, 0)>(vb), h2 = tr_read<v_rd_off(D0, 2, 1)>(vb), l3 = tr_read<v_rd_off(D0, 3, 0)>(vb), h3 = tr_read<v_rd_off(D0, 3, 1)>(vb);
    asm volatile("s_waitcnt lgkmcnt(0)" ::: "memory"); SBAR();
#define PK(L, H) (bf16x8){L[0], L[1], L[2], L[3], H[0], H[1], H[2], H[3]}
    od = __builtin_amdgcn_mfma_f32_32x32x16_bf16(pa0, PK(l0, h0), od, 0, 0, 0);
    od = __builtin_amdgcn_mfma_f32_32x32x16_bf16(pa1, PK(l1, h1), od, 0, 0, 0);
    od = __builtin_amdgcn_mfma_f32_32x32x16_bf16(pa2, PK(l2, h2), od, 0, 0, 0);
    od = __builtin_amdgcn_mfma_f32_32x32x16_bf16(pa3, PK(l3, h3), od, 0, 0, 0);
#undef PK
}
template <int MAP> __device__ __forceinline__ void qkt_map(f32x16& p0, f32x16& p1, const LAS char* Ks, const bf16x8* qr, int r32, int hi, float cinit) {
#pragma unroll
    for (int r = 0; r < 16; ++r) { p0[r] = cinit; p1[r] = cinit; }
#pragma unroll
    for (int d0 = 4 * MAP; d0 < 4 * MAP + 4; ++d0) { const int cb = (d0 * 16 + hi * 8) * 2;
        const bf16x8 b0 = *(const LAS bf16x8*)(Ks + KSWZ(r32, cb));
        const bf16x8 b1 = *(const LAS bf16x8*)(Ks + KSWZ(32 + r32, cb));
        p0 = __builtin_amdgcn_mfma_f32_32x32x16_bf16(b0, qr[d0], p0, 0, 0, 0);
        p1 = __builtin_amdgcn_mfma_f32_32x32x16_bf16(b1, qr[d0], p1, 0, 0, 0); }
}
template <int HALF> __device__ __forceinline__ void qkt_half(f32x16& pm, f32x16& qm, const LAS char* Ks, const bf16x8* qr, int r32, int hi, float c0, float c1) {
#pragma unroll
    for (int r = 0; r < 16; ++r) { pm[r] = c0; qm[r] = c1; }
#pragma unroll
    for (int d0 = 0; d0 < 4; ++d0) {
        const bf16x8 b0 = *(const LAS bf16x8*)(Ks + KSWZ(32 * HALF + r32, (d0 * 16 + hi * 8) * 2));
        const bf16x8 b1 = *(const LAS bf16x8*)(Ks + KSWZ(32 * HALF + r32, ((4 + d0) * 16 + hi * 8) * 2));
        pm = __builtin_amdgcn_mfma_f32_32x32x16_bf16(b0, qr[d0], pm, 0, 0, 0);
        qm = __builtin_amdgcn_mfma_f32_32x32x16_bf16(b1, qr[4 + d0], qm, 0, 0, 0); }
}
__device__ __forceinline__ float swap_max(float v) { auto rr = __builtin_amdgcn_permlane32_swap(__float_as_uint(v), __float_as_uint(v), false, false); return fmaxf(__uint_as_float(rr[0]), __uint_as_float(rr[1])); }
__device__ __forceinline__ float swap_sum(float v) { auto rr = __builtin_amdgcn_permlane32_swap(__float_as_uint(v), __float_as_uint(v), false, false); return __uint_as_float(rr[0]) + __uint_as_float(rr[1]); }
constexpr float AT_THR = 8.0f;
__device__ __forceinline__ void online_ml(f32x16& p0, f32x16& p1, float& m, float& l, bool first) {
    float mx = p0[0];
#pragma unroll
    for (int r = 1; r < 16; ++r) mx = fmaxf(mx, p0[r]);
#pragma unroll
    for (int r = 0; r < 16; ++r) mx = fmaxf(mx, p1[r]);
    mx = swap_max(mx);
    if (first || __any(mx > AT_THR)) {
        const float d = (first || mx > AT_THR) ? mx : 0.f;
        m += d; l = first ? 0.f : l * __builtin_amdgcn_exp2f(-d);
#pragma unroll
        for (int r = 0; r < 16; ++r) { p0[r] -= d; p1[r] -= d; }
    }
    float s = 0.f;
#pragma unroll
    for (int r = 0; r < 16; ++r) s += __builtin_amdgcn_exp2f(p0[r]);
#pragma unroll
    for (int r = 0; r < 16; ++r) s += __builtin_amdgcn_exp2f(p1[r]);
    l += s;
}

template <int MAP> __device__ __forceinline__ void attn_one_map(Frame& F, const bf16* Z, int b, int h, int qrow0, int NT, f32x16 (&o)[4]) {
    const int tid = F.tid, wid = F.wave, lane = F.lane, r32 = lane & 31, hi = lane >> 5;
    LAS char* V_lds = (LAS char*)F.lds; LAS char* K_lds = V_lds + 2 * AT_SHM_V;
    bf16x8 qr[8];
    {
#pragma unroll
      for (int d0 = 4 * MAP; d0 < 4 * MAP + 4; ++d0) qr[d0] = __builtin_bit_cast(bf16x8, ldz8(z8p(Z, (size_t)(qrow0 + wid * 32 + r32), ZQ + h * 128 + hi * 8 + d0 * 16))); }
    const int sr = tid >> 4, sc = (tid & 15) * 8, vst0 = v_st(sr, sc), vst1 = v_st(32 + sr, sc);
    const int kr = tid >> 3, kcol = 64 * MAP + (tid & 7) * 8, kc = kcol * 2;
    const int vb0 = (int)(uintptr_t)V_lds + v_rd_base(lane);
#define KBASE(j) ((size_t)((j) < 4 ? NLAT + b * 256 + (j) * 64 : b * 2048 + ((j) - 4) * 64) * (size_t)(ZW * 2))
    const char* Zc = (const char*)Z;
    const unsigned kofs = (unsigned)z8off(kr, ZK + h * 128 + kcol), vofs0 = (unsigned)z8off(sr, ZV + h * 128 + sc), vofs1 = vofs0 + (unsigned)(32 * ZW * 2);
#define PK4(P, BASE, OUT) do { unsigned a0 = cvtpk(P[BASE + 0], P[BASE + 1]), a1 = cvtpk(P[BASE + 2], P[BASE + 3]);   \
    unsigned b0 = cvtpk(P[BASE + 4], P[BASE + 5]), b1 = cvtpk(P[BASE + 6], P[BASE + 7]);                              \
    auto r0 = __builtin_amdgcn_permlane32_swap(a0, b0, false, false); auto r1 = __builtin_amdgcn_permlane32_swap(a1, b1, false, false); \
    v4u w_ = {r0[0], r1[0], r0[1], r1[1]}; OUT = __builtin_bit_cast(bf16x8, w_); } while (0)
    o[0] = f32x16{}; o[1] = f32x16{}; o[2] = f32x16{}; o[3] = f32x16{};
    float m = 0.f, l = 0.f;
    u32x2 ks = *(const u32x2*)(Zc + KBASE(0) + kofs);
    u32x2 vs0 = *(const u32x2*)(Zc + KBASE(0) + vofs0), vs1 = *(const u32x2*)(Zc + KBASE(0) + vofs1);
    *(LAS v4u*)(K_lds + KSWZ(kr, kc)) = fp8x8_bf16(ks);
    *(LAS v4u*)(V_lds + vst0) = fp8x8_bf16(vs0); *(LAS v4u*)(V_lds + vst1) = fp8x8_bf16(vs1);
    __syncthreads();
    for (int j = 0; j < NT; ++j) {
        const int cur = j & 1; const bool more = j + 1 < NT, first = j == 0;
        if (more) { const char* zt = Zc + KBASE(j + 1); ks = *(const u32x2*)(zt + kofs); vs0 = *(const u32x2*)(zt + vofs0); vs1 = *(const u32x2*)(zt + vofs1); }
        const LAS char* Kc = K_lds + cur * AT_SHM_K;
        f32x16 p0, p1;
        { float c = -m; asm volatile("" : "+v"(c)); qkt_map<MAP>(p0, p1, Kc, qr, r32, hi, c); }
        float mx = p0[0];
#pragma unroll
        for (int r = 1; r < 16; ++r) mx = fmaxf(mx, p0[r]);
#pragma unroll
        for (int r = 0; r < 16; ++r) mx = fmaxf(mx, p1[r]);
        mx = swap_max(mx);
        if (first || __any(mx > AT_THR)) {
            const float d = (first || mx > AT_THR) ? mx : 0.f;
            m += d;
#pragma unroll
            for (int r = 0; r < 16; ++r) { p0[r] -= d; p1[r] -= d; }
            if (!first) { const float f = __builtin_amdgcn_exp2f(-d); l *= f;
#pragma unroll
                for (int r = 0; r < 16; ++r) { const float fr = bperm(f, crow(r, hi));
                    o[0][r] *= fr; o[1][r] *= fr; o[2][r] *= fr; o[3][r] *= fr; } }
        }
        SBAR();
        float s = 0.f;
#pragma unroll
        for (int r = 0; r < 16; ++r) { p0[r] = __builtin_amdgcn_exp2f(p0[r]); s += p0[r]; }
#pragma unroll
        for (int r = 0; r < 16; ++r) { p1[r] = __builtin_amdgcn_exp2f(p1[r]); s += p1[r]; }
        l += s;
        bf16x8 pa0, pa1, pa2, pa3;
        PK4(p0, 0, pa0); PK4(p0, 8, pa1); PK4(p1, 0, pa2); PK4(p1, 8, pa3);
        SBAR();
        const int vb = vb0 + cur * AT_SHM_V;
        pv_one<0>(o[0], vb, pa0, pa1, pa2, pa3); pv_one<1>(o[1], vb, pa0, pa1, pa2, pa3); pv_one<2>(o[2], vb, pa0, pa1, pa2, pa3); pv_one<3>(o[3], vb, pa0, pa1, pa2, pa3);
        if (more) { LAS char* Kn = K_lds + (cur ^ 1) * AT_SHM_K; LAS char* Vn = V_lds + (cur ^ 1) * AT_SHM_V;
            *(LAS v4u*)(Kn + KSWZ(kr, kc)) = fp8x8_bf16(ks);
            *(LAS v4u*)(Vn + vst0) = fp8x8_bf16(vs0); *(LAS v4u*)(Vn + vst1) = fp8x8_bf16(vs1); }
        __syncthreads();
    }
#undef PK4
#undef KBASE
    l = swap_sum(l);
    const float inv = 1.0f / l;
#pragma unroll
    for (int r = 0; r < 16; ++r) { const float fr = bperm(inv, crow(r, hi));
        o[0][r] *= fr; o[1][r] *= fr; o[2][r] *= fr; o[3][r] *= fr; }
}
__device__ __forceinline__ void attn_item(Frame& F, int l, int b, int h, int qb, float lam, float postscale) {
    const int wid = F.wave, lane = F.lane, r32 = lane & 31, hi = lane >> 5;
    const bool ctxq = qb < 0; const int NT = ctxq ? 4 : 36;
    const int qrow0 = ctxq ? NLAT + b * 256 : b * 2048 + qb * 256;
    const bf16* Z = WSP(bf16, WS_Z);
    f32x16 o[4];
    {
        LAS char* stash = (LAS char*)F.lds + 2 * AT_SHM_V + 2 * AT_SHM_K + wid * 8192 + lane * 16;
        attn_one_map<0>(F, Z, b, h, qrow0, NT, o);
#pragma unroll
        for (int d0 = 0; d0 < 4; ++d0)
#pragma unroll
            for (int i = 0; i < 2; ++i) { v4u w; w.x = cvtpk(o[d0][8 * i + 0], o[d0][8 * i + 1]); w.y = cvtpk(o[d0][8 * i + 2], o[d0][8 * i + 3]); w.z = cvtpk(o[d0][8 * i + 4], o[d0][8 * i + 5]); w.w = cvtpk(o[d0][8 * i + 6], o[d0][8 * i + 7]);
                *(LAS v4u*)(stash + (d0 * 2 + i) * 1024) = w; }
        SBAR();
        attn_one_map<1>(F, Z, b, h, qrow0, NT, o);
        const float nlam = -lam;
#pragma unroll
        for (int d0 = 0; d0 < 4; ++d0)
#pragma unroll
            for (int i = 0; i < 2; ++i) { const v4u w = *(const LAS v4u*)(stash + (d0 * 2 + i) * 1024);
#pragma unroll
                for (int q = 0; q < 4; ++q) { o[d0][8 * i + 2 * q] = fmaf(nlam, o[d0][8 * i + 2 * q], __uint_as_float(w[q] << 16)); o[d0][8 * i + 2 * q + 1] = fmaf(nlam, o[d0][8 * i + 2 * q + 1], __uint_as_float(w[q] & 0xffff0000u)); } }
    }
    const float* sg = F.da_subln_g + l * 128;
    unsigned char* Yda = WSP(unsigned char, WS_Y);
    float g4[4];
#pragma unroll
    for (int d0 = 0; d0 < 4; ++d0) g4[d0] = sg[32 * d0 + r32] * postscale * ABLF(l, 0);
#pragma unroll
    for (int r = 0; r < 16; ++r) {
        float ss = (o[0][r] * o[0][r] + o[1][r] * o[1][r]) + (o[2][r] * o[2][r] + o[3][r] * o[3][r]);
        ss += swz<0x041F>(ss); ss += swz<0x081F>(ss); ss += swz<0x101F>(ss); ss += swz<0x201F>(ss); ss += swz<0x401F>(ss);
        const float rstd = 1.0f / sqrtf(ss * (1.0f / 128.0f) + EPS);
        unsigned char* yr = Yda + (size_t)(qrow0 + wid * 32 + crow(r, hi)) * 512 + h * 128 + r32;
#pragma unroll
        for (int d0 = 0; d0 < 4; ++d0) yr[32 * d0] = (unsigned char)f2fp8(o[d0][r] * rstd * g4[d0]);
    }
}
__device__ __forceinline__ void phase_attn(Frame& F0, int l) {
    PHASE_FRAME;
    const float lam = MISCF[MISC_LAM + l]; const float lam_init = 0.8f - 0.6f * expf(-0.3f * (float)l);
    const int nitems = l == 0 ? 288 : 256;
    const int nctx = (l == 0 && F.G == 256) ? 32 : 0; const bool do_conv = F.vcu >= nctx;
    const size_t cme = (size_t)(F.vcu - nctx) * NTHR + F.tid, cnme = (size_t)(F.G - nctx) * NTHR;
    const bool conv_first = (F.vcu & 1) == 0;
    if (do_conv && conv_first) peer_table_convert(F, l, cme, cnme);
    for (int it = F.vcu; it < nitems; it += F.G) {
        if (it < 256) attn_item(F, l, it >> 5, (it >> 3) & 3, it & 7, lam, 1.0f - lam_init);
        else { const int j = it - 256; attn_item(F, l, j >> 2, j & 3, -1, lam, 1.0f - lam_init); }
    }
    if (do_conv && !conv_first) peer_table_convert(F, l, cme, cnme);
}

__device__ __forceinline__ unsigned fkey(float f) { const unsigned b = __float_as_uint(f); return (b & 0x80000000u) ? ~b : (b | 0x80000000u); }
__device__ __forceinline__ float funkey(unsigned k) { return __uint_as_float((k & 0x80000000u) ? (k & 0x7fffffffu) : ~k); }
__device__ __forceinline__ void ins16(unsigned (&lst)[16], unsigned v) {
#pragma unroll
    for (int i = 0; i < 16; ++i) { const unsigned hi = lst[i] > v ? lst[i] : v; v = lst[i] > v ? v : lst[i]; lst[i] = hi; }
}
#define CE_D(a, b) do { const unsigned hi_ = (a) > (b) ? (a) : (b), lo_ = (a) > (b) ? (b) : (a); (a) = hi_; (b) = lo_; } while (0)
__device__ __forceinline__ void sort16_desc(unsigned (&k)[16]) {
#pragma unroll
    for (int kk = 2; kk <= 16; kk <<= 1)
#pragma unroll
        for (int j = kk >> 1; j > 0; j >>= 1)
#pragma unroll
            for (int i = 0; i < 16; ++i) { const int l = i ^ j;
                if (l > i) { if ((i & kk) == 0) CE_D(k[i], k[l]); else CE_D(k[l], k[i]); } }
}
__device__ __forceinline__ void merge16_desc(unsigned (&cur)[16], const unsigned (&blk)[16]) {
#pragma unroll
    for (int i = 0; i < 16; ++i) cur[i] = cur[i] > blk[15 - i] ? cur[i] : blk[15 - i];
#pragma unroll
    for (int j = 8; j > 0; j >>= 1)
#pragma unroll
        for (int i = 0; i < 16; ++i) { const int l = i ^ j; if (l > i) CE_D(cur[i], cur[l]); }
}
typedef short s16x2 __attribute__((ext_vector_type(2)));
__device__ __forceinline__ v4u ld16h(const LAS unsigned char* p) { return *(const LAS v4u*)p; }
__device__ __forceinline__ v4u ld16h(const unsigned char* p) { return *(const v4u*)p; }
template <class SP> __device__ __forceinline__ void peer_top16_of_128(SP s, unsigned (&lst)[16]) {
#pragma unroll 1
    for (int blk = 0; blk < 8; ++blk) {
        const v4u w0 = ld16h(s + blk * 16);
        const unsigned base = 127u - (unsigned)(blk * 16);
        unsigned ka[16];
#pragma unroll
        for (int t = 0; t < 4; ++t) { const unsigned w = w0[t];
            ka[4 * t] = (w << 24) | (base - (unsigned)(4 * t)); ka[4 * t + 1] = ((w << 16) & 0xFF000000u) | (base - (unsigned)(4 * t + 1));
            ka[4 * t + 2] = ((w << 8) & 0xFF000000u) | (base - (unsigned)(4 * t + 2)); ka[4 * t + 3] = (w & 0xFF000000u) | (base - (unsigned)(4 * t + 3)); }
        sort16_desc(ka);
        if (blk == 0) {
#pragma unroll
            for (int i = 0; i < 16; ++i) lst[i] = ka[i];
        } else merge16_desc(lst, ka);
    }
}
__device__ __forceinline__ float key16_score(unsigned key) { return ((float)(int)(key >> 24) - 128.0f) * (1.0f / PEER_SQ); }
__device__ __forceinline__ unsigned pick16(const unsigned (&P)[4], unsigned idx) {
    const unsigned sel = (idx & 7u) | 0x0c0c0c00u;
    const unsigned lo = __builtin_amdgcn_perm(P[1], P[0], sel), hi = __builtin_amdgcn_perm(P[3], P[2], sel);
    return (idx & 8u) ? hi : lo;
}
template <class IP, class GP> __device__ __forceinline__ void peer_topk_finish(const unsigned (&l0)[16], const unsigned (&l1)[16], IP eo, GP go) {
        float v0[16], v1[16]; unsigned P0[4], P1[4];
#pragma unroll
        for (int i = 0; i < 16; ++i) { v0[i] = key16_score(l0[i]); v1[i] = key16_score(l1[i]); }
#pragma unroll
        for (int q = 0; q < 4; ++q) {
            P0[q] = (127u - (l0[4 * q] & 127u)) | ((127u - (l0[4 * q + 1] & 127u)) << 8) | ((127u - (l0[4 * q + 2] & 127u)) << 16) | ((127u - (l0[4 * q + 3] & 127u)) << 24);
            P1[q] = (127u - (l1[4 * q] & 127u)) | ((127u - (l1[4 * q + 1] & 127u)) << 8) | ((127u - (l1[4 * q + 2] & 127u)) << 16) | ((127u - (l1[4 * q + 3] & 127u)) << 24); }
#define PKEY(i, j) ((fkey(v0[i] + v1[j]) & ~255u) | (255u - (unsigned)((i) * 16 + (j))))
        unsigned A[16], B[16], C[16], D[16];
#pragma unroll
        for (int j = 0; j < 16; ++j) A[j] = PKEY(0, j);
        {
            int cnt = 0;
#pragma unroll
            for (int i = 1; i < 16; ++i)
#pragma unroll
                for (int j = 0; j < 16; ++j) if ((i + 1) * (j + 1) <= 16) { const unsigned key = PKEY(i, j);
                    if (cnt < 16) B[cnt] = key; else if (cnt < 32) C[cnt - 16] = key; else D[cnt - 32] = key; ++cnt; }
#pragma unroll
            for (int c = 2; c < 16; ++c) D[c] = 0u;
        }
#undef PKEY
        sort16_desc(B); sort16_desc(C); sort16_desc(D);
        merge16_desc(A, B); merge16_desc(C, D); merge16_desc(A, C);
        float bs[16]; float mx = funkey(A[0] & ~255u), sum = 0.f;
#pragma unroll
        for (int r = 0; r < 16; ++r) { bs[r] = __expf(funkey(A[r] & ~255u) - mx); sum += bs[r]; }
        const float inv = 1.0f / sum;
#pragma unroll
        for (int r = 0; r < 16; ++r) { const unsigned flat = 255u - (A[r] & 255u);
            eo[r] = (int)(pick16(P0, flat >> 4) * 128u + pick16(P1, flat)); go[r] = bs[r] * inv; }
}
template <class IP, class GP> __device__ __forceinline__ void peer_topk_problem(const unsigned char* SC, int row, int hh, IP eo, GP go) {
    const unsigned char* sp = SC + (size_t)row * 2048 + hh * 256;
    unsigned l0[16], l1[16];
    peer_top16_of_128(sp, l0); peer_top16_of_128(sp + 128, l1);
    peer_topk_finish(l0, l1, eo, go);
}
__device__ __forceinline__ void phase_peer_topk(Frame& F0, int l) {
    PHASE_FRAME;
    const int nprob = (l == 0 ? NROW : NLAT) * 8;
    const unsigned char* SC = WSP(unsigned char, WS_SC);
    LAS char* stg = (LAS char*)F.lds + F.wave * 17408;
    const int lane = F.lane;
    const int ntask = nprob / 64, nbase = F.G * NWAVES;
    const bool spread = ntask >= nbase && ntask - nbase <= F.G;
    for (int k = 0;; ++k) {
        int task;
        if (spread) { if (k == 0) task = F.vcu * NWAVES + F.wave; else if (k == 1 && F.wave == (F.vcu & 7) && nbase + F.vcu < ntask) task = nbase + F.vcu; else break; }
        else { task = F.vcu * NWAVES + F.wave + k * nbase; if (task >= ntask) break; }
        const int pbase = task * 64;
        unsigned l0[16], l1[16];
#pragma unroll
        for (int q = 0; q < 16; ++q) { const int pw = 4 * q + (lane >> 4), pid = pbase + pw, chunk = lane & 15;
            const v4u w = *(const v4u*)(SC + (size_t)(pid >> 3) * 2048 + (pid & 7) * 256 + chunk * 16);
            *(LAS v4u*)(stg + pw * 272 + chunk * 16) = w; }
        asm volatile("s_waitcnt lgkmcnt(0)" ::: "memory");
        peer_top16_of_128((const LAS unsigned char*)(stg + lane * 272), l0); peer_top16_of_128((const LAS unsigned char*)(stg + lane * 272 + 128), l1);
        asm volatile("s_waitcnt lgkmcnt(0)" ::: "memory");
        const int pid = pbase + lane, row = pid >> 3, hh = pid & 7;
        peer_topk_finish(l0, l1, WSP(int, WS_EIDX) + (size_t)row * 128 + hh * 16, WSP(float, WS_EGATE) + (size_t)row * 128 + hh * 16);
    }
}

typedef float f32x2v __attribute__((ext_vector_type(2)));
__device__ __forceinline__ void fp8x16_to_f32(const v4u w, float (&f)[16]) {
#pragma unroll
    for (int q = 0; q < 4; ++q) { const f32x2v a = __builtin_amdgcn_cvt_pk_f32_fp8((int)w[q], false), b = __builtin_amdgcn_cvt_pk_f32_fp8((int)w[q], true);
        f[4 * q] = a.x; f[4 * q + 1] = a.y; f[4 * q + 2] = b.x; f[4 * q + 3] = b.y; }
}
typedef unsigned v3u __attribute__((ext_vector_type(3)));
typedef unsigned v6u __attribute__((ext_vector_type(6)));
typedef float v32f __attribute__((ext_vector_type(32)));
__device__ __forceinline__ v32f fp6x32_to_f32(const v3u a, const v3u b) { const v6u w = {a.x, a.y, a.z, b.x, b.y, b.z}; return __builtin_amdgcn_cvt_scalef32_pk32_f32_fp6(w, 1.0f); }
__device__ __forceinline__ const GAS unsigned* srow(const unsigned char* tab, int e, unsigned lane12) { asm volatile("" : "+v"(lane12));
    return (const GAS unsigned*)((const GAS unsigned char*)tab + (size_t)(unsigned)e * (unsigned)PEER_ROWB + lane12); }
#ifndef PG_SORT
#define PG_SORT 1
#endif
template <int K, int J> __device__ __forceinline__ void bsort_step(unsigned& a, unsigned& b, int lane) {
    if constexpr (J == 64) { const unsigned lo = a < b ? a : b, hi = a < b ? b : a; a = lo; b = hi; }
    else {
        unsigned pa, pb;
        if constexpr (J == 32) { pa = (unsigned)__builtin_amdgcn_ds_bpermute((lane ^ 32) << 2, (int)a); pb = (unsigned)__builtin_amdgcn_ds_bpermute((lane ^ 32) << 2, (int)b); }
        else { pa = (unsigned)__builtin_amdgcn_ds_swizzle((int)a, 0x1F | (J << 10)); pb = (unsigned)__builtin_amdgcn_ds_swizzle((int)b, 0x1F | (J << 10)); }
        const bool lower = (lane & J) == 0;
        bool asca, ascb;
        if constexpr (K < 64) { asca = (lane & K) == 0; ascb = asca; } else if constexpr (K == 64) { asca = true; ascb = false; } else { asca = true; ascb = true; }
        const unsigned mna = a < pa ? a : pa, mxa = a < pa ? pa : a, mnb = b < pb ? b : pb, mxb = b < pb ? pb : b;
        a = (lower == asca) ? mna : mxa; b = (lower == ascb) ? mnb : mxb;
    }
}
template <int K, int J> __device__ __forceinline__ void bsort_stage(unsigned& a, unsigned& b, int lane) { bsort_step<K, J>(a, b, lane); if constexpr (J > 1) bsort_stage<K, J / 2>(a, b, lane); }
__device__ __forceinline__ void bsort128(unsigned& a, unsigned& b, int lane) {
    bsort_stage<2, 1>(a, b, lane); bsort_stage<4, 2>(a, b, lane); bsort_stage<8, 4>(a, b, lane); bsort_stage<16, 8>(a, b, lane);
    bsort_stage<32, 16>(a, b, lane); bsort_stage<64, 32>(a, b, lane); bsort_stage<128, 64>(a, b, lane);
}
__device__ __forceinline__ unsigned pick_key(int id, float g) { return ((unsigned)id << 16) | (unsigned)__builtin_bit_cast(unsigned short, (_Float16)g); }
__device__ __forceinline__ float key_gate(unsigned k) { return (float)__builtin_bit_cast(_Float16, (unsigned short)(k & 0xffffu)); }
template <int NB, bool LIDX, bool PIPE = false> __device__ __forceinline__ void phase_peer_gather(Frame& F0, int l, bool dry, int mode) {
    PHASE_FRAME;
    const int gw = mode == 0 ? F.vcu * NWAVES + F.wave : ((int)blockIdx.x - 128) * NWAVES + F.wave, NGW = mode == 0 ? F.G * NWAVES : 1024;
    const int nrows = l == 0 ? NROW : NLAT;
    LAS int* EIl = (LAS int*)(F.lds + 65536); LAS float* EGl = (LAS float*)(F.lds + 65536 + 72 * 128 * 4);
    const int rpb = nrows / 256, brow0 = (int)blockIdx.x * rpb;
    if (LIDX) {
        const unsigned char* SCp = WSP(unsigned char, WS_SC);
        for (int pr = F.tid; pr < rpb * 8; pr += NTHR) { const int rl = pr >> 3, hh = pr & 7; peer_topk_problem(SCp, brow0 + rl, hh, EIl + rl * 128 + hh * 16, EGl + rl * 128 + hh * 16); }
        __syncthreads();
    }
    const bf16* H = WSP(bf16, WS_H); const unsigned char* TU = WSP(unsigned char, WS_TU); const unsigned char* TV = WSP(unsigned char, WS_TV);
    const int* EI = WSP(int, WS_EIDX); const float* EG = WSP(float, WS_EGATE);
    const bool fuse_n1 = (l + 1 < DEPTH) && !dry;
    LAS float* wg = (LAS float*)F.lds;
    if (fuse_n1) {
        const float* src = WSP(float, WS_WG) + (size_t)(l + 1) * 16384;
        for (int e = F.tid * 4; e < 16384; e += NTHR * 4) *(LAS f32x4*)(wg + e) = *(const f32x4*)(src + e);
        __syncthreads();
    }
    constexpr bool PREF = PG_SORT && NB == 16 && !LIDX && !PIPE;
    int pfiA = 0, pfiB = 0; float pfgA = 0.f, pfgB = 0.f; v4u pfh = {0u, 0u, 0u, 0u};
    if (PREF && gw < nrows) { const int lane = F.lane;
        pfiA = EI[(size_t)gw * 128 + lane]; pfiB = EI[(size_t)gw * 128 + 64 + lane]; pfgA = EG[(size_t)gw * 128 + lane]; pfgB = EG[(size_t)gw * 128 + 64 + lane];
        pfh = *(const v4u*)(WSP(unsigned char, WS_H8) + (size_t)gw * 1024 + lane * 16); }
    for (int rit = 0;; ++rit) {
        const int rl = F.wave + 8 * rit, row = LIDX ? brow0 + rl : gw + rit * NGW;
        if (LIDX ? rl >= rpb : row >= nrows) break;
        int lane = F.lane; asm volatile("" : "+v"(lane));
        const int myi = red16_index(lane); const unsigned lane12 = (unsigned)lane * 12u;
        float hf[16];
        unsigned kA = 0u, kB = 0u;
        { v4u w8;
          if constexpr (PREF) { w8 = pfh; kA = pick_key(pfiA, pfgA); kB = pick_key(pfiB, pfgB);
              const int nrow = row + NGW;
              if (nrow < nrows) { pfiA = EI[(size_t)nrow * 128 + lane]; pfiB = EI[(size_t)nrow * 128 + 64 + lane]; pfgA = EG[(size_t)nrow * 128 + lane]; pfgB = EG[(size_t)nrow * 128 + 64 + lane];
                  pfh = *(const v4u*)(WSP(unsigned char, WS_H8) + (size_t)nrow * 1024 + lane * 16); } }
          else w8 = *(const v4u*)(WSP(unsigned char, WS_H8) + (size_t)row * 1024 + lane * 16);
#pragma unroll
          for (int q = 0; q < 4; ++q) { const f32x2v a = __builtin_amdgcn_cvt_pk_f32_fp8((int)w8[q], false), b = __builtin_amdgcn_cvt_pk_f32_fp8((int)w8[q], true);
              hf[4 * q] = a.x; hf[4 * q + 1] = a.y; hf[4 * q + 2] = b.x; hf[4 * q + 3] = b.y; } }
        float y[16];
#pragma unroll
        for (int i = 0; i < 16; ++i) y[i] = 0.f;
        if constexpr (PIPE) {
            const int idA = EI[(size_t)row * 128 + lane], idB = EI[(size_t)row * 128 + 64 + lane]; const float gA = EG[(size_t)row * 128 + lane], gB = EG[(size_t)row * 128 + 64 + lane];
            v3u ru[16], rv[16];
#define PG_LOAD(dst, TAB, idv, lb) _Pragma("unroll") for (int i = 0; i < 16; ++i) { const int e = __builtin_amdgcn_readlane(idv, (lb) + i); const GAS unsigned* pp = srow(TAB, e, lane12); dst[i] = (v3u){pp[0], pp[1], pp[2]}; }
#define PG_MB() do { asm volatile("" ::: "memory"); SBAR(); } while (0)
#define PG_OPQ(r) asm volatile("" : "+v"(r))
            PG_LOAD(ru, TU, idA, 0);
            PG_MB();
#pragma unroll 1
            for (int kb = 0; kb < 128; kb += 16) {
                const int idv = kb < 64 ? idA : idB; const int lb = kb & 63;
                PG_LOAD(rv, TV, idv, lb);
                PG_MB();
                float p[16];
#pragma unroll
                for (int i = 0; i < 16; i += 2) { v3u r0 = ru[i], r1 = ru[i + 1]; PG_OPQ(r0); PG_OPQ(r1); const v32f a = fp6x32_to_f32(r0, r1);
                    f32x2v s0 = {0.f, 0.f}, s1 = {0.f, 0.f};
#pragma unroll
                    for (int q = 0; q < 8; ++q) { const f32x2v h2 = {hf[2 * q], hf[2 * q + 1]};
                        s0 = __builtin_elementwise_fma((f32x2v){a[2 * q], a[2 * q + 1]}, h2, s0); s1 = __builtin_elementwise_fma((f32x2v){a[16 + 2 * q], a[17 + 2 * q]}, h2, s1); }
                    p[i] = s0.x + s0.y; p[i + 1] = s1.x + s1.y; SBAR(); }
                const float act = reduce16(p, lane) * (1.0f / PEER_USCALE);
                const float myg = bperm(kb < 64 ? gA : gB, lb + myi);
                const float wv = myg * gelu_exact(act) * ABLF(l, 3) * (1.0f / PEER_VSCALE);
                PG_MB();
                if (kb + 16 < 128) { const int kn = kb + 16; const int idn = kn < 64 ? idA : idB; const int ln = kn & 63; PG_LOAD(ru, TU, idn, ln); }
                PG_MB();
#pragma unroll
                for (int i = 0; i < 16; i += 2) { const float w0 = rlane(wv, red16_lane(i)), w1 = rlane(wv, red16_lane(i + 1));
                    v3u r0 = rv[i], r1 = rv[i + 1]; PG_OPQ(r0); PG_OPQ(r1); const v32f a = fp6x32_to_f32(r0, r1);
#pragma unroll
                    for (int q = 0; q < 8; ++q) { f32x2v yy = {y[2 * q], y[2 * q + 1]};
                        yy = __builtin_elementwise_fma((f32x2v){w0, w0}, (f32x2v){a[2 * q], a[2 * q + 1]}, yy); yy = __builtin_elementwise_fma((f32x2v){w1, w1}, (f32x2v){a[16 + 2 * q], a[17 + 2 * q]}, yy);
                        y[2 * q] = yy.x; y[2 * q + 1] = yy.y; }
                    SBAR(); }
            }
#undef PG_LOAD
#undef PG_MB
#undef PG_OPQ
        } else {
        constexpr bool SORTED = PG_SORT && NB == 16 && !LIDX;
#ifndef PG_DOSORT
#define PG_DOSORT 0
#endif
        if constexpr (SORTED && PG_DOSORT) bsort128(kA, kB, lane);
#pragma unroll 1
        for (int kb = 0; kb < 128; kb += 16) {
            int mye; float myg;
            if constexpr (SORTED) { const unsigned kk = (unsigned)__builtin_amdgcn_ds_bpermute(((kb & 63) + myi) << 2, (int)(kb < 64 ? kA : kB)); mye = (int)(kk >> 16); myg = key_gate(kk); }
            else { mye = LIDX ? EIl[rl * 128 + kb + myi] : EI[(size_t)row * 128 + kb + myi]; myg = LIDX ? EGl[rl * 128 + kb + myi] : EG[(size_t)row * 128 + kb + myi]; }
            float p[16]; v3u raw[NB];
#pragma unroll
            for (int hb = 0; hb < 16; hb += NB) {
#pragma unroll
                for (int i = 0; i < NB; ++i) { const int e = __builtin_amdgcn_readlane(mye, red16_lane(hb + i)); const GAS unsigned* pp = srow(TU, e, lane12); raw[i] = (v3u){pp[0], pp[1], pp[2]}; }
                SBAR();
#pragma unroll
                for (int i = 0; i < NB; i += 2) { const v32f a = fp6x32_to_f32(raw[i], raw[i + 1]);
                    f32x2v s0 = {0.f, 0.f}, s1 = {0.f, 0.f};
#pragma unroll
                    for (int q = 0; q < 8; ++q) { const f32x2v h2 = {hf[2 * q], hf[2 * q + 1]};
                        s0 = __builtin_elementwise_fma((f32x2v){a[2 * q], a[2 * q + 1]}, h2, s0); s1 = __builtin_elementwise_fma((f32x2v){a[16 + 2 * q], a[17 + 2 * q]}, h2, s1); }
                    p[hb + i] = s0.x + s0.y; p[hb + i + 1] = s1.x + s1.y; SBAR(); } }
            const float act = reduce16(p, lane) * (1.0f / PEER_USCALE);
            const float wv = myg * gelu_exact(act) * ABLF(l, 3) * (1.0f / PEER_VSCALE);
#pragma unroll
            for (int hb = 0; hb < 16; hb += NB) {
#pragma unroll
                for (int i = 0; i < NB; ++i) { const int e = __builtin_amdgcn_readlane(mye, red16_lane(hb + i)); const GAS unsigned* pp = srow(TV, e, lane12); raw[i] = (v3u){pp[0], pp[1], pp[2]}; }
                SBAR();
#pragma unroll
                for (int i = 0; i < NB; i += 2) { const float w0 = __uint_as_float(__builtin_amdgcn_readlane(__float_as_uint(wv), red16_lane(hb + i))), w1 = __uint_as_float(__builtin_amdgcn_readlane(__float_as_uint(wv), red16_lane(hb + i + 1)));
                    const v32f a = fp6x32_to_f32(raw[i], raw[i + 1]);
#pragma unroll
                    for (int q = 0; q < 8; ++q) { f32x2v yy = {y[2 * q], y[2 * q + 1]};
                        yy = __builtin_elementwise_fma((f32x2v){w0, w0}, (f32x2v){a[2 * q], a[2 * q + 1]}, yy); yy = __builtin_elementwise_fma((f32x2v){w1, w1}, (f32x2v){a[16 + 2 * q], a[17 + 2 * q]}, yy);
                        y[2 * q] = yy.x; y[2 * q + 1] = yy.y; }
                    SBAR(); } }
        }
        }
        const bool lat = row < NLAT;
        float* xr = (lat ? F.out + (size_t)row * 1024 : WSP(float, WS_XC) + (size_t)(row - NLAT) * 1024) + lane * 16;
        const float* g2 = WSP(float, WS_MOD) + (size_t)(l * 9 + (lat ? (row >> 11) : 8)) * 6144 + 5 * 1024 + lane * 16;
        float xo[16], gg[8], xx[8];
        char* xslot = (char*)F.out + (size_t)row * 4096;
        if (lat) unpack8(*(const v4u*)(xslot + lane * 32), xx); else ld8f(xr, xx);
        ld8f(g2, gg);
#pragma unroll
        for (int q = 0; q < 8; ++q) xo[q] = xx[q] + gg[q] * y[q];
        if (lat) unpack8(*(const v4u*)(xslot + lane * 32 + 16), xx); else ld8f(xr + 8, xx);
        ld8f(g2 + 8, gg);
#pragma unroll
        for (int q = 0; q < 8; ++q) xo[8 + q] = xx[q] + gg[q] * y[8 + q];
        if (l == DEPTH - 1) {
            float ss = 0.f;
#pragma unroll
            for (int q = 0; q < 16; ++q) ss += xo[q] * xo[q];
            const float rstd = 1.0f / sqrtf(wave_sum(ss) * (1.0f / 1024.0f) + EPS);
            ld8f(F.final_g + lane * 16, gg);
#pragma unroll
            for (int q = 0; q < 8; ++q) xo[q] = xo[q] * rstd * gg[q];
            ld8f(F.final_g + lane * 16 + 8, gg);
#pragma unroll
            for (int q = 0; q < 8; ++q) xo[8 + q] = xo[8 + q] * rstd * gg[q];
        }
        if (!dry || xo[0] == 1234.567f) {
            if (lat && l != DEPTH - 1) {
                float t[8];
#pragma unroll
                for (int q = 0; q < 8; ++q) t[q] = xo[q];
                *(v4u*)(xslot + lane * 32) = pack8(t);
#pragma unroll
                for (int q = 0; q < 8; ++q) t[q] = xo[8 + q];
                *(v4u*)(xslot + lane * 32 + 16) = pack8(t);
            } else {
#pragma unroll
                for (int q = 0; q < 4; ++q) *(f32x4*)(xr + 4 * q) = (f32x4){xo[4 * q], xo[4 * q + 1], xo[4 * q + 2], xo[4 * q + 3]}; } }
        if (fuse_n1) {
            float ss = 0.f;
#pragma unroll
            for (int q = 0; q < 16; ++q) ss += xo[q] * xo[q];
            const float rstd = 1.0f / sqrtf(wave_sum(ss) * (1.0f / 1024.0f) + EPS);
            const float* gn = F.norm1_g + (l + 1) * 1024 + lane * 16;
            const float* mod = WSP(float, WS_MOD) + (size_t)((l + 1) * 9 + (lat ? (row >> 11) : 8)) * 6144 + lane * 16;
            float hh[16], sh[8], sc[8];
            ld8f(gn, gg); ld8f(mod, sh); ld8f(mod + 1024, sc);
#pragma unroll
            for (int q = 0; q < 8; ++q) hh[q] = (xo[q] * rstd * gg[q]) * (sc[q] + 1.0f) + sh[q];
            ld8f(gn + 8, gg); ld8f(mod + 8, sh); ld8f(mod + 1024 + 8, sc);
#pragma unroll
            for (int q = 0; q < 8; ++q) hh[8 + q] = (xo[8 + q] * rstd * gg[q]) * (sc[q] + 1.0f) + sh[q];
            bf16* hp = WSP(bf16, WS_H) + (size_t)row * 1024 + lane * 16;
            { v4u w8; w8.x = pk4fp8(hh[0], hh[1], hh[2], hh[3]); w8.y = pk4fp8(hh[4], hh[5], hh[6], hh[7]); w8.z = pk4fp8(hh[8], hh[9], hh[10], hh[11]); w8.w = pk4fp8(hh[12], hh[13], hh[14], hh[15]);
              *(v4u*)(WSP(unsigned char, WS_H8) + (size_t)row * 1024 + lane * 16) = w8; }
            { float t[8];
#pragma unroll
              for (int q = 0; q < 8; ++q) t[q] = hh[q];
              const v4u w0 = pack8(t);
#pragma unroll
              for (int q = 0; q < 8; ++q) t[q] = hh[8 + q];
              const v4u w1 = pack8(t);
              if (mode == 0) { *(v4u*)hp = w0; *(v4u*)(hp + 8) = w1; }
              else {
                  gu64* h8 = (gu64*)hp;
                  __hip_atomic_store(h8 + 0, ((unsigned long long)w0.y << 32) | w0.x, RLX_AGENT); __hip_atomic_store(h8 + 1, ((unsigned long long)w0.w << 32) | w0.z, RLX_AGENT);
                  __hip_atomic_store(h8 + 2, ((unsigned long long)w1.y << 32) | w1.x, RLX_AGENT); __hip_atomic_store(h8 + 3, ((unsigned long long)w1.w << 32) | w1.z, RLX_AGENT); } }
            float p[16];
#pragma unroll
            for (int jj = 0; jj < 16; ++jj) { float sacc = 0.f;
#pragma unroll
                for (int q4 = 0; q4 < 4; ++q4) { const f32x4 w = *(LAS f32x4*)(wg + jj * 1024 + lane * 16 + 4 * q4);
                    sacc += (hh[4 * q4] * w.x + hh[4 * q4 + 1] * w.y) + (hh[4 * q4 + 2] * w.z + hh[4 * q4 + 3] * w.w); }
                p[jj] = sacc; if ((jj & 3) == 3) SBAR(); }
            const float tot = reduce16(p, lane);
            if ((lane & 3) == 0) WSP(float, WS_G)[(size_t)row * 16 + myi] = tot;
            if (mode != 0) {
                asm volatile("s_waitcnt vmcnt(0)" ::: "memory");
                if (lane == 0) __hip_atomic_fetch_add((unsigned*)(F.ctl + CW_TILE + 64 * (row >> 8)), 1u, RLX_AGENT);
            }
        }
    }
}

#ifndef PG8_SP2
#define PG8_SP2 true
#endif
#ifndef PG8_ALIGN
#define PG8_ALIGN true
#endif
__device__ __forceinline__ void phase_gemm_in(Frame& F0, int l) {
    PHASE_FRAME;
    pg8::EpiZ E{(pg8::bf16_t*)WSP(bf16, WS_Z), ZW, MISCF + MISC_COS, MISCF + MISC_SIN, NLAT, QSCALE, Z8COLS / 256, ZGT / 256};
    { pg8::Gemm g{(const pg8::bf16_t*)WSP(unsigned char, WS_H8), (const pg8::bf16_t*)(WSP(unsigned char, WS_WIN) + (size_t)l * ZW * 1024), NROW, ZW, 512};
      pg8::SubOrder S; S.S.init(NROW, ZW - (ZGT - ZBG), F.G, (int)blockIdx.x); S.cut = ZBG / 256; S.skip = (ZGT - ZBG) / 256; S.base = 0;
      pg8::gemm_phase<pg8::EpiZ, pg8::SubOrder, PG8_ALIGN, PG8_SP2, true>(F.lds, g, S, E, F.wave); }
    __syncthreads();
    { pg8::Gemm g{(const pg8::bf16_t*)WSP(bf16, WS_H), (const pg8::bf16_t*)(WSP(bf16, WS_WINC) + (size_t)l * (ZGT - ZBG) * 1024) - (size_t)ZBG * 1024, NROW, ZW, 1024};
      pg8::SubOrder S; S.S.init(NROW, ZGT - ZBG, F.G, F.G - 1 - (int)blockIdx.x); S.cut = 1 << 20; S.skip = 0; S.base = ZBG / 256;
      pg8::gemm_phase<pg8::EpiZ, pg8::SubOrder, PG8_ALIGN, PG8_SP2>(F.lds, g, S, E, F.wave); }
}
#ifdef PROBE_G1
__device__ __forceinline__ void phase_gemm_in_probe(Frame& F0, int l) {
    PHASE_FRAME;
    pg8::EpiNull E{(pg8::bf16_t*)WSP(bf16, WS_Z)};
    { pg8::Gemm g{(const pg8::bf16_t*)WSP(unsigned char, WS_H8), (const pg8::bf16_t*)(WSP(unsigned char, WS_WIN) + (size_t)l * ZW * 1024), NROW, ZW, 512};
      pg8::SubOrder S; S.S.init(NROW, ZW - (ZGT - ZBG), F.G, (int)blockIdx.x); S.cut = ZBG / 256; S.skip = (ZGT - ZBG) / 256; S.base = 0;
      pg8::gemm_phase<pg8::EpiNull, pg8::SubOrder, PG8_ALIGN, PG8_SP2, true>(F.lds, g, S, E, F.wave); }
    __syncthreads();
    { pg8::Gemm g{(const pg8::bf16_t*)WSP(bf16, WS_H), (const pg8::bf16_t*)(WSP(bf16, WS_WINC) + (size_t)l * (ZGT - ZBG) * 1024) - (size_t)ZBG * 1024, NROW, ZW, 1024};
      pg8::SubOrder S; S.S.init(NROW, ZGT - ZBG, F.G, F.G - 1 - (int)blockIdx.x); S.cut = 1 << 20; S.skip = 0; S.base = ZBG / 256;
      pg8::gemm_phase<pg8::EpiNull, pg8::SubOrder, PG8_ALIGN, PG8_SP2>(F.lds, g, S, E, F.wave); }
    __syncthreads();
}
#endif
__device__ __forceinline__ void phase_gemm_merge(Frame& F0, int l) {
    PHASE_FRAME;
    const int nrows = l == 0 ? NROW : NLAT;
    const bool spread = l == 0 && F.G == 256;
    pg8::EpiMerge E{(const pg8::bf16_t*)WSP(bf16, WS_Z), (pg8::bf16_t*)WSP(bf16, WS_H), NROW / 256, ZW, ZGT, (pg8::bf16_t*)WSP(bf16, WS_ST), (unsigned*)(F.ctl + CW_TILE), spread ? NLAT / 256 : -1};
    const int ntile = spread ? 256 : (nrows / 256) * 4;
    { pg8::Gemm g{(const pg8::bf16_t*)WSP(unsigned char, WS_Y), (const pg8::bf16_t*)(WSP(unsigned char, WS_WBR) + (size_t)l * 3 * 1024 * 512 * 2), 2 * NROW, 2 * 1024, 256};
      pg8::MergeOrder S{ntile, F.G, F.vcu, NROW / 256, 2, 0, 0, spread ? 64 : 0, 256};
      pg8::gemm_phase<pg8::EpiMerge, pg8::MergeOrder, PG8_ALIGN, PG8_SP2, true>(F.lds, g, S, E, F.wave); }
    __syncthreads();
    { pg8::Gemm g{(const pg8::bf16_t*)WSP(bf16, WS_Y), (const pg8::bf16_t*)(WSP(bf16, WS_WBR) + (size_t)l * 3 * 1024 * 512), 3 * NROW, 3 * 1024, 512};
      pg8::MergeOrder S{ntile, F.G, F.vcu, NROW / 256, 1, 2, 64, spread ? 32 : 0, 256};
      pg8::gemm_phase<pg8::EpiMerge, pg8::MergeOrder, PG8_ALIGN, PG8_SP2>(F.lds, g, S, E, F.wave); }
    if (DEFER_PROLOGUE && l == 0 && F.G == 256 && F.vcu >= 32) { __syncthreads(); prologue_wqk(F, F.vcu - 32, 224); }
}
__device__ __forceinline__ void phase_gemm_out(Frame& F0, int l) {
    PHASE_FRAME;
    const int nrows = l == 0 ? NROW : NLAT;
    pg8::Gemm g{(const pg8::bf16_t*)WSP(bf16, WS_H), (const pg8::bf16_t*)(WSP(bf16, WS_WO) + (size_t)l * 1024 * 1024), nrows, 1024, 1024};
    pg8::StaticOrder S; S.init(nrows, 1024, F.G, (int)blockIdx.x);
    pg8::EpiRes E{l == 0 ? F.x : F.out, F.out, l == 0 ? F.ctx : WSP(float, WS_XC), WSP(float, WS_XC), WSP(float, WS_MOD) + (size_t)l * 9 * 6144, 2 * 1024, NLAT, l == 0};
    pg8::gemm_phase<pg8::EpiRes, pg8::StaticOrder, PG8_ALIGN, PG8_SP2>(F.lds, g, S, E, F.wave);

}
__device__ __forceinline__ void phase_gemm_peerq(Frame& F0, int l) {
    PHASE_FRAME;
    const int nrows = l == 0 ? NROW : NLAT;
    pg8::Gemm g{(const pg8::bf16_t*)WSP(unsigned char, WS_H8), (const pg8::bf16_t*)(WSP(unsigned char, WS_WQK) + (size_t)l * 2048 * 1024), nrows, 2048, 512};
    pg8::StaticOrder S; S.init(nrows, 2048, F.G, (int)blockIdx.x);
    pg8::EpiStore8 E{WSP(unsigned char, WS_SC), 2048, PEER_SQ};
    pg8::gemm_phase<pg8::EpiStore8, pg8::StaticOrder, PG8_ALIGN, PG8_SP2, true>(F.lds, g, S, E, F.wave);
    if (DEFER_PROLOGUE && l == 0 && F.G == 256 && (int)blockIdx.x >= 64) { __syncthreads();
        prologue_transposes(F, 1, ((int)blockIdx.x - 64) * NWAVES + F.wave, 192 * NWAVES);
        peer_table_convert(F, 1, (size_t)((int)blockIdx.x - 64) * NTHR + F.tid, (size_t)192 * NTHR); }
}

struct TileWaitOrder {
    int isA, blk, wave; const unsigned* ready; unsigned* tmo;
    __device__ __forceinline__ bool next(int i, pg8::Unit& u) const {
        if (isA) { if (i < 16) { const int x = blk & 7, j = blk >> 3; u.pm = 4 * i + (j >> 2); u.pn = 4 * x + (j & 3); return true; }
                   if (i == 16) { u.pm = 64 + (blk >> 5); u.pn = blk & 31; return true; } return false; }
        if (i == 0) { u.pm = 64 + (blk >> 5); u.pn = blk & 31; return true; } return false;
    }
    __device__ __forceinline__ void a_ready(const pg8::Unit& u) const {
        if (wave == 0) {
            const unsigned long long t0 = __builtin_amdgcn_s_memrealtime(); unsigned polls = 0;
            while ((unsigned)__builtin_amdgcn_readfirstlane(__hip_atomic_load(ready + 64 * u.pm, __ATOMIC_RELAXED, __HIP_MEMORY_SCOPE_AGENT)) < 256u) {
                if ((++polls & 255u) == 0u && __builtin_amdgcn_readfirstlane(__hip_atomic_load(tmo, __ATOMIC_RELAXED, __HIP_MEMORY_SCOPE_AGENT)) != 0u) break;
                if (__builtin_amdgcn_s_memrealtime() - t0 > 2000000ull) { __hip_atomic_store(tmo, 1u, __ATOMIC_RELAXED, __HIP_MEMORY_SCOPE_AGENT); break; }
                __builtin_amdgcn_s_sleep(2); }
            __builtin_amdgcn_fence(__ATOMIC_ACQUIRE, "agent");
            asm volatile("s_waitcnt vmcnt(0)" ::: "memory");
        }
        asm volatile("" ::: "memory"); __builtin_amdgcn_s_barrier(); asm volatile("" ::: "memory");
    }
    __device__ __forceinline__ void done(const pg8::Unit&) const {}
};
__device__ __forceinline__ void phase_gather_project(Frame& F0) {
    PHASE_FRAME;
    const int blk = (int)blockIdx.x;
    if (blk >= 128) { phase_peer_gather<8, false>(F, 0, false, 1); __syncthreads(); }
    pg8::Gemm g{(const pg8::bf16_t*)WSP(bf16, WS_H), (const pg8::bf16_t*)(WSP(bf16, WS_WIN) + (size_t)1 * ZW * 1024), NROW, ZW, 1024};
    TileWaitOrder S{blk < 128 ? 1 : 0, blk, F.wave, (const unsigned*)(F.ctl + CW_TILE), (unsigned*)(F.ctl + CW_TMO)};
    pg8::EpiZ E{(pg8::bf16_t*)WSP(bf16, WS_Z), ZW, MISCF + MISC_COS, MISCF + MISC_SIN, NLAT, QSCALE, Z8COLS / 256, ZGT / 256};
    pg8::gemm_phase<pg8::EpiZ, TileWaitOrder, PG8_ALIGN, PG8_SP2>(F.lds, g, S, E, F.wave);
}

#ifndef MK_ONE_LAUNCH
#define MK_ONE_LAUNCH 1
#endif
#ifndef ENMASK
#define ENMASK 0xFFFFFFFFu
#endif
#ifndef DUPMASK
#define DUPMASK 0u
#endif
#define EN(i, stmt) do { if (ENMASK & (1u << (i))) { stmt; } if (DUPMASK & (1u << (i))) { __syncthreads(); stmt; } } while (0)
constexpr int CVA = 8192, CVB = 9216;
constexpr int PH_PER_LAYER = 11, N_PHASES = 1 + DEPTH * PH_PER_LAYER;
__global__ void __launch_bounds__(NTHR, 2) fwd_kernel(Args args) {
    extern __shared__ __attribute__((aligned(16))) unsigned char lds[];
    Frame F;
    F.lds = (LAS unsigned char*)lds; F.ldsg = lds;
    F.MISC = (volatile LAS unsigned*)(F.lds + LDSCTL_OFF);
    F.tid = threadIdx.x; F.lane = F.tid & 63; F.wave = __builtin_amdgcn_readfirstlane(F.tid >> 6);
    F.G = gridDim.x; { const int bx = blockIdx.x; F.vcu = (F.G % 8 == 0) ? (bx % 8) * (F.G / 8) + bx / 8 : bx; }
    F.ws = (GAS unsigned char*)args.ws; F.out = args.out; F.ctl = (gu32*)(args.ws + WS_CTL);
    F.x = args.in[0]; F.c = args.in[1]; F.ctx = args.in[2]; F.c_ctx = args.in[3]; F.w_ada = args.in[4]; F.b_ada = args.in[5]; F.norm1_g = args.in[6]; F.norm2_g = args.in[7];
    F.w_in = args.in[8]; F.ml_gate_b = args.in[9]; F.ml_conv_w = args.in[10]; F.ml_norm_g = args.in[11]; F.cv_conv_w = args.in[12]; F.da_lam = args.in[13]; F.da_subln_g = args.in[14];
    F.w_da = args.in[15]; F.w_ml = args.in[16]; F.w_cv = args.in[17]; F.w_o = args.in[18]; F.peer_wq = args.in[19]; F.peer_keys = args.in[20]; F.peer_u = args.in[21]; F.peer_v = args.in[22];
    F.final_g = args.in[23];
    for (int u = F.tid; u < (LDS_BYTES - LDSCTL_OFF) / 4; u += NTHR) ((LAS unsigned*)(F.lds + LDSCTL_OFF))[u] = 0u;
    __syncthreads();
    XcdBarrier bar; bar.bar = (unsigned*)(F.ctl + CW_BAR); bar.x = 0; bar.st = nullptr; bar.leader = F.wave == 0;
    const int lo = args.ph_lo, hi = args.ph_hi;
#ifndef FUSE_PGG
#define FUSE_PGG 0
#endif
    const bool fusedpg = FUSE_PGG && F.G == 256;
#ifndef FUSE_PK
#define FUSE_PK 0
#endif
    const bool fusedpk = FUSE_PK && !fusedpg && F.G == 256 && (hi - lo > 1 || MK_ONE_LAUNCH);
    if (MK_ONE_LAUNCH || hi - lo > 1) bar = xcd_barrier_post((unsigned*)(F.ctl + CW_BAR), F.MISC + 8, F.tid == 0); bar.leader = F.wave == 0;
#if MK_ONE_LAUNCH
#define IN(k) true
#else
#define IN(k) (lo <= (k) && (k) < hi)
#endif
#define SEAM(k) do { if (IN(k) && IN((k) + 1)) xcd_barrier(bar); } while (0)
    if (IN(0)) { EN(0, phase_prologue(F)); } SEAM(0);
    static_assert(DEPTH == 2, "two layer bodies below");
    { constexpr int l = 0;
        constexpr int pb = 1 + l * PH_PER_LAYER;
        if (l == 0) { if (IN(pb + 0)) { EN(1, phase_norm(F, l, 0)); } SEAM(pb + 0); }
#ifdef PROBE_G1
        if (IN(pb + 1)) { phase_gemm_in_probe(F, l); }
#endif
        if (l == 0 || !fusedpg) { if (IN(pb + 1)) { EN(2, phase_gemm_in(F, l)); } SEAM(pb + 1); }
        if (IN(pb + 2)) { if (l == 1) { EN(4, phase_convbranch(F, l, 0, CVB, 0)); } EN(5, phase_ml_a(F, l)); EN(4, phase_convbranch(F, l, l == 0 ? 0 : CVB, l == 0 ? CVA : NLAT, F.G == 256 ? 64 : 0)); } SEAM(pb + 2);
        if (IN(pb + 3)) { EN(6, phase_ml_b(F)); EN(7, phase_attn(F, l)); } SEAM(pb + 3);
        if (IN(pb + 4)) { EN(8, phase_ml_c(F, l)); if (l == 0) { EN(4, phase_convbranch(F, l, CVA, NROW, F.G == 256 ? 64 : 0)); } } SEAM(pb + 4);
        if (IN(pb + 5)) { EN(9, phase_gemm_merge(F, l)); } SEAM(pb + 5);
        if (IN(pb + 6)) { EN(10, phase_gemm_out(F, l)); } SEAM(pb + 6);
        if (IN(pb + 7)) { EN(11, phase_norm(F, l, 1)); } SEAM(pb + 7);
        if (IN(pb + 8)) { EN(12, phase_gemm_peerq(F, l)); } SEAM(pb + 8);
        if (!fusedpk) { if (IN(pb + 9)) { EN(13, phase_peer_topk(F, l)); } SEAM(pb + 9); }
        if (IN(pb + 10)) { if (DUPMASK & (1u << 14)) { phase_peer_gather<8, false>(F, l, true, 0); __syncthreads(); } if (ENMASK & (1u << 14)) { if (l == 0 && fusedpg) phase_gather_project(F); else if (fusedpk) phase_peer_gather<8, true>(F, l, false, 0); else phase_peer_gather<16, false, false>(F, l, false, 0); } } SEAM(pb + 10);
    }
    { constexpr int l = 1;
        constexpr int pb = 1 + l * PH_PER_LAYER;
        if (l == 0) { if (IN(pb + 0)) { EN(1, phase_norm(F, l, 0)); } SEAM(pb + 0); }
#ifdef PROBE_G1
        if (IN(pb + 1)) { phase_gemm_in_probe(F, l); }
#endif
        if (l == 0 || !fusedpg) { if (IN(pb + 1)) { EN(2, phase_gemm_in(F, l)); } SEAM(pb + 1); }
        if (IN(pb + 2)) { if (l == 1) { EN(4, phase_convbranch(F, l, 0, CVB, 0)); } EN(5, phase_ml_a(F, l)); EN(4, phase_convbranch(F, l, l == 0 ? 0 : CVB, l == 0 ? CVA : NLAT, F.G == 256 ? 64 : 0)); } SEAM(pb + 2);
        if (IN(pb + 3)) { EN(6, phase_ml_b(F)); EN(7, phase_attn(F, l)); } SEAM(pb + 3);
        if (IN(pb + 4)) { EN(8, phase_ml_c(F, l)); if (l == 0) { EN(4, phase_convbranch(F, l, CVA, NROW, F.G == 256 ? 64 : 0)); } } SEAM(pb + 4);
        if (IN(pb + 5)) { EN(9, phase_gemm_merge(F, l)); } SEAM(pb + 5);
        if (IN(pb + 6)) { EN(10, phase_gemm_out(F, l)); } SEAM(pb + 6);
        if (IN(pb + 7)) { EN(11, phase_norm(F, l, 1)); } SEAM(pb + 7);
        if (IN(pb + 8)) { EN(12, phase_gemm_peerq(F, l)); } SEAM(pb + 8);
        if (!fusedpk) { if (IN(pb + 9)) { EN(13, phase_peer_topk(F, l)); } SEAM(pb + 9); }
        if (IN(pb + 10)) { if (DUPMASK & (1u << 14)) { phase_peer_gather<8, false>(F, l, true, 0); __syncthreads(); } if (ENMASK & (1u << 14)) { if (l == 0 && fusedpg) phase_gather_project(F); else if (fusedpk) phase_peer_gather<8, true>(F, l, false, 0); else phase_peer_gather<16, false, false>(F, l, false, 0); } } SEAM(pb + 10);
    }
#undef IN
#undef SEAM
}

extern "C" void kernel_launch(void* const* d_in, const int* in_sizes, int n_in, void* d_out, int out_size, void* d_ws, size_t ws_size, hipStream_t stream) {
    static int grid = 0;
    if (grid == 0) {
        if (n_in != 24 || in_sizes[0] != NLAT * DM || out_size != NLAT * DM || ws_size < WS_END) {
            fprintf(stderr, "kernel_launch: shape mismatch n_in %d in0 %d out %d ws %zu (need %zu)\n", n_in, n_in > 0 ? in_sizes[0] : -1, out_size, ws_size, (size_t)WS_END); grid = -1; return; }
        int dev = 0, cus = 0;
        if (hipGetDevice(&dev) != hipSuccess || hipDeviceGetAttribute(&cus, hipDeviceAttributeMultiprocessorCount, dev) != hipSuccess) { grid = -1; return; }
        if (hipFuncSetAttribute((const void*)fwd_kernel, hipFuncAttributeMaxDynamicSharedMemorySize, LDS_BYTES) != hipSuccess) { fprintf(stderr, "kernel_launch: hipFuncSetAttribute failed\n"); grid = -1; return; }
        int per_cu = 0;
        if (hipOccupancyMaxActiveBlocksPerMultiprocessor(&per_cu, (const void*)fwd_kernel, NTHR, LDS_BYTES) != hipSuccess || per_cu < 1) { fprintf(stderr, "kernel_launch: occupancy query says %d\n", per_cu); }
        (void)hipGetLastError();
        grid = cus;
    }
    if (grid < 0) return;
    (void)hipMemsetAsync((char*)d_ws + WS_CTL, 0, CTL_ZERO_BYTES, stream);
    Args a{};
    for (int i = 0; i < 24; ++i) a.in[i] = (const float*)d_in[i];
    a.out = (float*)d_out; a.ws = (unsigned char*)d_ws;
#if MK_ONE_LAUNCH
    a.ph_lo = 0; a.ph_hi = N_PHASES;
    hipLaunchKernelGGL(fwd_kernel, dim3(grid), dim3(NTHR), LDS_BYTES, stream, a);
#else
    for (int p = 0; p < N_PHASES; ++p) { a.ph_lo = p; a.ph_hi = p + 1; hipLaunchKernelGGL(fwd_kernel, dim3(grid), dim3(NTHR), LDS_BYTES, stream, a); }
#endif
    const hipError_t le = hipPeekAtLastError();
    if (le != hipSuccess) fprintf(stderr, "kernel_launch: launch failed: %s\n", hipGetErrorName(le));
}
```

```cpp
#include <hip/hip_runtime.h>
#include <cstdio>
#include <cstdint>
#include <cmath>

constexpr int DM = 1024, NBATCH = 8, SEQ = 2048, CTXL = 256, DEPTH = 2;
constexpr int NLAT = NBATCH * SEQ, NCTX = NBATCH * CTXL, NROW = NLAT + NCTX;
constexpr int DIN = 8208;
constexpr int ZW = 8192;
constexpr int ZQ = 0, ZK = 512, ZV = 1024, ZMQ = 1536, ZMK = 2048, ZMV = 2560, ZMO = 3072, ZBG = 3584, ZCG = 4096, ZXV = 4608, ZGT = 5120;
constexpr int ORIG_GATE_COL = 3584;
constexpr int PEER_HEADS = 8, PEER_NK = 128, PEER_K = 16, PEER_NEXP = 16384, PEER_HK = PEER_HEADS * PEER_K;
constexpr float EPS = 1e-6f;
constexpr float PEER_SQ = 28.0f;
constexpr float PEER_USCALE = 64.0f, PEER_VSCALE = 4.0f;
constexpr int PEER_ROWB = 768;
constexpr float QSCALE = 0.125f * 1.4426950408889634f;
constexpr int NCHUNK = 18;
constexpr int STW = 144;

constexpr size_t MiB = 1u << 20;
constexpr size_t WS_CTL = 0, CTL_ZERO_BYTES = 64 * 1024;
constexpr size_t WS_MOD = 1 * MiB;
constexpr size_t WS_MISC = WS_MOD + 512 * 1024;
constexpr size_t WS_WG = WS_MOD + 768 * 1024;
constexpr size_t WS_WIN = 2 * MiB;
constexpr size_t WS_WINC = 18 * MiB;
constexpr size_t WS_WBR = 24 * MiB;
constexpr size_t WS_WO = 30 * MiB;
constexpr size_t WS_WQK = 34 * MiB;
constexpr size_t WS_H = 52 * MiB;
constexpr size_t WS_Y = 88 * MiB;
constexpr size_t WS_XC = 142 * MiB;
constexpr size_t WS_G = 150 * MiB;
constexpr size_t WS_ST = WS_G + 1152 * 1024;
constexpr size_t WS_Z = WS_ST + 41472 * 1024;
constexpr size_t WS_H8 = WS_Z + (size_t)NROW * ZW * 2;
constexpr size_t WS_TU = WS_H8 + 18 * MiB;
constexpr size_t WS_TV = 38 * MiB;
constexpr size_t WS_END = WS_TU + 12 * MiB;
constexpr size_t WS_SC = WS_Z;
constexpr size_t WS_EIDX = WS_ST;
constexpr size_t WS_EGATE = WS_ST + 9 * MiB;
static_assert(WS_EGATE + 9 * MiB <= WS_Z && WS_TV + 12 * MiB <= WS_H && WS_WQK + 4 * MiB <= WS_TV && WS_WINC + 6 * MiB <= WS_WBR && WS_END <= 512 * MiB, "workspace map");
constexpr int MISC_LAM = 0, MISC_COS = 64, MISC_SIN = 64 + 1024, MISC_DEC = 4096;
constexpr int CW_TMO = 0, CW_CODE = 1, CW_BAR = 4096, CW_TILE = 8192;

constexpr int LDS_BYTES = 156160;
constexpr int LDSCTL_OFF = LDS_BYTES - 512;
constexpr int SCR_BYTES = LDSCTL_OFF;
constexpr int NWAVES = 8, NTHR = 512;

#ifndef DEFER_PROLOGUE
#define DEFER_PROLOGUE 0
#endif
#ifndef ABL
#define ABL 0u
#endif
#define ABLF(l, k) ((ABL >> (4 * (l) + (k))) & 1u ? 0.0f : 1.0f)
#define MK_ONE_LAUNCH 1
namespace pg8 {
#define PG8_LAS __attribute__((address_space(3)))
typedef unsigned short bf16_t;
typedef short bf16x8 __attribute__((ext_vector_type(8)));
typedef float f32x4 __attribute__((ext_vector_type(4)));
typedef unsigned u32x4 __attribute__((ext_vector_type(4)));
typedef int i32x4 __attribute__((ext_vector_type(4)));
typedef int i32x8 __attribute__((ext_vector_type(8)));
__device__ __forceinline__ float bperm_(float v, int srclane) { return __int_as_float(__builtin_amdgcn_ds_bpermute(srclane << 2, __float_as_int(v))); }
constexpr int BM = 256, BK = 64, HALF = 128, HTB = HALF * BK * 2  , STAGE_BYTES = 8 * HTB, NXCD = 8, WGM = 8;

__host__ __device__ __forceinline__ int lds_byte(int r, int c) { const int st = (r >> 4) * 2 + (c >> 5), rr = r & 15, cc = c & 31, ob = rr * 64 + cc * 2; return st * 1024 + (ob ^ (((ob >> 9) & 1) << 5)); }
__host__ __device__ __forceinline__ void stage_rc(int b, int& R, int& C) { const int st = b / 1024, sb = b % 1024, swz = sb ^ (((sb >> 9) & 1) << 5); R = (st >> 1) * 16 + swz / 64; C = (st & 1) * 32 + (swz % 64) / 2; }
__host__ __device__ __forceinline__ int perm32(int rho) { const int n = rho >> 4, i = rho & 15; return 8 * (i >> 2) + 4 * n + (i & 3); }

struct Unit { int pm, pn; };
struct Gemm { const bf16_t* A; const bf16_t* Bt; int M, N, K; };

struct StaticOrder {
    int nM, nN, nwg, G, c;
    __host__ __device__ void init(int M, int N, int G_, int c_) { nM = M / BM; nN = N / BM; nwg = nM * nN; G = G_; c = c_; }
    __host__ __device__ bool next(int i, Unit& u) const {
        const long L = (long)i * G + c; if (L >= nwg) return false;
        int wgid = (int)L; { const int q = nwg / NXCD, r = nwg % NXCD, xcd = wgid % NXCD, off = wgid / NXCD; wgid = (xcd < r ? xcd * (q + 1) : r * (q + 1) + (xcd - r) * q) + off; }
        const int nig = WGM * nN, gid = wgid / nig, fm = gid * WGM, gsz = (nM - fm) < WGM ? (nM - fm) : WGM;
        u.pm = fm + ((wgid % nig) % gsz); u.pn = (wgid % nig) / gsz; return true;
    }
    __device__ __forceinline__ void a_ready(const Unit&) const {}
    __device__ __forceinline__ void done(const Unit&) const {}
};
struct SubOrder {
    StaticOrder S; int cut, skip, base;
    __host__ __device__ bool next(int i, Unit& u) const { if (!S.next(i, u)) return false; u.pn = (u.pn < cut ? u.pn : u.pn + skip) + base; return true; }
    __device__ __forceinline__ void a_ready(const Unit&) const {}
    __device__ __forceinline__ void done(const Unit&) const {}
};
__device__ __forceinline__ unsigned cvt_pk_bf16(float lo, float hi) { unsigned r; asm volatile("v_cvt_pk_bf16_f32 %0, %1, %2" : "=v"(r) : "v"(lo), "v"(hi)); return r; }
typedef unsigned u32x2 __attribute__((ext_vector_type(2)));
typedef _Float16 f16x2 __attribute__((ext_vector_type(2)));
__device__ __forceinline__ unsigned cvt_pk_f16(float lo, float hi) { f16x2 v = {(_Float16)lo, (_Float16)hi}; return __builtin_bit_cast(unsigned, v); }
__device__ __forceinline__ float bflo(unsigned w) { return __builtin_bit_cast(float, w << 16); }
__device__ __forceinline__ float bfhi(unsigned w) { return __builtin_bit_cast(float, w & 0xffff0000u); }
__device__ __forceinline__ float sigmoidf_(float x) { return __builtin_amdgcn_rcpf(1.0f + __builtin_amdgcn_exp2f(-1.4426950408889634f * x)); }

template <bool F16> struct EpiStore16 {
    static constexpr bool PERM = true, AFTER_DRAIN = false;
    bf16_t* O; int ldc;
    __device__ __forceinline__ void operator()(const f32x4 (&acc)[2][2][4][2], const Unit& u, int wr, int wc, int fr, int fq) const {
        const int row0 = u.pm * BM + wr * 64 + fr, col0 = u.pn * BM + wc * 32 + 8 * fq;
#pragma unroll
        for (int ai = 0; ai < 2; ++ai)
#pragma unroll
            for (int m = 0; m < 4; ++m) { bf16_t* rowp = O + (size_t)(row0 + ai * HALF + m * 16) * ldc + col0;
#pragma unroll
                for (int bj = 0; bj < 2; ++bj) { const f32x4 v0 = acc[ai][bj][m][0], v1 = acc[ai][bj][m][1]; u32x4 w;
                    if (F16) { w.x = cvt_pk_f16(v0[0], v0[1]); w.y = cvt_pk_f16(v0[2], v0[3]); w.z = cvt_pk_f16(v1[0], v1[1]); w.w = cvt_pk_f16(v1[2], v1[3]); }
                    else { w.x = cvt_pk_bf16(v0[0], v0[1]); w.y = cvt_pk_bf16(v0[2], v0[3]); w.z = cvt_pk_bf16(v1[0], v1[1]); w.w = cvt_pk_bf16(v1[2], v1[3]); }
                    *(u32x4*)(rowp + bj * HALF) = w; } }
    }
};

struct EpiStore8 {
    static constexpr bool PERM = true, AFTER_DRAIN = false;
    unsigned char* O; int ldc; float scale;
    __device__ __forceinline__ unsigned q8(float v) const { return (unsigned)__builtin_amdgcn_fmed3f(__builtin_fmaf(v, scale, 128.5f), 1.0f, 255.0f); }
    __device__ __forceinline__ void operator()(const f32x4 (&acc)[2][2][4][2], const Unit& u, int wr, int wc, int fr, int fq) const {
        typedef unsigned u32x2g __attribute__((ext_vector_type(2)));
        const int row0 = u.pm * BM + wr * 64 + fr, col0 = u.pn * BM + wc * 32 + 8 * fq;
#pragma unroll
        for (int ai = 0; ai < 2; ++ai)
#pragma unroll
            for (int m = 0; m < 4; ++m) { unsigned char* rowp = O + (size_t)(row0 + ai * HALF + m * 16) * ldc + col0;
#pragma unroll
                for (int bj = 0; bj < 2; ++bj) { const f32x4 v0 = acc[ai][bj][m][0], v1 = acc[ai][bj][m][1]; u32x2g w;
                    w.x = q8(v0[0]) | (q8(v0[1]) << 8) | (q8(v0[2]) << 16) | (q8(v0[3]) << 24); w.y = q8(v1[0]) | (q8(v1[1]) << 8) | (q8(v1[2]) << 16) | (q8(v1[3]) << 24);
                    *(u32x2g*)(rowp + bj * HALF) = w; } }
    }
};
struct EpiNull {
    static constexpr bool PERM = true, AFTER_DRAIN = false;
    bf16_t* O;
    __device__ __forceinline__ void operator()(const f32x4 (&acc)[2][2][4][2], const Unit& u, int wr, int wc, int fr, int fq) const {
        f32x4 s = {0.f, 0.f, 0.f, 0.f};
#pragma unroll
        for (int ai = 0; ai < 2; ++ai)
#pragma unroll
            for (int bj = 0; bj < 2; ++bj)
#pragma unroll
                for (int m = 0; m < 4; ++m) { s += acc[ai][bj][m][0]; s += acc[ai][bj][m][1]; }
        if ((s.x + s.y) + (s.z + s.w) == 1234.567f) O[u.pm + fr] = 1;
    }
};
struct EpiZ {
    static constexpr bool PERM = true, AFTER_DRAIN = false;
    bf16_t* O; int ldc; const float* cosT; const float* sinT; int nlat; float qscale;
    int z8_pn1;
    int gate_pn0;
    __device__ __forceinline__ void operator()(const f32x4 (&acc)[2][2][4][2], const Unit& u, int wr, int wc, int fr, int fq) const {
        const int row0 = u.pm * BM + wr * 64 + fr, col0 = u.pn * BM + wc * 32 + 8 * fq;
        const bool fragmaj = u.pn >= gate_pn0; int t16_ = ((wr * 4 + wc) * 64 + fq * 16 + fr) * 16; asm volatile("" : "+v"(t16_)); const int t16 = t16_;
        const bool qk = u.pn < 4, rope = qk && (u.pm * BM < nlat);
        const float sc = u.pn < 2 ? qscale : 1.0f;
        const int isc = wc & 1, i0 = 8 * (fq & 1);
        const float sgn = fq < 2 ? -1.0f : 1.0f;
#pragma unroll
        for (int ai = 0; ai < 2; ++ai)
#pragma unroll
            for (int m = 0; m < 4; ++m) { const int row = row0 + ai * HALF + m * 16; bf16_t* rowp = O + (size_t)row * ldc + col0;
                f32x4 c0 = {1.f, 1.f, 1.f, 1.f}, c1 = c0, s0 = {0.f, 0.f, 0.f, 0.f}, s1 = s0;
                if (rope) { const int t = row & 2047, pos = isc ? (t & 63) : (t >> 6);
                    c0 = *(const f32x4*)(cosT + pos * 16 + i0); c1 = *(const f32x4*)(cosT + pos * 16 + i0 + 4);
                    s0 = *(const f32x4*)(sinT + pos * 16 + i0) * sgn; s1 = *(const f32x4*)(sinT + pos * 16 + i0 + 4) * sgn; }
#pragma unroll
                for (int bj = 0; bj < 2; ++bj) { f32x4 v0 = acc[ai][bj][m][0], v1 = acc[ai][bj][m][1];
                    if (qk) {
                        if (rope) { f32x4 p0, p1;
                            const int pl = (fq * 16 + fr) ^ 32;
                            p0.x = bperm_(v0.x, pl); p0.y = bperm_(v0.y, pl); p0.z = bperm_(v0.z, pl); p0.w = bperm_(v0.w, pl);
                            p1.x = bperm_(v1.x, pl); p1.y = bperm_(v1.y, pl); p1.z = bperm_(v1.z, pl); p1.w = bperm_(v1.w, pl);
                            v0 = v0 * c0 + p0 * s0; v1 = v1 * c1 + p1 * s1; }
                        v0 = v0 * sc; v1 = v1 * sc; }
                    if (u.pn < z8_pn1) {
                        typedef unsigned u32x2g __attribute__((ext_vector_type(2)));
                        int g0 = __builtin_amdgcn_cvt_pk_fp8_f32(v0[0], v0[1], 0, false); g0 = __builtin_amdgcn_cvt_pk_fp8_f32(v0[2], v0[3], g0, true);
                        int g1 = __builtin_amdgcn_cvt_pk_fp8_f32(v1[0], v1[1], 0, false); g1 = __builtin_amdgcn_cvt_pk_fp8_f32(v1[2], v1[3], g1, true);
                        *(u32x2g*)((char*)(O + (size_t)row * ldc + u.pn * BM) + (wc * 32 + 8 * fq + bj * HALF)) = (u32x2g){(unsigned)g0, (unsigned)g1};
                        continue; }
                    u32x4 w; w.x = cvt_pk_bf16(v0[0], v0[1]); w.y = cvt_pk_bf16(v0[2], v0[3]); w.z = cvt_pk_bf16(v1[0], v1[1]); w.w = cvt_pk_bf16(v1[2], v1[3]);
                    if (fragmaj) {
                        typedef unsigned u32x2g __attribute__((ext_vector_type(2)));
                        const int L = ((ai * 4 + m) * 2 + bj) * 4096 + (t16 >> 1);
                        int g0 = __builtin_amdgcn_cvt_pk_fp8_f32(v0[0], v0[1], 0, false); g0 = __builtin_amdgcn_cvt_pk_fp8_f32(v0[2], v0[3], g0, true);
                        int g1 = __builtin_amdgcn_cvt_pk_fp8_f32(v1[0], v1[1], 0, false); g1 = __builtin_amdgcn_cvt_pk_fp8_f32(v1[2], v1[3], g1, true);
                        *(u32x2g*)((char*)(O + (size_t)(u.pm * BM + (L >> 9)) * ldc + u.pn * BM) + (L & 511)) = (u32x2g){(unsigned)g0, (unsigned)g1}; }
                    else *(u32x4*)(rowp + bj * HALF) = w; } }
    }
};

struct EpiMerge {
    static constexpr bool PERM = true, AFTER_DRAIN = false;
    const bf16_t* Z; bf16_t* MB; int nMs, zw, zgt;
    bf16_t* scr;
    unsigned* flags; int xrow0;
    template <int DST, bool HASIN> __device__ __forceinline__ void walk(const f32x4 (&acc)[2][2][4][2], int br, int pn, int pmt, int wr, int wc, int fr, int fq) const {
        typedef __attribute__((address_space(1))) char gch; typedef __attribute__((address_space(1))) u32x4 gv4; typedef __attribute__((address_space(1))) unsigned long long gq;
        const int row0 = pmt * BM + wr * 64 + fr, col0 = pn * BM + wc * 32 + 8 * fq;
        int t16_ = ((wr * 4 + wc) * 64 + fq * 16 + fr) * 16; asm volatile("" : "+v"(t16_)); const int t16 = t16_;
        const gch* Zt = (const gch*)(Z + (size_t)(pmt * BM) * zw + zgt + br * 1024 + pn * BM);
        const unsigned gofs = (unsigned)(((t16 >> 1) >> 9) * (zw * 2) + ((t16 >> 1) & 511));
        gch* sp = (gch*)scr + (size_t)(pmt * 4 + pn) * 131072;
#pragma unroll
        for (int ai = 0; ai < 2; ++ai) {
            typedef unsigned u32x2g __attribute__((ext_vector_type(2))); typedef __attribute__((address_space(1))) u32x2g gv2;
            u32x2g gw[4][2]; u32x4 ow[4][2];
#pragma unroll
            for (int m = 0; m < 4; ++m)
#pragma unroll
                for (int bj = 0; bj < 2; ++bj) { const size_t row = (size_t)(row0 + ai * HALF + m * 16); const int col = col0 + bj * HALF; const int q = (ai * 4 + m) * 2 + bj;
                    gw[m][bj] = *(const gv2*)(Zt + (gofs + (unsigned)(q * 8 * (zw * 2))));
                    if (!HASIN) ow[m][bj] = (u32x4){0u, 0u, 0u, 0u};
                    else if (DST == 2) { const gq* qp = (const gq*)(MB + row * 1024 + col);
                        const unsigned long long q0 = __hip_atomic_load(qp, __ATOMIC_RELAXED, __HIP_MEMORY_SCOPE_AGENT), q1 = __hip_atomic_load(qp + 1, __ATOMIC_RELAXED, __HIP_MEMORY_SCOPE_AGENT);
                        ow[m][bj] = (u32x4){(unsigned)q0, (unsigned)(q0 >> 32), (unsigned)q1, (unsigned)(q1 >> 32)}; }
                    else ow[m][bj] = *(const gv4*)(sp + (unsigned)(t16 + q * 8192)); }
#pragma unroll
            for (int m = 0; m < 4; ++m)
#pragma unroll
                for (int bj = 0; bj < 2; ++bj) { const size_t row = (size_t)(row0 + ai * HALF + m * 16); const int col = col0 + bj * HALF; const int q = (ai * 4 + m) * 2 + bj;
                    const u32x2g g = gw[m][bj]; const u32x4 o = ow[m][bj]; const f32x4 v0 = acc[ai][bj][m][0], v1 = acc[ai][bj][m][1];
                    typedef float f32x2g __attribute__((ext_vector_type(2)));
                    const f32x2g ga = __builtin_amdgcn_cvt_pk_f32_fp8((int)g.x, false), gb = __builtin_amdgcn_cvt_pk_f32_fp8((int)g.x, true), gc = __builtin_amdgcn_cvt_pk_f32_fp8((int)g.y, false), gd = __builtin_amdgcn_cvt_pk_f32_fp8((int)g.y, true);
                    float r[8];
                    r[0] = v0[0] * sigmoidf_(ga.x) + bflo(o.x); r[1] = v0[1] * sigmoidf_(ga.y) + bfhi(o.x); r[2] = v0[2] * sigmoidf_(gb.x) + bflo(o.y); r[3] = v0[3] * sigmoidf_(gb.y) + bfhi(o.y);
                    r[4] = v1[0] * sigmoidf_(gc.x) + bflo(o.z); r[5] = v1[1] * sigmoidf_(gc.y) + bfhi(o.z); r[6] = v1[2] * sigmoidf_(gd.x) + bflo(o.w); r[7] = v1[3] * sigmoidf_(gd.y) + bfhi(o.w);
                    u32x4 w; w.x = cvt_pk_bf16(r[0], r[1]); w.y = cvt_pk_bf16(r[2], r[3]); w.z = cvt_pk_bf16(r[4], r[5]); w.w = cvt_pk_bf16(r[6], r[7]);
                    if (DST == 2) { gq* qp = (gq*)(MB + row * 1024 + col);
                        __hip_atomic_store(qp, ((unsigned long long)w.y << 32) | w.x, __ATOMIC_RELAXED, __HIP_MEMORY_SCOPE_AGENT); __hip_atomic_store(qp + 1, ((unsigned long long)w.w << 32) | w.z, __ATOMIC_RELAXED, __HIP_MEMORY_SCOPE_AGENT); }
                    else if (DST == 0) *(gv4*)(sp + (unsigned)(t16 + q * 8192)) = w;
                    else *(u32x4*)(MB + row * 1024 + col) = w; }
        }
    }
    __device__ __forceinline__ void operator()(const f32x4 (&acc)[2][2][4][2], const Unit& u, int wr, int wc, int fr, int fq) const {
        const int br = u.pn >> 2, pn = u.pn & 3, pmt = u.pm - br * nMs;
        const bool xt = xrow0 >= 0 && pmt >= xrow0;
        unsigned* fl = flags + 64 * ((pmt - xrow0) * 4 + pn);
        if (xt && br > 0) {
            const unsigned need = 8u * (unsigned)br; unsigned sp = 0;
            while (__hip_atomic_load(fl, __ATOMIC_RELAXED, __HIP_MEMORY_SCOPE_AGENT) < need && ++sp < (1u << 22)) __builtin_amdgcn_s_sleep(2);
        }
        if (xt) { if (br > 0) walk<2, true>(acc, br, pn, pmt, wr, wc, fr, fq); else walk<2, false>(acc, br, pn, pmt, wr, wc, fr, fq); }
        else if (br == 2) walk<1, true>(acc, br, pn, pmt, wr, wc, fr, fq);
        else if (br == 1) walk<0, true>(acc, br, pn, pmt, wr, wc, fr, fq);
        else walk<0, false>(acc, br, pn, pmt, wr, wc, fr, fq);
        if (xt && br < 2) { asm volatile("s_waitcnt vmcnt(0)" ::: "memory"); if (fr == 0 && fq == 0) __hip_atomic_fetch_add(fl, 1u, __ATOMIC_RELAXED, __HIP_MEMORY_SCOPE_AGENT); }
    }
};
struct MergeOrder {
    int ntile, G, c, nMs, nbr, br0;
    int xc0, xn, xt0;
    __device__ __forceinline__ bool next(int i, Unit& u) const {
        int t = (i / nbr) * G + c, br = br0 + i % nbr;
        if (t >= ntile) { const int nown = c < ntile ? (ntile - 1 - c) / G + 1 : 0, k = c - xc0; if (i != nown * nbr || k < 0 || k >= xn) return false; t = xt0 + k / nbr; br = br0 + k % nbr; }
        u.pm = br * nMs + (t >> 2); u.pn = br * 4 + (t & 3); return true; }
    __device__ __forceinline__ void a_ready(const Unit&) const {}
    __device__ __forceinline__ void done(const Unit&) const {}
};

struct EpiRes {
    static constexpr bool PERM = false, AFTER_DRAIN = false;
    const float* base_lat; float* dst_lat; const float* base_ctx; float* dst_ctx; const float* mod; int goff, nlat; bool base_lat_f32;
    __device__ __forceinline__ void operator()(const f32x4 (&acc)[2][2][4][2], const Unit& u, int wr, int wc, int fr, int fq) const {
        const int rowt = u.pm * BM; const bool lat = rowt < nlat;
        const float* g = mod + (lat ? (rowt >> 11) : 8) * 6144 + goff;
        const int col0 = u.pn * BM + wc * 32 + 4 * fq;
        f32x4 gv[2][2];
#pragma unroll
        for (int bj = 0; bj < 2; ++bj)
#pragma unroll
            for (int n = 0; n < 2; ++n) gv[bj][n] = *(const f32x4*)(g + col0 + bj * HALF + n * 16);
        if (lat) {
            typedef __attribute__((address_space(1))) char gch; typedef __attribute__((address_space(1))) u32x2 gv2; typedef __attribute__((address_space(1))) f32x4 gf4;
            const gch* bb = (const gch*)base_lat + (size_t)rowt * 4096; gch* db = (gch*)dst_lat + (size_t)rowt * 4096; const gch* bf = (const gch*)(base_lat + (size_t)rowt * 1024);
            int fr_ = fr; asm volatile("" : "+v"(fr_));
            const unsigned lo = (unsigned)((wr * 64 + fr_) * 4096 + col0 * 2), lo4 = (unsigned)((wr * 64 + fr_) * 4096 + col0 * 4);
#pragma unroll
            for (int ai = 0; ai < 2; ++ai) {
                f32x4 bs[4][2][2];
#pragma unroll
                for (int m = 0; m < 4; ++m)
#pragma unroll
                    for (int bj = 0; bj < 2; ++bj)
#pragma unroll
                        for (int n = 0; n < 2; ++n) { const unsigned o_ = lo + (unsigned)((ai * HALF + m * 16) * 4096 + (bj * HALF + n * 16) * 2);
                            if (base_lat_f32) bs[m][bj][n] = *(const gf4*)(bf + (lo4 + (unsigned)((ai * HALF + m * 16) * 4096 + (bj * HALF + n * 16) * 4)));
                            else { const u32x2 w = *(const gv2*)(bb + o_);
                                bs[m][bj][n] = (f32x4){__uint_as_float(w.x << 16), __uint_as_float(w.x & 0xffff0000u), __uint_as_float(w.y << 16), __uint_as_float(w.y & 0xffff0000u)}; } }
#pragma unroll
                for (int m = 0; m < 4; ++m)
#pragma unroll
                    for (int bj = 0; bj < 2; ++bj)
#pragma unroll
                        for (int n = 0; n < 2; ++n) { const unsigned o_ = lo + (unsigned)((ai * HALF + m * 16) * 4096 + (bj * HALF + n * 16) * 2); const f32x4 r = bs[m][bj][n] + gv[bj][n] * acc[ai][bj][m][n];
                            u32x2 w; w.x = cvt_pk_bf16(r[0], r[1]); w.y = cvt_pk_bf16(r[2], r[3]);
                            *(gv2*)(db + o_) = w; }
            }
            return;
        }
        {
            typedef __attribute__((address_space(1))) char gch; typedef __attribute__((address_space(1))) f32x4 gf4;
            const gch* bc = (const gch*)(base_ctx + (size_t)(rowt - nlat) * 1024); gch* dc = (gch*)(dst_ctx + (size_t)(rowt - nlat) * 1024);
            int fr_ = fr; asm volatile("" : "+v"(fr_));
            const unsigned lo4 = (unsigned)((wr * 64 + fr_) * 4096 + col0 * 4);
#pragma unroll
            for (int ai = 0; ai < 2; ++ai) {
                f32x4 bs[4][2][2];
#pragma unroll
                for (int m = 0; m < 4; ++m)
#pragma unroll
                    for (int bj = 0; bj < 2; ++bj)
#pragma unroll
                        for (int n = 0; n < 2; ++n) bs[m][bj][n] = *(const gf4*)(bc + (lo4 + (unsigned)((ai * HALF + m * 16) * 4096 + (bj * HALF + n * 16) * 4)));
#pragma unroll
                for (int m = 0; m < 4; ++m)
#pragma unroll
                    for (int bj = 0; bj < 2; ++bj)
#pragma unroll
                        for (int n = 0; n < 2; ++n) *(gf4*)(dc + (lo4 + (unsigned)((ai * HALF + m * 16) * 4096 + (bj * HALF + n * 16) * 4))) = bs[m][bj][n] + gv[bj][n] * acc[ai][bj][m][n];
            }
        }
    }
};
template <class Epi, class Sched, bool ALIGN_EPI = false, bool SP2 = false, bool FP8 = false>
__device__ __forceinline__ void gemm_phase(PG8_LAS unsigned char* lds, const Gemm g, const Sched& S, const Epi& E, int wave_id) {
    int tid_ = (int)__builtin_amdgcn_mbcnt_hi(~0u, __builtin_amdgcn_mbcnt_lo(~0u, 0u)); asm volatile("" : "+v"(tid_)); tid_ += 64 * wave_id;
    const int tid = tid_, wid = __builtin_amdgcn_readfirstlane(tid >> 6), lane = tid & 63, wr = wid >> 2, wc = wid & 3, fr = lane & 15, fq = lane >> 4;
    const int K = g.K; int nt_ = K / BK; if constexpr (FP8) asm volatile("" : "+s"(nt_)); const int nt = nt_;
    unsigned voffA[2], voffB[2];
#pragma unroll
    for (int i = 0; i < 2; ++i) { int R, C; stage_rc(tid * 16 + i * 8192, R, C); const int Rb = Epi::PERM ? ((R & ~31) + perm32(R & 31)) : R;
        voffA[i] = (unsigned)(R * K + C) * 2u; voffB[i] = (unsigned)(Rb * K + C) * 2u; }
    const size_t kstep = (size_t)(BK * 2);
    const size_t hstep = (size_t)HALF * K * 2;
    const size_t tstep = 2 * hstep;
    const unsigned ldsw = (unsigned)wid * 1024u;
    const int aoff = lds_byte(wr * 64 + fr, fq * 8), boff = lds_byte(wc * 32 + fr, fq * 8);
#define PG8_SA(b, h) (((b) * 2 + (h)) * HTB)
#define PG8_SB(b, h) ((4 + (b) * 2 + (h)) * HTB)
#define PG8_STAGE(bufoff, gbase, voff) do { _Pragma("unroll") for (int _i = 0; _i < 2; ++_i) \
        __builtin_amdgcn_global_load_lds((const unsigned*)((const char*)(gbase) + (voff)[_i]), (PG8_LAS unsigned*)(lds + (bufoff) + ldsw + _i * 8192), 16, 0, 0); } while (0)
#define PG8_LDA(dst, b, h) do { _Pragma("unroll") for (int m = 0; m < 4; ++m) _Pragma("unroll") for (int k = 0; k < 2; ++k) dst[m][k] = *(const PG8_LAS bf16x8*)(lds + PG8_SA(b, h) + aoff + m * 2048 + k * 1024); } while (0)
#define PG8_LDB(dst, b, h) do { _Pragma("unroll") for (int n = 0; n < 2; ++n) _Pragma("unroll") for (int k = 0; k < 2; ++k) dst[n][k] = *(const PG8_LAS bf16x8*)(lds + PG8_SB(b, h) + boff + n * 2048 + k * 1024); } while (0)
#define PG8_MMA(ai, bj, At, Bt) do { __builtin_amdgcn_s_setprio(1); _Pragma("unroll") for (int m = 0; m < 4; ++m) _Pragma("unroll") for (int n = 0; n < 2; ++n) { \
        if constexpr (FP8) { const i32x8 wv = __builtin_shufflevector(__builtin_bit_cast(i32x4, Bt[n][0]), __builtin_bit_cast(i32x4, Bt[n][1]), 0, 1, 2, 3, 4, 5, 6, 7); \
            const i32x8 av = __builtin_shufflevector(__builtin_bit_cast(i32x4, At[m][0]), __builtin_bit_cast(i32x4, At[m][1]), 0, 1, 2, 3, 4, 5, 6, 7); \
            asm volatile("v_mfma_scale_f32_16x16x128_f8f6f4 %0, %1, %2, %0, %3, %4 op_sel_hi:[0,0,0]" : "+v"(acc[ai][bj][m][n]) : "v"(wv), "v"(av), "v"(0x79797979), "v"(0x7f7f7f7f)); } \
        else { _Pragma("unroll") for (int k = 0; k < 2; ++k) acc[ai][bj][m][n] = __builtin_amdgcn_mfma_f32_16x16x32_bf16(Bt[n][k], At[m][k], acc[ai][bj][m][n], 0, 0, 0); } } \
        __builtin_amdgcn_s_setprio(0); } while (0)
#define PG8_WAIT_V(n) asm volatile("s_waitcnt vmcnt(" #n ")" ::: "memory")
#define PG8_WAIT_L(n) asm volatile("s_waitcnt lgkmcnt(" #n ")" ::: "memory")
#define PG8_BAR __builtin_amdgcn_s_barrier()
#define PG8_SCHED __builtin_amdgcn_sched_barrier(0)
    Unit cur, nxt; int ui = 0;
    if (!S.next(0, cur)) return;
    f32x4 acc[2][2][4][2];
#pragma unroll
    for (int a = 0; a < 2; ++a)
#pragma unroll
        for (int b = 0; b < 2; ++b)
#pragma unroll
            for (int m = 0; m < 4; ++m)
#pragma unroll
                for (int n = 0; n < 2; ++n) acc[a][b][m][n] = (f32x4){0.f, 0.f, 0.f, 0.f};
    bf16x8 At[4][2], B0[2][2], B1[2][2];
    const char* cA = (const char*)g.A + (size_t)cur.pm * tstep; const char* cB = (const char*)g.Bt + (size_t)cur.pn * tstep;
    S.a_ready(cur);
    if constexpr (SP2) {
        PG8_STAGE(PG8_SB(0, 0), cB, voffB); PG8_STAGE(PG8_SB(0, 1), cB + hstep, voffB); PG8_STAGE(PG8_SA(0, 0), cA, voffA); PG8_STAGE(PG8_SA(0, 1), cA + hstep, voffA);
        if (wr == 1) PG8_BAR;
        PG8_WAIT_V(2); PG8_BAR;
        PG8_STAGE(PG8_SB(1, 0), cB + kstep, voffB); PG8_STAGE(PG8_SA(1, 0), cA + kstep, voffA); PG8_STAGE(PG8_SB(1, 1), cB + hstep + kstep, voffB);
        PG8_WAIT_V(6); PG8_BAR;
    } else {
        PG8_STAGE(PG8_SB(0, 0), cB, voffB); PG8_STAGE(PG8_SA(0, 0), cA, voffA); PG8_STAGE(PG8_SB(0, 1), cB + hstep, voffB); PG8_STAGE(PG8_SA(0, 1), cA + hstep, voffA);
        if (wr == 1) PG8_BAR;
        PG8_WAIT_V(4); PG8_BAR;
        PG8_STAGE(PG8_SB(1, 0), cB + kstep, voffB); PG8_STAGE(PG8_SA(1, 0), cA + kstep, voffA); PG8_STAGE(PG8_SB(1, 1), cB + hstep + kstep, voffB);
        PG8_WAIT_V(6); PG8_BAR;
    }
    for (;;) {
        const bool has_next = S.next(ui + 1, nxt);
        const char* nA = has_next ? (const char*)g.A + (size_t)nxt.pm * tstep : cA; const char* nB = has_next ? (const char*)g.Bt + (size_t)nxt.pn * tstep : cB;
#pragma unroll 1
        for (int t = 0; t < nt; t += 2) {
            const bool last = (t == nt - 2);
            const char* a1 = cA + (size_t)(t + 1) * kstep;
            const char* a2 = last ? nA : cA + (size_t)(t + 2) * kstep; const char* b2 = last ? nB : cB + (size_t)(t + 2) * kstep;
            const char* a3 = a2 + kstep; const char* b3 = b2 + kstep;
            if (last && has_next) S.a_ready(nxt);
            if constexpr (SP2) {
            PG8_LDB(B0, 0, 0); PG8_LDB(B1, 0, 1); PG8_SCHED; PG8_LDA(At, 0, 0); PG8_STAGE(PG8_SA(1, 1), a1 + hstep, voffA);
            PG8_WAIT_V(8); PG8_WAIT_L(0); PG8_BAR; PG8_MMA(0, 0, At, B0); PG8_MMA(0, 1, At, B1); PG8_BAR; PG8_SCHED;
            PG8_LDA(At, 0, 1); PG8_STAGE(PG8_SB(0, 0), b2, voffB); PG8_STAGE(PG8_SB(0, 1), b2 + hstep, voffB); PG8_STAGE(PG8_SA(0, 0), a2, voffA);
            PG8_WAIT_V(8); PG8_WAIT_L(0); PG8_BAR; PG8_MMA(1, 0, At, B0); PG8_MMA(1, 1, At, B1); PG8_BAR; PG8_SCHED;
            PG8_LDB(B0, 1, 0); PG8_LDB(B1, 1, 1); PG8_SCHED; PG8_LDA(At, 1, 0); PG8_STAGE(PG8_SA(0, 1), a2 + hstep, voffA);
            PG8_WAIT_V(8); PG8_WAIT_L(0); PG8_BAR; PG8_MMA(0, 0, At, B0); PG8_MMA(0, 1, At, B1); PG8_BAR; PG8_SCHED;
            PG8_LDA(At, 1, 1); PG8_STAGE(PG8_SB(1, 0), b3, voffB); PG8_STAGE(PG8_SB(1, 1), b3 + hstep, voffB); PG8_STAGE(PG8_SA(1, 0), a3, voffA);
            PG8_WAIT_V(8); PG8_WAIT_L(0); PG8_BAR; PG8_MMA(1, 0, At, B0); PG8_MMA(1, 1, At, B1); PG8_BAR; PG8_SCHED;
            } else {
            PG8_LDB(B0, 0, 0); PG8_SCHED; PG8_LDA(At, 0, 0); PG8_STAGE(PG8_SA(1, 1), a1 + hstep, voffA);
            PG8_WAIT_L(8); PG8_BAR; PG8_WAIT_L(0); PG8_MMA(0, 0, At, B0); PG8_BAR; PG8_SCHED;
            PG8_LDB(B1, 0, 1); PG8_STAGE(PG8_SB(0, 0), b2, voffB);
            PG8_BAR; PG8_WAIT_L(0); PG8_MMA(0, 1, At, B1); PG8_BAR;
            PG8_LDA(At, 0, 1); PG8_STAGE(PG8_SA(0, 0), a2, voffA);
            PG8_BAR; PG8_WAIT_L(0); PG8_MMA(1, 0, At, B0); PG8_BAR; PG8_SCHED;
            PG8_STAGE(PG8_SB(0, 1), b2 + hstep, voffB);
            PG8_WAIT_V(6); PG8_BAR; PG8_MMA(1, 1, At, B1); PG8_BAR;
            PG8_LDB(B0, 1, 0); PG8_SCHED; PG8_LDA(At, 1, 0); PG8_STAGE(PG8_SA(0, 1), a2 + hstep, voffA);
            PG8_WAIT_L(8); PG8_BAR; PG8_WAIT_L(0); PG8_MMA(0, 0, At, B0); PG8_BAR; PG8_SCHED;
            PG8_LDB(B1, 1, 1); PG8_STAGE(PG8_SB(1, 0), b3, voffB);
            PG8_BAR; PG8_WAIT_L(0); PG8_MMA(0, 1, At, B1); PG8_BAR;
            PG8_LDA(At, 1, 1); PG8_STAGE(PG8_SA(1, 0), a3, voffA);
            PG8_BAR; PG8_WAIT_L(0); PG8_MMA(1, 0, At, B0); PG8_BAR; PG8_SCHED;
            PG8_STAGE(PG8_SB(1, 1), b3 + hstep, voffB);
            PG8_WAIT_V(6); PG8_BAR; PG8_MMA(1, 1, At, B1); PG8_BAR;
            }
        }
        if constexpr (FP8) asm volatile("s_nop 15\n\ts_nop 7" ::: "memory");
        if constexpr (ALIGN_EPI) { if (wr == 0) PG8_BAR; }
        if constexpr (!Epi::AFTER_DRAIN) { E(acc, cur, wr, wc, fr, fq); S.done(cur); }
        if (!has_next) break;
#pragma unroll
        for (int a = 0; a < 2; ++a)
#pragma unroll
            for (int b = 0; b < 2; ++b)
#pragma unroll
                for (int m = 0; m < 4; ++m)
#pragma unroll
                    for (int n = 0; n < 2; ++n) acc[a][b][m][n] = (f32x4){0.f, 0.f, 0.f, 0.f};
        cur = nxt; cA = nA; cB = nB; ++ui;
        if constexpr (ALIGN_EPI) { if (wr == 1) PG8_BAR; }
    }
    PG8_WAIT_V(0);
    if constexpr (!ALIGN_EPI) { if (wr == 0) PG8_BAR; }
    PG8_BAR;
    if constexpr (Epi::AFTER_DRAIN) { E.fused(acc, cur, wr, wc, fr, fq, lds, wid, lane); S.done(cur); }
#undef PG8_SA
#undef PG8_SB
#undef PG8_STAGE
#undef PG8_LDA
#undef PG8_LDB
#undef PG8_MMA
#undef PG8_WAIT_V
#undef PG8_WAIT_L
#undef PG8_BAR
#undef PG8_SCHED
}
}
#define GAS __attribute__((address_space(1)))
#define LAS __attribute__((address_space(3)))
typedef unsigned short bf16;
typedef unsigned v4u __attribute__((ext_vector_type(4)));
typedef float f32x4 __attribute__((ext_vector_type(4)));
typedef short bf16x8 __attribute__((ext_vector_type(8)));
typedef GAS unsigned gu32;
typedef GAS unsigned long long gu64;
#define RLX_AGENT __ATOMIC_RELAXED, __HIP_MEMORY_SCOPE_AGENT
#define LDS_WAIT() asm volatile("s_waitcnt lgkmcnt(0)" ::: "memory")
#define VM_WAIT() asm volatile("s_waitcnt vmcnt(0)" ::: "memory")
__device__ __forceinline__ unsigned long long rt() { return __builtin_amdgcn_s_memrealtime(); }
__device__ __forceinline__ unsigned f2bf(float f) { unsigned u = __builtin_bit_cast(unsigned, f); return (u + 0x7fffu + ((u >> 16) & 1u)) >> 16; }
__device__ __forceinline__ unsigned pk2(float lo, float hi) { return f2bf(lo) | (f2bf(hi) << 16); }
template <int PAT> __device__ __forceinline__ float swz(float v) { return __int_as_float(__builtin_amdgcn_ds_swizzle(__float_as_int(v), PAT)); }
__device__ __forceinline__ float bperm(float v, int srclane) { return __int_as_float(__builtin_amdgcn_ds_bpermute(srclane << 2, __float_as_int(v))); }
__device__ __forceinline__ float rlane(float v, int l) { return __int_as_float(__builtin_amdgcn_readlane(__float_as_int(v), l)); }
constexpr int Z8COLS = 3584;
__device__ __forceinline__ size_t z8off(size_t row, int col) { return row * (size_t)(ZW * 2) + (size_t)(col + (col & ~255)); }
__device__ __forceinline__ const unsigned char* z8p(const bf16* Z, size_t row, int col) { return (const unsigned char*)Z + z8off(row, col); }
typedef float f32x2p __attribute__((ext_vector_type(2)));
typedef unsigned u32x2z __attribute__((ext_vector_type(2)));
__device__ __forceinline__ v4u fp8x8_bf16(const u32x2z w) {
    const f32x2p a = __builtin_amdgcn_cvt_pk_f32_fp8((int)w.x, false), b = __builtin_amdgcn_cvt_pk_f32_fp8((int)w.x, true), c = __builtin_amdgcn_cvt_pk_f32_fp8((int)w.y, false), d = __builtin_amdgcn_cvt_pk_f32_fp8((int)w.y, true);
    v4u r; r.x = (__float_as_uint(a.x) >> 16) | (__float_as_uint(a.y) & 0xffff0000u); r.y = (__float_as_uint(b.x) >> 16) | (__float_as_uint(b.y) & 0xffff0000u);
    r.z = (__float_as_uint(c.x) >> 16) | (__float_as_uint(c.y) & 0xffff0000u); r.w = (__float_as_uint(d.x) >> 16) | (__float_as_uint(d.y) & 0xffff0000u); return r; }
__device__ __forceinline__ v4u ldz8(const unsigned char* p) { return fp8x8_bf16(*(const u32x2z*)p); }
__device__ __forceinline__ unsigned fp6code(float x) {
    const float a = fminf(fabsf(x), 7.5f);
    const float sc = a < 2.f ? 8.f : (a < 4.f ? 4.f : 2.f), k = a < 2.f ? 0.f : (a < 4.f ? 8.f : 16.f);
    return (unsigned)(k + rintf(a * sc)) | ((__float_as_uint(x) >> 26) & 32u);
}
__device__ __forceinline__ float clamp240(float x) { return fminf(fmaxf(x, -240.f), 240.f); }
__device__ __forceinline__ unsigned pk4fp8(float a, float b, float c, float d) { int pk = __builtin_amdgcn_cvt_pk_fp8_f32(clamp240(a), clamp240(b), 0, false); pk = __builtin_amdgcn_cvt_pk_fp8_f32(clamp240(c), clamp240(d), pk, true); return (unsigned)pk; }
__device__ __forceinline__ unsigned f2fp8(float a) { return (unsigned)__builtin_amdgcn_cvt_pk_fp8_f32(clamp240(a), 0.f, 0, false) & 0xffu; }
#define XB_TMO      128
#define XB_XCNT(j)  (256  + 64 * (j))
#define XB_XSUB(j)  (1280 + 64 * (j))
#define XB_XGEN(j)  (2304 + 64 * (j))
#define XB_TOP      3328
#define XB_TOPGEN   3392
#define XCD_BAR_WORDS 3456
#define XB_SPIN_CAP (1u << 18)

__device__ __forceinline__ unsigned xb_ld(unsigned* p)              { return __hip_atomic_load(p, __ATOMIC_RELAXED, __HIP_MEMORY_SCOPE_AGENT); }
__device__ __forceinline__ unsigned xb_add(unsigned* p, unsigned v) { return __hip_atomic_fetch_add(p, v, __ATOMIC_RELAXED, __HIP_MEMORY_SCOPE_AGENT); }
__device__ __forceinline__ unsigned xb_xcc_id() { return (unsigned)__builtin_amdgcn_s_getreg((3 << 11) | 20) & 0xFu; }
#define XB_SPIN(cond, bar) do { unsigned _sp = 0; while (cond) { __builtin_amdgcn_s_sleep(1); \
    if ((++_sp & 255u) == 0u) { if (xb_ld(&(bar)[XB_TMO])) break; if (_sp > XB_SPIN_CAP) { atomicAdd(&(bar)[XB_TMO], 1u); break; } } } } while (0)

struct XcdBarrier {
    bool leader;
    unsigned* bar; unsigned x;
    volatile LAS unsigned* st;
};

__device__ __forceinline__ XcdBarrier xcd_barrier_post(unsigned* bar, volatile LAS unsigned* st, bool leader) {
    XcdBarrier b; b.bar = bar; b.x = xb_xcc_id(); b.st = st; b.leader = leader;
    if (leader) (void)xb_add(&bar[XB_XCNT(b.x)], 1u);
    return b;
}
__device__ __forceinline__ void xcd_barrier_complete(unsigned* bar, unsigned x, unsigned& nloc, unsigned& nx) {
    const unsigned G = gridDim.x * gridDim.y * gridDim.z;
    unsigned sum, cnt, mine, sp = 0u;
    for (;;) {
        sum = 0u; cnt = 0u; mine = 0u;
#pragma unroll
        for (unsigned j = 0; j < 16; ++j) { const unsigned c = xb_ld(&bar[XB_XCNT(j)]); sum += c; cnt += (c > 0u) ? 1u : 0u; mine = (j == x) ? c : mine; }
        if (sum == G) break;
        __builtin_amdgcn_s_sleep(1);
        if ((++sp & 255u) == 0u) { if (xb_ld(&bar[XB_TMO])) break; if (sp > XB_SPIN_CAP) { atomicAdd(&bar[XB_TMO], 1u); break; } }
    }
    nloc = mine > 0u ? mine : 1u; nx = cnt > 0u ? cnt : 1u;
}

__device__ __forceinline__ void xcd_barrier(const XcdBarrier& b) {
    asm volatile("s_waitcnt vmcnt(0)" ::: "memory");
    __syncthreads();
    if ((int)__builtin_amdgcn_mbcnt_hi(~0u, __builtin_amdgcn_mbcnt_lo(~0u, 0u)) == 0 && b.leader) {
        unsigned* bar = b.bar; asm volatile("" : "+s"(bar));
        unsigned bx = b.x; asm volatile("" : "+s"(bx));
        __builtin_amdgcn_s_waitcnt(0);
        unsigned nloc = b.st[0], nx = b.st[1];
        if (nloc == 0u) { xcd_barrier_complete(bar, bx, nloc, nx); b.st[0] = nloc; b.st[1] = nx; }
        const unsigned old = xb_add(&bar[XB_XSUB(bx)], 1u);
        const unsigned gen = old / nloc;
        if (old + 1u == (gen + 1u) * nloc) {
            __builtin_amdgcn_fence(__ATOMIC_RELEASE, "agent");
            asm volatile("s_waitcnt vmcnt(0)" ::: "memory");
            const unsigned og = xb_add(&bar[XB_TOP], 1u);
            const unsigned tg = og / nx;
            if (og + 1u == (tg + 1u) * nx) xb_add(&bar[XB_TOPGEN], 1u);
            else XB_SPIN(xb_ld(&bar[XB_TOPGEN]) == tg, bar);
            __builtin_amdgcn_fence(__ATOMIC_ACQUIRE, "agent");
            xb_add(&bar[XB_XGEN(bx)], 1u);
            asm volatile("s_waitcnt vmcnt(0)" ::: "memory");
        } else {
            XB_SPIN(xb_ld(&bar[XB_XGEN(bx)]) == gen, bar);
            __builtin_amdgcn_fence(__ATOMIC_ACQUIRE, "agent");
            asm volatile("s_waitcnt vmcnt(0)" ::: "memory");
        }
    }
    __syncthreads();
}

typedef float f32x16 __attribute__((ext_vector_type(16)));
typedef short s16x4 __attribute__((ext_vector_type(4)));
typedef unsigned u32x2 __attribute__((ext_vector_type(2)));
using pg8::bflo; using pg8::bfhi; using pg8::sigmoidf_;

struct Args { const float* in[24]; float* out; unsigned char* ws; int ph_lo, ph_hi; };

struct Frame {
    LAS unsigned char* lds;
    unsigned char* ldsg;
    volatile LAS unsigned* MISC;
    gu32* ctl;
    int tid, lane, wave, vcu, G;
    const float* const* in_dummy;
    GAS unsigned char* ws; float* out;
    const float *x, *c, *ctx, *c_ctx, *w_ada, *b_ada, *norm1_g, *norm2_g, *w_in, *ml_gate_b, *ml_conv_w, *ml_norm_g, *cv_conv_w, *da_lam, *da_subln_g,
                *w_da, *w_ml, *w_cv, *w_o, *peer_wq, *peer_keys, *peer_u, *peer_v, *final_g;
};

#define PHASE_FRAME Frame F = F0; { int l_ = (int)__builtin_amdgcn_mbcnt_hi(~0u, __builtin_amdgcn_mbcnt_lo(~0u, 0u)); asm volatile("" : "+v"(l_)); int wv_ = F0.wave; asm volatile("" : "+s"(wv_)); F.wave = wv_; F.lane = l_; F.tid = wv_ * 64 + l_; GAS unsigned char* w_ = F0.ws; asm volatile("" : "+s"(w_)); F.ws = w_; \
    const __attribute__((address_space(4))) Args* ap_ = (const __attribute__((address_space(4))) Args*)__builtin_amdgcn_kernarg_segment_ptr(); asm volatile("" : "+s"(ap_)); \
    F.x = ap_->in[0]; F.c = ap_->in[1]; F.ctx = ap_->in[2]; F.c_ctx = ap_->in[3]; F.w_ada = ap_->in[4]; F.b_ada = ap_->in[5]; F.norm1_g = ap_->in[6]; F.norm2_g = ap_->in[7]; F.w_in = ap_->in[8]; F.ml_gate_b = ap_->in[9]; \
    F.ml_conv_w = ap_->in[10]; F.ml_norm_g = ap_->in[11]; F.cv_conv_w = ap_->in[12]; F.da_lam = ap_->in[13]; F.da_subln_g = ap_->in[14]; F.w_da = ap_->in[15]; F.w_ml = ap_->in[16]; F.w_cv = ap_->in[17]; F.w_o = ap_->in[18]; \
    F.peer_wq = ap_->in[19]; F.peer_keys = ap_->in[20]; F.peer_u = ap_->in[21]; F.peer_v = ap_->in[22]; F.final_g = ap_->in[23]; F.out = ap_->out; }
__device__ __forceinline__ float wave_sum(float v) {
    v += swz<0x041F>(v); v += swz<0x081F>(v); v += swz<0x101F>(v); v += swz<0x201F>(v); v += swz<0x401F>(v);
    return rlane(v, 0) + rlane(v, 32);
}
__device__ __forceinline__ float wave_max(float v) {
    v = fmaxf(v, swz<0x041F>(v)); v = fmaxf(v, swz<0x081F>(v)); v = fmaxf(v, swz<0x101F>(v)); v = fmaxf(v, swz<0x201F>(v)); v = fmaxf(v, swz<0x401F>(v));
    return fmaxf(rlane(v, 0), rlane(v, 32));
}
__device__ __forceinline__ float reduce16(const float (&p)[16], int lane) {
    float q8[8], q4[4], q2[2];
    { const bool up = (lane & 32) != 0;
#pragma unroll
      for (int i = 0; i < 8; ++i) { const float keep = up ? p[i + 8] : p[i], send = up ? p[i] : p[i + 8]; q8[i] = keep + bperm(send, lane ^ 32); } }
    { const bool up = (lane & 16) != 0;
#pragma unroll
      for (int i = 0; i < 4; ++i) { const float keep = up ? q8[i + 4] : q8[i], send = up ? q8[i] : q8[i + 4]; q4[i] = keep + swz<0x401F>(send); } }
    { const bool up = (lane & 8) != 0;
#pragma unroll
      for (int i = 0; i < 2; ++i) { const float keep = up ? q4[i + 2] : q4[i], send = up ? q4[i] : q4[i + 2]; q2[i] = keep + swz<0x201F>(send); } }
    float v;
    { const bool up = (lane & 4) != 0; const float keep = up ? q2[1] : q2[0], send = up ? q2[0] : q2[1]; v = keep + swz<0x101F>(send); }
    v += swz<0x081F>(v); v += swz<0x041F>(v);
    return v;
}
__device__ __forceinline__ int red16_index(int lane) { return ((lane >> 5) & 1) * 8 + ((lane >> 4) & 1) * 4 + ((lane >> 3) & 1) * 2 + ((lane >> 2) & 1); }
__device__ __forceinline__ int red16_lane(int e) { return ((e >> 3) & 1) * 32 + ((e >> 2) & 1) * 16 + ((e >> 1) & 1) * 8 + (e & 1) * 4; }

__device__ __forceinline__ float siluf_(float x) { return x / (1.0f + __expf(-x)); }
__device__ __forceinline__ float bf2f(bf16 b) { return __builtin_bit_cast(float, (unsigned)b << 16); }
__device__ __forceinline__ float log_sigmoidf_(float x) { return fminf(x, 0.f) - log1pf(__expf(-fabsf(x))); }
__device__ __forceinline__ float gelu_exact(float v) { return 0.5f * v * (1.0f + erff(v * 0.70710678118654752f)); }
__device__ __forceinline__ void unpack8(const v4u w, float (&f)[8]) {
    f[0] = bflo(w.x); f[1] = bfhi(w.x); f[2] = bflo(w.y); f[3] = bfhi(w.y); f[4] = bflo(w.z); f[5] = bfhi(w.z); f[6] = bflo(w.w); f[7] = bfhi(w.w);
}
__device__ __forceinline__ void ld8f(const float* p, float (&f)[8]) { const f32x4 a = *(const f32x4*)p, b = *(const f32x4*)(p + 4); f[0] = a.x; f[1] = a.y; f[2] = a.z; f[3] = a.w; f[4] = b.x; f[5] = b.y; f[6] = b.z; f[7] = b.w; }
__device__ __forceinline__ v4u pack8(const float (&f)[8]) { v4u w; w.x = pk2(f[0], f[1]); w.y = pk2(f[2], f[3]); w.z = pk2(f[4], f[5]); w.w = pk2(f[6], f[7]); return w; }

__device__ __forceinline__ void transpose_item(const float* W, int ldw, int k0, int nsrc0, bf16* WT, int K, int ndst0, LAS float* scr, int lane) {
#pragma unroll 8
    for (int i = 0; i < 32; ++i) { const int kk = 2 * i + (lane >> 5); scr[kk * 33 + (lane & 31)] = W[(size_t)(k0 + kk) * ldw + nsrc0 + (lane & 31)]; }
    LDS_WAIT(); asm volatile("" ::: "memory");
    const int c = lane & 7;
#pragma unroll
    for (int j = 0; j < 4; ++j) { const int n = (lane >> 3) + 8 * j; const LAS float* s = scr + (8 * c) * 33 + n;
        v4u o; o.x = pk2(s[0 * 33], s[1 * 33]); o.y = pk2(s[2 * 33], s[3 * 33]); o.z = pk2(s[4 * 33], s[5 * 33]); o.w = pk2(s[6 * 33], s[7 * 33]);
        *(GAS v4u*)(WT + (size_t)(ndst0 + n) * K + k0 + 8 * c) = o; }
    LDS_WAIT(); asm volatile("" ::: "memory");
}
__device__ __forceinline__ void transpose_item8(const float* W, int ldw, int k0, int nsrc0, unsigned char* WT, int K, int ndst0, LAS float* scr, int lane) {
#pragma unroll 8
    for (int i = 0; i < 32; ++i) { const int kk = 2 * i + (lane >> 5); scr[kk * 33 + (lane & 31)] = W[(size_t)(k0 + kk) * ldw + nsrc0 + (lane & 31)]; }
    LDS_WAIT(); asm volatile("" ::: "memory");
    const int c = lane & 7;
#pragma unroll
    for (int j = 0; j < 4; ++j) { const int n = (lane >> 3) + 8 * j; const LAS float* s = scr + (8 * c) * 33 + n;
        u32x2 o; o.x = pk4fp8(s[0 * 33] * 64.f, s[1 * 33] * 64.f, s[2 * 33] * 64.f, s[3 * 33] * 64.f); o.y = pk4fp8(s[4 * 33] * 64.f, s[5 * 33] * 64.f, s[6 * 33] * 64.f, s[7 * 33] * 64.f);
        *(GAS u32x2*)(WT + (size_t)(ndst0 + n) * K + k0 + 8 * c) = o; }
    LDS_WAIT(); asm volatile("" ::: "memory");
}

#define WSP(T, off) ((T*)(GAS T*)(F.ws + (off)))
#define MISCF (WSP(float, WS_MISC))

__device__ __forceinline__ void prologue_wqk(Frame& F, int first, int stride) {
    constexpr int LS = 132;
    LAS float* keysS = (LAS float*)F.lds;
    LAS float* wqS = keysS + 128 * LS;
    f32x4 tk[8], tw[4];
#define WQK_LOAD(it_) do { const int l_ = (it_) >> 8, hp_ = ((it_) >> 4) & 15, kb_ = (it_) & 15; \
        const float* keys_ = F.peer_keys + ((size_t)l_ * 16 + hp_) * 16384; const float* wq_ = F.peer_wq + (size_t)l_ * 1024 * 2048 + (size_t)(kb_ * 64) * 2048 + hp_ * 128; \
        _Pragma("unroll") for (int i = 0; i < 8; ++i) tk[i] = *(const f32x4*)(keys_ + 4 * (F.tid + 512 * i)); \
        _Pragma("unroll") for (int i = 0; i < 4; ++i) { const int e4 = F.tid + 512 * i; tw[i] = *(const f32x4*)(wq_ + (size_t)(e4 >> 5) * 2048 + 4 * (e4 & 31)); } } while (0)
    if (first < 512) WQK_LOAD(first);
    for (int it = first; it < 512; it += stride) {
        const int l = it >> 8, hp = (it >> 4) & 15, kb = it & 15;
#pragma unroll
        for (int i = 0; i < 8; ++i) { const int e4 = F.tid + 512 * i; *(LAS f32x4*)(keysS + (e4 >> 5) * LS + 4 * (e4 & 31)) = tk[i]; }
#pragma unroll
        for (int i = 0; i < 4; ++i) { const int e4 = F.tid + 512 * i; *(LAS f32x4*)(wqS + (e4 >> 5) * LS + 4 * (e4 & 31)) = tw[i]; }
        __syncthreads();
        if (it + stride < 512) WQK_LOAD(it + stride);
        const int r32 = F.lane & 31, hi = F.lane >> 5, kt = F.wave & 1, nt = F.wave >> 1;
        f32x16 acc;
#pragma unroll
        for (int r = 0; r < 16; ++r) acc[r] = 0.f;
        const LAS float* ap = wqS + (32 * kt + r32) * LS + 8 * hi; const LAS float* bp = keysS + (32 * nt + r32) * LS + 8 * hi;
#pragma unroll
        for (int st = 0; st < 8; ++st) {
            const f32x4 a0 = *(const LAS f32x4*)(ap + 16 * st), a1 = *(const LAS f32x4*)(ap + 16 * st + 4), b0 = *(const LAS f32x4*)(bp + 16 * st), b1 = *(const LAS f32x4*)(bp + 16 * st + 4);
            const v4u aw = {pk2(a0.x, a0.y), pk2(a0.z, a0.w), pk2(a1.x, a1.y), pk2(a1.z, a1.w)}, bw = {pk2(b0.x, b0.y), pk2(b0.z, b0.w), pk2(b1.x, b1.y), pk2(b1.z, b1.w)};
            acc = __builtin_amdgcn_mfma_f32_32x32x16_bf16(__builtin_bit_cast(bf16x8, aw), __builtin_bit_cast(bf16x8, bw), acc, 0, 0, 0);
        }
        unsigned char* o = WSP(unsigned char, WS_WQK) + (size_t)l * 2048 * 1024 + (size_t)(hp * 128 + 32 * nt + r32) * 1024 + kb * 64 + 32 * kt + 4 * hi;
#pragma unroll
        for (int g = 0; g < 4; ++g) *(unsigned*)(o + 8 * g) = pk4fp8(acc[4 * g] * 64.0f, acc[4 * g + 1] * 64.0f, acc[4 * g + 2] * 64.0f, acc[4 * g + 3] * 64.0f);
        __syncthreads();
    }
}
#undef WQK_LOAD
__device__ __forceinline__ void prologue_transposes(Frame& F, int l, int first, int stride) {
    LAS float* scr = (LAS float*)(F.lds + F.wave * 16384);
    constexpr int PER_L = 4096 + 768 + 512;
    for (int it = first; it < PER_L; it += stride) {
        int r = it;
        if (r < 4096) { const int kb = r >> 8, n0 = (r & 255) * 32, nsrc = n0 + (n0 >= ORIG_GATE_COL ? 16 : 0);
            if (n0 >= ZBG && n0 < ZGT) transpose_item(F.w_in + (size_t)l * 1024 * DIN, DIN, kb * 64, nsrc, WSP(bf16, WS_WINC) + (size_t)l * (ZGT - ZBG) * 1024, 1024, n0 - ZBG, scr, F.lane);
            else transpose_item8(F.w_in + (size_t)l * 1024 * DIN, DIN, kb * 64, nsrc, WSP(unsigned char, WS_WIN) + (size_t)l * ZW * 1024, 1024, n0, scr, F.lane); }
        else if (r < 4864) { r -= 4096; const int br = r >> 8; r &= 255; const int kb = r >> 5, nb = r & 31;
            bf16* dst = WSP(bf16, WS_WBR) + (size_t)(l * 3 + br) * 1024 * 512; const size_t lo = (size_t)l * 512 * 1024;
            unsigned char* dst8 = WSP(unsigned char, WS_WBR) + (size_t)l * 3 * 1024 * 512 * 2 + (size_t)br * 1024 * 512;
            if (br == 0) transpose_item8(F.w_da + lo, 1024, kb * 64, nb * 32, dst8, 512, nb * 32, scr, F.lane);
            else if (br == 1) transpose_item8(F.w_ml + lo, 1024, kb * 64, nb * 32, dst8, 512, nb * 32, scr, F.lane);
            else transpose_item(F.w_cv + lo, 1024, kb * 64, nb * 32, dst, 512, nb * 32, scr, F.lane); }
        else { r -= 4864; const int kb = r >> 5, nb = r & 31;
            transpose_item(F.w_o + (size_t)l * 1024 * 1024, 1024, kb * 64, nb * 32, WSP(bf16, WS_WO) + (size_t)l * 1024 * 1024, 1024, nb * 32, scr, F.lane); }
    }
}
__device__ __forceinline__ void phase_prologue(Frame& F0) {
    PHASE_FRAME;
    const int gw = F.vcu * NWAVES + F.wave, NGW = F.G * NWAVES;
    if (!(DEFER_PROLOGUE && F.G == 256)) prologue_wqk(F, (int)blockIdx.x, F.G);
    {
        LAS float* sc = (LAS float*)F.lds;
        LAS float* red = sc + 9 * 1024;
        for (int e = F.tid; e < 9 * 1024; e += NTHR) { const int r = e >> 10, k = e & 1023; const float v = r < 8 ? F.c[r * 1024 + k] : F.c_ctx[k]; sc[e] = siluf_(v); }
        __syncthreads();
        for (int it = blockIdx.x; it < 192; it += F.G) {
            const int l = it / 96, cb = it % 96;
            const float* W = F.w_ada + (size_t)l * 1024 * 6144 + cb * 64 + F.lane;
            float a[9];
#pragma unroll
            for (int r = 0; r < 9; ++r) a[r] = 0.f;
            const int k0 = F.wave * 128;
#pragma unroll 2
            for (int k = k0; k < k0 + 128; k += 4) {
                const float w0 = W[(size_t)k * 6144], w1 = W[(size_t)(k + 1) * 6144], w2 = W[(size_t)(k + 2) * 6144], w3 = W[(size_t)(k + 3) * 6144];
#pragma unroll
                for (int r = 0; r < 9; ++r) { const f32x4 s4 = *(const LAS f32x4*)(sc + r * 1024 + k); a[r] += (s4.x * w0 + s4.y * w1) + (s4.z * w2 + s4.w * w3); } }
#pragma unroll
            for (int r = 0; r < 9; ++r) red[(F.wave * 9 + r) * 64 + F.lane] = a[r];
            __syncthreads();
            for (int o = F.tid; o < 576; o += NTHR) { const int r = o >> 6, j = o & 63; float s = 0.f;
#pragma unroll
                for (int w = 0; w < 8; ++w) s += red[(w * 9 + r) * 64 + j];
                WSP(float, WS_MOD)[(size_t)(l * 9 + r) * 6144 + cb * 64 + j] = s + F.b_ada[l * 6144 + cb * 64 + j]; }
            __syncthreads();
        }
    }
    {
        const int gt = F.vcu * NTHR + F.tid, NGT = F.G * NTHR;
        for (int e = gt; e < 2 * 16 * 1024; e += NGT) { const int l = e >> 14, j = (e >> 10) & 15, k = e & 1023;
            WSP(float, WS_WG)[e] = F.w_in[(size_t)l * 1024 * DIN + (size_t)k * DIN + ORIG_GATE_COL + j]; }
        for (int e = gt; e < 64 * 16; e += NGT) { const int pos = e >> 4, i = e & 15;
            const float inv = exp2f(-(float)i * (13.287712379549449f / 16.0f));
            const float ang = (float)pos * inv;
            const float n = rintf(ang * 0.15915494309189535f);
            float r = fmaf(-n, 6.28318548202514648f, ang); r = fmaf(-n, -1.7484555e-7f, r);
            MISCF[MISC_COS + e] = __cosf(r); MISCF[MISC_SIN + e] = __sinf(r); }
        if (gt < 2) { const float* lv = F.da_lam + gt * 256; float s01 = 0.f, s23 = 0.f;
            for (int i = 0; i < 64; ++i) { s01 += lv[i] * lv[64 + i]; s23 += lv[128 + i] * lv[192 + i]; }
            const float lam_init = 0.8f - 0.6f * expf(-0.3f * (float)gt);
            MISCF[MISC_LAM + gt] = expf(s01) - expf(s23) + lam_init; }
    }
    prologue_transposes(F, 0, gw, NGW);
    if (!(DEFER_PROLOGUE && F.G == 256)) prologue_transposes(F, 1, gw, NGW);
}

__device__ __forceinline__ void peer_table_convert(Frame& F, int l, size_t me, size_t nme) {
    typedef float v16f __attribute__((ext_vector_type(16))); typedef unsigned v6u_ __attribute__((ext_vector_type(6)));
    const size_t n32 = (size_t)PEER_NEXP * 1024 / 32;
    const float* su = F.peer_u + (size_t)l * PEER_NEXP * 1024; const float* sv = F.peer_v + (size_t)l * PEER_NEXP * 1024;
    unsigned char* du = WSP(unsigned char, WS_TU); unsigned char* dv = WSP(unsigned char, WS_TV);
#define PTC_SRC(i_) (((i_) < n32 ? su + (i_) * 32 : sv + ((i_) - n32) * 32))
#define PTC_CVT(i_, t_) do { const bool isu_ = (i_) < n32; const size_t j_ = isu_ ? (i_) : (i_) - n32; const float sc_ = isu_ ? PEER_USCALE : PEER_VSCALE; v16f a_, b_; \
        _Pragma("unroll") for (int q = 0; q < 8; ++q) { a_[2 * q] = t_[q].x * sc_; b_[2 * q] = t_[q].y * sc_; a_[2 * q + 1] = t_[q].z * sc_; b_[2 * q + 1] = t_[q].w * sc_; } \
        const v6u_ w_ = __builtin_amdgcn_cvt_scalef32_2xpk16_fp6_f32(a_, b_, 1.0f); unsigned* o_ = (unsigned*)((isu_ ? du : dv) + j_ * 24); \
        *(u32x2*)o_ = (u32x2){w_[0], w_[1]}; *(u32x2*)(o_ + 2) = (u32x2){w_[2], w_[3]}; *(u32x2*)(o_ + 4) = (u32x2){w_[4], w_[5]}; } while (0)
#pragma unroll 1
    for (size_t i = me; i < 2 * n32; i += 2 * nme) {
        const size_t i2 = i + nme; const bool two = i2 < 2 * n32;
        const float* s0 = PTC_SRC(i); const float* s1 = PTC_SRC(two ? i2 : i);
        f32x4 t0[8], t1[8];
#pragma unroll
        for (int q = 0; q < 8; ++q) t0[q] = *(const f32x4*)(s0 + 4 * q);
#pragma unroll
        for (int q = 0; q < 8; ++q) t1[q] = *(const f32x4*)(s1 + 4 * q);
        PTC_CVT(i, t0);
        if (two) PTC_CVT(i2, t1);
    }
#undef PTC_SRC
#undef PTC_CVT
}
__device__ __forceinline__ void peer_table_convert16(Frame& F, int l, size_t me, size_t nme) {
    const size_t n16 = (size_t)PEER_NEXP * 1024 / 16;
    const float* su = F.peer_u + (size_t)l * PEER_NEXP * 1024; const float* sv = F.peer_v + (size_t)l * PEER_NEXP * 1024;
    unsigned char* du = WSP(unsigned char, WS_TU); unsigned char* dv = WSP(unsigned char, WS_TV);
    constexpr int CU_ = 2;
#pragma unroll 1
    for (size_t i0 = me; i0 < 2 * n16; i0 += CU_ * nme) {
        f32x4 a[CU_][4];
#pragma unroll
        for (int u = 0; u < CU_; ++u) { const size_t i = i0 + u * nme; if (i < 2 * n16) { const bool isu = i < n16; const size_t j = isu ? i : i - n16; const float* s = (isu ? su : sv) + j * 16;
#pragma unroll
            for (int q = 0; q < 4; ++q) a[u][q] = *(const f32x4*)(s + 4 * q); } }
        __builtin_amdgcn_sched_barrier(0);
#pragma unroll
        for (int u = 0; u < CU_; ++u) { const size_t i = i0 + u * nme; if (i < 2 * n16) { const bool isu = i < n16; const size_t j = isu ? i : i - n16; const float sc = isu ? PEER_USCALE : PEER_VSCALE;
            unsigned c[16];
#pragma unroll
            for (int q = 0; q < 4; ++q) { const f32x4 v = a[u][q] * sc; c[4 * q] = fp6code(v.x); c[4 * q + 1] = fp6code(v.y); c[4 * q + 2] = fp6code(v.z); c[4 * q + 3] = fp6code(v.w); }
            unsigned long long lo = 0ull;
#pragma unroll
            for (int q = 0; q < 11; ++q) lo |= (unsigned long long)c[q] << (6 * q);
            unsigned hi = c[10] >> 4;
#pragma unroll
            for (int q = 11; q < 16; ++q) hi |= c[q] << (6 * q - 64);
            unsigned* o = (unsigned*)((isu ? du : dv) + j * 12); o[0] = (unsigned)lo; o[1] = (unsigned)(lo >> 32); o[2] = hi; } }
    }
}
__device__ __forceinline__ void phase_norm(Frame& F0, int l, int which) {
    PHASE_FRAME;
    const int gw = F.vcu * NWAVES + F.wave, NGW = F.G * NWAVES;
    LAS float* wg = (LAS float*)F.lds;
    if (which == 0) {
        const float* src = WSP(float, WS_WG) + (size_t)l * 16384;
        for (int e = F.tid * 4; e < 16384; e += NTHR * 4) *(LAS f32x4*)(wg + e) = *(const f32x4*)(src + e);
        __syncthreads();
    }
    const float* xl_src = (l == 0 && which == 0) ? F.x : F.out;
    const float* xc_src = (l == 0 && which == 0) ? F.ctx : WSP(float, WS_XC);
    const float* gn1 = F.norm1_g, * gn2 = F.norm2_g; const float* gn = (which ? gn2 : gn1) + l * 1024;
    const int nrows = (which == 1 && l == 1) ? NLAT : NROW;
    bf16* H = WSP(bf16, WS_H);
    f32x4 pv[4];
#pragma unroll
    for (int j = 0; j < 4; ++j) pv[j] = (f32x4){0.f, 0.f, 0.f, 0.f};
#define NORM_LDROW(row_) do { const int r_ = (row_); const bool lat_ = r_ < NLAT; const float* xr_ = lat_ ? xl_src + (size_t)r_ * 1024 : xc_src + (size_t)(r_ - NLAT) * 1024; \
        _Pragma("unroll") for (int j = 0; j < 4; ++j) { \
            if (lat_ && which == 1) { const u32x2 w_ = *(const u32x2*)((const char*)F.out + (size_t)r_ * 4096 + (F.lane * 4 + 256 * j) * 2); pv[j].x = __uint_as_float(w_.x); pv[j].y = __uint_as_float(w_.y); } \
            else pv[j] = *(const f32x4*)(xr_ + F.lane * 4 + 256 * j); } } while (0)
    if (gw < nrows) NORM_LDROW(gw);
    for (int row = gw; row < nrows; row += NGW) {
        const bool lat = row < NLAT;
        const float* mod = WSP(float, WS_MOD) + (size_t)(l * 9 + (lat ? (row >> 11) : 8)) * 6144 + (which ? 3072 : 0);
        f32x4 v[4]; float ss = 0.f;
#pragma unroll
        for (int j = 0; j < 4; ++j) {
            if (lat && which == 1) { const unsigned wx = __float_as_uint(pv[j].x), wy = __float_as_uint(pv[j].y);
                v[j] = (f32x4){__uint_as_float(wx << 16), __uint_as_float(wx & 0xffff0000u), __uint_as_float(wy << 16), __uint_as_float(wy & 0xffff0000u)}; }
            else v[j] = pv[j];
            ss += (v[j].x * v[j].x + v[j].y * v[j].y) + (v[j].z * v[j].z + v[j].w * v[j].w); }
        if (row + NGW < nrows) NORM_LDROW(row + NGW);
        const float rstd = 1.0f / sqrtf(wave_sum(ss) * (1.0f / 1024.0f) + EPS);
#pragma unroll
        for (int j = 0; j < 4; ++j) { const int c = F.lane * 4 + 256 * j;
            const f32x4 g = *(const f32x4*)(gn + c), sh = *(const f32x4*)(mod + c), sc = *(const f32x4*)(mod + 1024 + c);
            v[j] = (v[j] * rstd * g) * (sc + 1.0f) + sh;
            if (which == 0) { u32x2 w; w.x = pk2(v[j].x, v[j].y); w.y = pk2(v[j].z, v[j].w);
                *(u32x2*)(H + (size_t)row * 1024 + c) = w; }
            *(unsigned*)(WSP(unsigned char, WS_H8) + (size_t)row * 1024 + c) = pk4fp8(v[j].x, v[j].y, v[j].z, v[j].w); }
        if (which == 0) {
            float p[16];
#pragma unroll
            for (int jj = 0; jj < 16; ++jj) { float s = 0.f;
#pragma unroll
                for (int j = 0; j < 4; ++j) { const f32x4 w = *(LAS f32x4*)(wg + jj * 1024 + F.lane * 4 + 256 * j); s += (v[j].x * w.x + v[j].y * w.y) + (v[j].z * w.z + v[j].w * w.w); }
                p[jj] = s; if ((jj & 3) == 3) __builtin_amdgcn_sched_barrier(0); }
            const float tot = reduce16(p, F.lane);
            if ((F.lane & 3) == 0) WSP(float, WS_G)[(size_t)row * 16 + red16_index(F.lane)] = tot;
        }
    }
#undef NORM_LDROW
}

__device__ __forceinline__ void phase_rope(Frame& F0) {
    PHASE_FRAME;
    const int gw = F.vcu * NWAVES + F.wave, NGW = F.G * NWAVES;
    const float* cosT = MISCF + MISC_COS; const float* sinT = MISCF + MISC_SIN;
    bf16* Z = WSP(bf16, WS_Z);
    for (int row = gw; row < NROW; row += NGW) {
        bf16* zr = Z + (size_t)row * ZW;
        if (row < NLAT) {
            const int t = row & 2047, pr = t >> 6, pc = t & 63;
#pragma unroll
            for (int tensor = 0; tensor < 2; ++tensor) { const int base = tensor ? ZK : ZQ; const float scale = tensor ? 1.0f : QSCALE;
#pragma unroll
                for (int it = 0; it < 4; ++it) { const int idx = F.lane + 64 * it, hm = idx >> 5, p = idx & 31, i = p & 15, isc = p >> 4, pos = isc ? pc : pr;
                    const int ca = base + hm * 64 + isc * 32 + i, cb = ca + 16;
                    const float c = cosT[pos * 16 + i], s = sinT[pos * 16 + i], xa = bf2f(zr[ca]), xb = bf2f(zr[cb]);
                    zr[ca] = (bf16)f2bf((xa * c - xb * s) * scale); zr[cb] = (bf16)f2bf((xa * s + xb * c) * scale); } }
        } else {
            float f[8]; unpack8(*(const v4u*)(zr + ZQ + F.lane * 8), f);
#pragma unroll
            for (int i = 0; i < 8; ++i) f[i] *= QSCALE;
            *(v4u*)(zr + ZQ + F.lane * 8) = pack8(f);
        }
    }
}
__device__ __forceinline__ void phase_convbranch(Frame& F0, int l, int r0, int r1, int wg0) {
    PHASE_FRAME;
    const int nwg = F.G - wg0;
    if ((int)blockIdx.x < wg0) return;
    const int total = r1 * 64;
    const bf16* Z = WSP(bf16, WS_Z); bf16* Y = WSP(bf16, WS_Y) + (size_t)2 * NROW * 512;
    const float* cw = F.cv_conv_w + l * 3 * 512;
    for (int e = r0 * 64 + ((int)blockIdx.x - wg0) * NTHR + F.tid; e < total; e += nwg * NTHR) {
        const int row = e >> 6, c0 = (e & 63) * 8; const bool lat = row < NLAT;
        const int t = lat ? (row & 2047) : ((row - NLAT) & 255), L = lat ? 2048 : 256;
        const bf16* zr = Z + (size_t)row * ZW;
        float acc[8], a[8], b[8], w[8];
        unpack8(*(const v4u*)(zr + ZCG + c0), a); unpack8(*(const v4u*)(zr + ZXV + c0), b);
        ld8f(cw + 512 + c0, w);
#pragma unroll
        for (int i = 0; i < 8; ++i) acc[i] = w[i] * (a[i] * b[i]);
        if (t > 0) { unpack8(*(const v4u*)(zr - ZW + ZCG + c0), a); unpack8(*(const v4u*)(zr - ZW + ZXV + c0), b);
            ld8f(cw + c0, w);
#pragma unroll
            for (int i = 0; i < 8; ++i) acc[i] += w[i] * (a[i] * b[i]); }
        if (t < L - 1) { unpack8(*(const v4u*)(zr + ZW + ZCG + c0), a); unpack8(*(const v4u*)(zr + ZW + ZXV + c0), b);
            ld8f(cw + 1024 + c0, w);
#pragma unroll
            for (int i = 0; i < 8; ++i) acc[i] += w[i] * (a[i] * b[i]); }
        unpack8(*(const v4u*)(zr + ZBG + c0), a);
#pragma unroll
        for (int i = 0; i < 8; ++i) acc[i] *= a[i] * ABLF(l, 2);
        *(v4u*)(Y + (size_t)row * 512 + c0) = pack8(acc);
    }
}

constexpr int MLP = 136;
constexpr int GS_LF = 0, GS_IG = 256, GS_DEC = 512, GS_E = 768, GS_SC = 1024;
typedef float f32x4m __attribute__((ext_vector_type(4)));
#define MFMA16(a, b, c) __builtin_amdgcn_mfma_f32_16x16x32_bf16((a), (b), (c), 0, 0, 0)

struct MlItem { int b, h, ci, row0, t0, L; };
__device__ __forceinline__ MlItem ml_decode(int b, int h, int ci) {
    MlItem m; m.b = b; m.h = h; m.ci = ci;
    if (ci < 2) { m.row0 = NLAT + b * 256 + ci * 128; m.t0 = ci * 128; m.L = 256; }
    else { m.row0 = b * 2048 + (ci - 2) * 128; m.t0 = (ci - 2) * 128; m.L = 2048; }
    return m;
}
__device__ __forceinline__ int ml_sidx(int b, int h, int dir, int ci) { return ((b * 4 + h) * 2 + dir) * NCHUNK + ci; }

__device__ __forceinline__ void ml_gates(Frame& F, int l, const MlItem& m, LAS float* gs) {
    if (F.tid < 128) {
        const float* gr = WSP(float, WS_G) + (size_t)(m.row0 + F.tid) * 16; const float* gb = F.ml_gate_b + l * 16;
        gs[GS_IG + F.tid] = gr[m.h] + gb[m.h];
        gs[GS_LF + F.tid] = log_sigmoidf_(gr[4 + m.h] + gb[4 + m.h]);
        gs[GS_IG + 128 + F.tid] = gr[8 + m.h] + gb[8 + m.h];
        gs[GS_LF + 128 + F.tid] = log_sigmoidf_(gr[12 + m.h] + gb[12 + m.h]);
    }
    __syncthreads();
    if (F.wave < 2) {
        const int d = F.wave, s0 = 2 * F.lane, s1 = s0 + 1;
        const float a = gs[GS_LF + d * 128 + s0], b = gs[GS_LF + d * 128 + s1], pair = a + b;
        float incl = pair;
#pragma unroll
        for (int o = 1; o < 64; o <<= 1) { const float t = bperm(incl, F.lane - o); if (F.lane >= o) incl += t; }
        const float total = rlane(incl, 63);
        const float P0 = incl - b, P1 = incl;
        const float D0 = d == 0 ? P0 : total - P0 + a, D1 = d == 0 ? P1 : total - P1 + b;
        const float a0 = gs[GS_IG + d * 128 + s0] - D0, a1 = gs[GS_IG + d * 128 + s1] - D1;
        const float M = wave_max(fmaxf(a0, a1));
        gs[GS_DEC + d * 128 + s0] = D0; gs[GS_DEC + d * 128 + s1] = D1;
        gs[GS_E + d * 128 + s0] = __expf(a0 - M); gs[GS_E + d * 128 + s1] = __expf(a1 - M);
        if (F.lane == 0) { gs[GS_SC + 2 * d] = M; gs[GS_SC + 2 * d + 1] = total; }
    }
    __syncthreads();
}
__device__ __forceinline__ void ml_conv_strip(const unsigned char* zc, int s_base, int t_base, int L, const float* cw, float scale, float (&o)[4][8]) {
    u32x2 xw[6];
    const u32x2 zero = {0u, 0u};
    xw[0] = t_base > 0 ? *(const u32x2*)(zc + (ptrdiff_t)(s_base - 1) * (ZW * 2)) : zero;
#pragma unroll
    for (int j = 1; j < 5; ++j) xw[j] = *(const u32x2*)(zc + (ptrdiff_t)(s_base + j - 1) * (ZW * 2));
    xw[5] = t_base + 4 < L ? *(const u32x2*)(zc + (ptrdiff_t)(s_base + 4) * (ZW * 2)) : zero;
    v4u xr[6];
#pragma unroll
    for (int j = 0; j < 6; ++j) xr[j] = fp8x8_bf16(xw[j]);
    float w0[8], w1[8], w2[8]; ld8f(cw, w0); ld8f(cw + 1024, w1); ld8f(cw + 2048, w2);
    float x0[8], x1[8], x2[8];
    unpack8(xr[0], x0); unpack8(xr[1], x1);
#pragma unroll
    for (int k = 0; k < 4; ++k) {
        unpack8(xr[k + 2], x2);
#pragma unroll
        for (int i = 0; i < 8; ++i) { o[k][i] = siluf_(w0[i] * x0[i] + w1[i] * x1[i] + w2[i] * x2[i]) * scale; x0[i] = x1[i]; x1[i] = x2[i]; }
    }
}
__device__ __forceinline__ void ml_fill_vt(Frame& F, const MlItem& m, LAS bf16* Vt, bool ext_rows) {
    const bf16* Z = WSP(bf16, WS_Z);
    const int sq = F.tid & 31, c0 = (F.tid >> 5) * 8, s_base = 4 * sq;
    v4u xr[4];
#pragma unroll
    for (int k = 0; k < 4; ++k) xr[k] = ldz8(z8p(Z, (size_t)(m.row0 + s_base + k), ZMV + m.h * 128 + c0));
#pragma unroll
    for (int q = 0; q < 4; ++q) {
        u32x2 lo, hi;
        lo.x = (xr[0][q] & 0xffffu) | (xr[1][q] << 16); lo.y = (xr[2][q] & 0xffffu) | (xr[3][q] << 16);
        hi.x = (xr[0][q] >> 16) | (xr[1][q] & 0xffff0000u); hi.y = (xr[2][q] >> 16) | (xr[3][q] & 0xffff0000u);
        *(LAS u32x2*)(Vt + (c0 + 2 * q) * MLP + s_base) = lo; *(LAS u32x2*)(Vt + (c0 + 2 * q + 1) * MLP + s_base) = hi; }
    if (ext_rows) { const int r = F.tid >> 5, s4 = (F.tid & 31) * 4; u32x2 v; v.x = r == 0 ? 0x3F803F80u : 0u; v.y = v.x; *(LAS u32x2*)(Vt + (128 + r) * MLP + s4) = v; }
}

__device__ __forceinline__ void phase_ml_a(Frame& F0, int l) {
    PHASE_FRAME;
    LAS bf16* Vt = (LAS bf16*)F.lds;
    LAS bf16* KtF = Vt + STW * MLP;
    LAS bf16* KtB = KtF + 128 * MLP;
    LAS float* gs = (LAS float*)(KtB + 128 * MLP);
    const bf16* Z = WSP(bf16, WS_Z);
    for (int item = blockIdx.x; item < NBATCH * 4 * NCHUNK; item += F.G) {
        int lane_ = F.lane; asm volatile("" : "+v"(lane_));
        const int g = lane_ >> 4, fr = lane_ & 15, w = F.wave;
        const MlItem m = ml_decode(item / 72, (item / NCHUNK) % 4, item % NCHUNK);
        ml_gates(F, l, m, gs);
        ml_fill_vt(F, m, Vt, true);
        { const int sq = F.tid & 31, c0 = (F.tid >> 5) * 8, s_base = 4 * sq;
          float kc[4][8];
          ml_conv_strip(z8p(Z, (size_t)m.row0, ZMK + m.h * 128 + c0), s_base, m.t0 + s_base, m.L, F.ml_conv_w + (size_t)l * 3072 + 512 + m.h * 128 + c0, 0.08838834764831845f, kc);
          const f32x4 ef = *(const LAS f32x4*)(gs + GS_E + s_base), eb = *(const LAS f32x4*)(gs + GS_E + 128 + s_base);
#pragma unroll
          for (int i = 0; i < 8; ++i) { u32x2 a, b;
              a.x = pk2(kc[0][i] * ef[0], kc[1][i] * ef[1]); a.y = pk2(kc[2][i] * ef[2], kc[3][i] * ef[3]);
              b.x = pk2(kc[0][i] * eb[0], kc[1][i] * eb[1]); b.y = pk2(kc[2][i] * eb[2], kc[3][i] * eb[3]);
              *(LAS u32x2*)(KtF + (c0 + i) * MLP + s_base) = a; *(LAS u32x2*)(KtB + (c0 + i) * MLP + s_base) = b; } }
        __syncthreads();
#pragma unroll 1
        for (int dir = 0; dir < 2; ++dir) {
            const LAS bf16* Kt = dir ? KtB : KtF;
            f32x4 acc[9];
#pragma unroll
            for (int ct = 0; ct < 9; ++ct) acc[ct] = (f32x4){0.f, 0.f, 0.f, 0.f};
#pragma unroll
            for (int kk = 0; kk < 4; ++kk) {
                const bf16x8 afr = *(const LAS bf16x8*)(Kt + (16 * w + fr) * MLP + 32 * kk + 8 * g);
#pragma unroll
                for (int ct = 0; ct < 9; ++ct) { const bf16x8 bfr = *(const LAS bf16x8*)(Vt + (16 * ct + fr) * MLP + 32 * kk + 8 * g); acc[ct] = MFMA16(afr, bfr, acc[ct]); }
                __builtin_amdgcn_sched_barrier(0);
            }
            const float M = gs[GS_SC + 2 * dir], tot = gs[GS_SC + 2 * dir + 1], scale = __expf(tot + M);
            const int si = ml_sidx(m.b, m.h, dir, m.ci);
            bf16* st = WSP(bf16, WS_ST) + (size_t)si * (STW * 128);
#pragma unroll
            for (int ct = 0; ct < 9; ++ct) { u32x2 v; v.x = pk2(acc[ct][0] * scale, acc[ct][1] * scale); v.y = pk2(acc[ct][2] * scale, acc[ct][3] * scale);
                *(u32x2*)(st + (16 * ct + fr) * 128 + 16 * w + 4 * g) = v; }
            if (F.tid == 0) MISCF[MISC_DEC + si] = __expf(tot);
        }
        __syncthreads();
    }
}
__device__ __forceinline__ void phase_ml_b(Frame& F0) {
    PHASE_FRAME;
    constexpr int NV = STW * 128 / 8;
    const int stride = F.G * NTHR;
    for (int e = F.vcu * NTHR + F.tid; e < 64 * NV; e += 2 * stride) {
        const int e2 = e + stride; const bool two = e2 < 64 * NV;
        const int chA = e / NV, vecA = e % NV, dirA = chA & 1, chB = two ? e2 / NV : chA, vecB = two ? e2 % NV : vecA, dirB = chB & 1;
        bf16* baseA = WSP(bf16, WS_ST) + (size_t)chA * NCHUNK * (STW * 128) + vecA * 8; bf16* baseB = WSP(bf16, WS_ST) + (size_t)chB * NCHUNK * (STW * 128) + vecB * 8;
        const float* decA = MISCF + MISC_DEC + chA * NCHUNK; const float* decB = MISCF + MISC_DEC + chB * NCHUNK;
        v4u tA[NCHUNK], tB[NCHUNK]; float dA[NCHUNK], dB[NCHUNK];
#pragma unroll
        for (int step = 0; step < NCHUNK; ++step) { const int ci = dirA == 0 ? step : (step < 2 ? 1 - step : 19 - step); tA[step] = *(const v4u*)(baseA + (size_t)ci * (STW * 128)); dA[step] = decA[ci]; }
        if (two) {
#pragma unroll
            for (int step = 0; step < NCHUNK; ++step) { const int ci = dirB == 0 ? step : (step < 2 ? 1 - step : 19 - step); tB[step] = *(const v4u*)(baseB + (size_t)ci * (STW * 128)); dB[step] = decB[ci]; } }
        { float c[8];
#pragma unroll
          for (int i = 0; i < 8; ++i) c[i] = 0.f;
#pragma unroll
          for (int step = 0; step < NCHUNK; ++step) { const int ci = dirA == 0 ? step : (step < 2 ? 1 - step : 19 - step);
              float tf[8]; unpack8(tA[step], tf);
              *(v4u*)(baseA + (size_t)ci * (STW * 128)) = pack8(c);
#pragma unroll
              for (int i = 0; i < 8; ++i) c[i] = dA[step] * c[i] + tf[i]; } }
        if (two) { float c[8];
#pragma unroll
          for (int i = 0; i < 8; ++i) c[i] = 0.f;
#pragma unroll
          for (int step = 0; step < NCHUNK; ++step) { const int ci = dirB == 0 ? step : (step < 2 ? 1 - step : 19 - step);
              float tf[8]; unpack8(tB[step], tf);
              *(v4u*)(baseB + (size_t)ci * (STW * 128)) = pack8(c);
#pragma unroll
              for (int i = 0; i < 8; ++i) c[i] = dB[step] * c[i] + tf[i]; } }
    }
}
__device__ __forceinline__ void phase_ml_c(Frame& F0, int l) {
    PHASE_FRAME;
    LAS bf16* Qi = (LAS bf16*)F.lds;
    LAS bf16* Ki = Qi + 128 * MLP;
    LAS bf16* Vt = Ki + 128 * MLP;
    LAS bf16* STl = Vt + 128 * MLP;
    LAS float* gs = (LAS float*)(STl + 129 * MLP);
    const bf16* Z = WSP(bf16, WS_Z); unsigned char* Yml = WSP(unsigned char, WS_Y) + (size_t)NROW * 512;
    const int w = F.wave;
    const int nitems = l == 0 ? NBATCH * 4 * NCHUNK : NBATCH * 4 * 16;
    for (int item = blockIdx.x; item < nitems; item += F.G) {
        const MlItem m = l == 0 ? ml_decode(item / 72, (item / NCHUNK) % 4, item % NCHUNK) : ml_decode(item / 64, (item / 16) % 4, 2 + (item % 16));
        ml_gates(F, l, m, gs);
        const bf16* st0 = WSP(bf16, WS_ST) + (size_t)ml_sidx(m.b, m.h, 0, m.ci) * (STW * 128);
        const bf16* st1 = WSP(bf16, WS_ST) + (size_t)ml_sidx(m.b, m.h, 1, m.ci) * (STW * 128);
        v4u pre[5];
#pragma unroll
        for (int k = 0; k < 4; ++k) pre[k] = *(const v4u*)(st0 + (size_t)(F.tid + NTHR * k) * 8);
        pre[4] = F.tid < 16 ? *(const v4u*)(st0 + 128 * 128 + F.tid * 8) : (v4u){0u, 0u, 0u, 0u};
        ml_fill_vt(F, m, Vt, false);
        { const int sq = F.tid & 31, c0 = (F.tid >> 5) * 8, s_base = 4 * sq;
          const float* cw = F.ml_conv_w + (size_t)l * 3072 + m.h * 128 + c0;
          float qc[4][8];
          ml_conv_strip(z8p(Z, (size_t)m.row0, ZMQ + m.h * 128 + c0), s_base, m.t0 + s_base, m.L, cw, 1.0f, qc);
#pragma unroll
          for (int k = 0; k < 4; ++k) *(LAS v4u*)(Qi + (s_base + k) * MLP + c0) = pack8(qc[k]);
          ml_conv_strip(z8p(Z, (size_t)m.row0, ZMK + m.h * 128 + c0), s_base, m.t0 + s_base, m.L, cw + 512, 0.08838834764831845f, qc);
#pragma unroll
          for (int k = 0; k < 4; ++k) *(LAS v4u*)(Ki + (s_base + k) * MLP + c0) = pack8(qc[k]); }
#define ML_ST_WRITE() do { _Pragma("unroll") for (int k = 0; k < 4; ++k) { const int e_ = F.tid + NTHR * k; *(LAS v4u*)(STl + (e_ >> 4) * MLP + (e_ & 15) * 8) = pre[k]; } \
            if (F.tid < 16) *(LAS v4u*)(STl + 128 * MLP + F.tid * 8) = pre[4]; } while (0)
        ML_ST_WRITE();
        __syncthreads();
#pragma unroll
        for (int k = 0; k < 4; ++k) pre[k] = *(const v4u*)(st1 + (size_t)(F.tid + NTHR * k) * 8);
        pre[4] = F.tid < 16 ? *(const v4u*)(st1 + 128 * 128 + F.tid * 8) : (v4u){0u, 0u, 0u, 0u};
        int lane_ = F.lane; asm volatile("" : "+v"(lane_));
        const int g = lane_ >> 4, fr = lane_ & 15;
        bf16x8 bq[4];
#pragma unroll
        for (int kk = 0; kk < 4; ++kk) bq[kk] = *(const LAS bf16x8*)(Qi + (16 * w + fr) * MLP + 32 * kk + 8 * g);
        f32x4 hs[8];
#pragma unroll
        for (int ct = 0; ct < 8; ++ct) hs[ct] = (f32x4){0.f, 0.f, 0.f, 0.f};
        LAS bf16* Pw = Qi + 16 * w * MLP;
#pragma unroll 1
        for (int dir = 0; dir < 2; ++dir) {
            if (dir == 1) { __syncthreads(); ML_ST_WRITE(); __syncthreads(); }
#pragma unroll
            for (int nt = 0; nt < 8; ++nt) { f32x4 a = (f32x4){0.f, 0.f, 0.f, 0.f};
#pragma unroll
                for (int kk = 0; kk < 4; ++kk) { const bf16x8 ak = *(const LAS bf16x8*)(Ki + (16 * nt + fr) * MLP + 32 * kk + 8 * g); a = MFMA16(ak, bq[kk], a); }
                const f32x4 es = *(const LAS f32x4*)(gs + GS_E + dir * 128 + 16 * nt + 4 * g);
                const bool full = dir == 0 ? (nt < w) : (nt > w), diag = nt == w;
                float pv[4];
#pragma unroll
                for (int r = 0; r < 4; ++r) { const bool dk = dir == 0 ? (4 * g + r <= fr) : (4 * g + r >= fr); pv[r] = (full || (diag && dk)) ? a[r] * es[r] : 0.f; }
                u32x2 pw; pw.x = pk2(pv[0], pv[1]); pw.y = pk2(pv[2], pv[3]);
                *(LAS u32x2*)(Pw + fr * MLP + 16 * nt + 4 * g) = pw;
                if (nt & 1) __builtin_amdgcn_sched_barrier(0); }
            bf16x8 bp[4];
#pragma unroll
            for (int kk = 0; kk < 4; ++kk) bp[kk] = *(const LAS bf16x8*)(Pw + fr * MLP + 32 * kk + 8 * g);
            f32x4 ai[9], ac[9];
#pragma unroll
            for (int ct = 0; ct < 9; ++ct) { ai[ct] = (f32x4){0.f, 0.f, 0.f, 0.f}; ac[ct] = (f32x4){0.f, 0.f, 0.f, 0.f}; }
            const short one_ = fr == 0 ? (short)0x3F80 : (short)0;
            const bf16x8 ones = {one_, one_, one_, one_, one_, one_, one_, one_};
#pragma unroll
            for (int kk = 0; kk < 4; ++kk) {
#pragma unroll
                for (int ct = 0; ct < 8; ++ct) { const bf16x8 av = *(const LAS bf16x8*)(Vt + (16 * ct + fr) * MLP + 32 * kk + 8 * g); ai[ct] = MFMA16(av, bp[kk], ai[ct]); }
                ai[8] = MFMA16(ones, bp[kk], ai[8]);
#pragma unroll
                for (int ct = 0; ct < 8; ++ct) { const bf16x8 sv = *(const LAS bf16x8*)(STl + (16 * ct + fr) * MLP + 32 * kk + 8 * g); ac[ct] = MFMA16(sv, bq[kk], ac[ct]); }
                { bf16x8 sv = *(const LAS bf16x8*)(STl + 128 * MLP + 32 * kk + 8 * g); if (fr != 0) sv = (bf16x8){0, 0, 0, 0, 0, 0, 0, 0}; ac[8] = MFMA16(sv, bq[kk], ac[8]); }
                __builtin_amdgcn_sched_barrier(0); }
            const float eM = __expf(gs[GS_SC + 2 * dir]);
            const float rs = __expf(gs[GS_DEC + dir * 128 + 16 * w + fr]);
            const float denl = rs * (eM * ai[8][0] + ac[8][0]);
            const float den = bperm(denl, fr);
            const float inv = rs / fmaxf(fabsf(den), 1.0f);
#pragma unroll
            for (int ct = 0; ct < 8; ++ct) hs[ct] += (ai[ct] * eM + ac[ct]) * inv;
        }
        const float* ng = F.ml_norm_g + l * 512 + m.h * 128;
        float ss = 0.f;
#pragma unroll
        for (int ct = 0; ct < 8; ++ct) ss += (hs[ct][0] * hs[ct][0] + hs[ct][1] * hs[ct][1]) + (hs[ct][2] * hs[ct][2] + hs[ct][3] * hs[ct][3]);
        ss += swz<0x401F>(ss); ss += bperm(ss, lane_ ^ 32);
        const float rstd = 1.0f / sqrtf(ss * (1.0f / 128.0f) + EPS) * ABLF(l, 1);
        const size_t row = (size_t)(m.row0 + 16 * w + fr);
#pragma unroll
        for (int ct = 0; ct < 8; ++ct) { const int col = m.h * 128 + 16 * ct + 4 * g;
            const unsigned ow = *(const unsigned*)z8p(Z, row, ZMO + col); const f32x4 gv = *(const f32x4*)(ng + 16 * ct + 4 * g);
            const f32x2p oa = __builtin_amdgcn_cvt_pk_f32_fp8((int)ow, false), ob = __builtin_amdgcn_cvt_pk_f32_fp8((int)ow, true);
            *(unsigned*)(Yml + row * 512 + col) = pk4fp8(hs[ct][0] * rstd * gv[0] * sigmoidf_(oa.x), hs[ct][1] * rstd * gv[1] * sigmoidf_(oa.y),
                                                         hs[ct][2] * rstd * gv[2] * sigmoidf_(ob.x), hs[ct][3] * rstd * gv[3] * sigmoidf_(ob.y)); }
        __syncthreads();
    }
}

constexpr int AT_SHM_V = 64 * 128 * 2, AT_SHM_K = 64 * 128 * 2;
#define KSWZ(row, colB) ((row) * 256 + ((colB) ^ (((row) & 7) << 4)))
#define SBAR() __builtin_amdgcn_sched_barrier(0)
__device__ __forceinline__ int crow(int r, int hi) { return (r & 3) + 8 * (r >> 2) + 4 * hi; }
__device__ __forceinline__ unsigned cvtpk(float lo, float hi) { unsigned r; asm volatile("v_cvt_pk_bf16_f32 %0, %1, %2" : "=v"(r) : "v"(lo), "v"(hi)); return r; }
__device__ __forceinline__ int v_st(int k, int c) { const int kk = (k & ~0xC) | ((k & 4) << 1) | ((k & 8) >> 1); return ((kk >> 3) * 4 + (c >> 5)) * 512 + ((kk & 7) * 32 + (c & 31)) * 2; }
__device__ __forceinline__ int v_rd_base(int lane) { return ((lane & 3) << 3) | (((lane >> 2) & 3) << 6) | (((lane >> 4) & 1) << 5) | (((lane >> 5) & 1) << 8); }
constexpr int v_rd_off(int d0, int ks, int half) { return d0 * 512 + ks * 4096 + half * 2048; }
template <int OFF> __device__ __forceinline__ s16x4 tr_read(int vb) { s16x4 r; asm volatile("ds_read_b64_tr_b16 %0, %1 offset:%2" : "=&v"(r) : "v"(vb), "i"(OFF) : "memory"); return r; }
template <int D0> __device__ __forceinline__ void pv_one(f32x16& od, int vb, bf16x8 pa0, bf16x8 pa1, bf16x8 pa2, bf16x8 pa3) {
    const s16x4 l0 = tr_read<v_rd_off(D0, 0, 0)>(vb), h0 = tr_read<v_rd_off(D0, 0, 1)>(vb), l1 = tr_read<v_rd_off(D0, 1, 0)>(vb), h1 = tr_read<v_rd_off(D0, 1, 1)>(vb);
    const s16x4 l2 = tr_read<v_rd_off(D0, 2, 0)>(vb), h2 = tr_read<v_rd_off(D0, 2, 1)>(vb), l3 = tr_read<v_rd_off(D0, 3, 0)>(vb), h3 = tr_read<v_rd_off(D0, 3, 1)>(vb);
    asm volatile("s_waitcnt lgkmcnt(0)" ::: "memory"); SBAR();
#define PK(L, H) (bf16x8){L[0], L[1], L[2], L[3], H[0], H[1], H[2], H[3]}
    od = __builtin_amdgcn_mfma_f32_32x32x16_bf16(pa0, PK(l0, h0), od, 0, 0, 0);
    od = __builtin_amdgcn_mfma_f32_32x32x16_bf16(pa1, PK(l1, h1), od, 0, 0, 0);
    od = __builtin_amdgcn_mfma_f32_32x32x16_bf16(pa2, PK(l2, h2), od, 0, 0, 0);
    od = __builtin_amdgcn_mfma_f32_32x32x16_bf16(pa3, PK(l3, h3), od, 0, 0, 0);
#undef PK
}
template <int MAP> __device__ __forceinline__ void qkt_map(f32x16& p0, f32x16& p1, const LAS char* Ks, const bf16x8* qr, int r32, int hi, float cinit) {
#pragma unroll
    for (int r = 0; r < 16; ++r) { p0[r] = cinit; p1[r] = cinit; }
#pragma unroll
    for (int d0 = 4 * MAP; d0 < 4 * MAP + 4; ++d0) { const int cb = (d0 * 16 + hi * 8) * 2;
        const bf16x8 b0 = *(const LAS bf16x8*)(Ks + KSWZ(r32, cb));
        const bf16x8 b1 = *(const LAS bf16x8*)(Ks + KSWZ(32 + r32, cb));
        p0 = __builtin_amdgcn_mfma_f32_32x32x16_bf16(b0, qr[d0], p0, 0, 0, 0);
        p1 = __builtin_amdgcn_mfma_f32_32x32x16_bf16(b1, qr[d0], p1, 0, 0, 0); }
}
template <int HALF> __device__ __forceinline__ void qkt_half(f32x16& pm, f32x16& qm, const LAS char* Ks, const bf16x8* qr, int r32, int hi, float c0, float c1) {
#pragma unroll
    for (int r = 0; r < 16; ++r) { pm[r] = c0; qm[r] = c1; }
#pragma unroll
    for (int d0 = 0; d0 < 4; ++d0) {
        const bf16x8 b0 = *(const LAS bf16x8*)(Ks + KSWZ(32 * HALF + r32, (d0 * 16 + hi * 8) * 2));
        const bf16x8 b1 = *(const LAS bf16x8*)(Ks + KSWZ(32 * HALF + r32, ((4 + d0) * 16 + hi * 8) * 2));
        pm = __builtin_amdgcn_mfma_f32_32x32x16_bf16(b0, qr[d0], pm, 0, 0, 0);
        qm = __builtin_amdgcn_mfma_f32_32x32x16_bf16(b1, qr[4 + d0], qm, 0, 0, 0); }
}
__device__ __forceinline__ float swap_max(float v) { auto rr = __builtin_amdgcn_permlane32_swap(__float_as_uint(v), __float_as_uint(v), false, false); return fmaxf(__uint_as_float(rr[0]), __uint_as_float(rr[1])); }
__device__ __forceinline__ float swap_sum(float v) { auto rr = __builtin_amdgcn_permlane32_swap(__float_as_uint(v), __float_as_uint(v), false, false); return __uint_as_float(rr[0]) + __uint_as_float(rr[1]); }
constexpr float AT_THR = 8.0f;
__device__ __forceinline__ void online_ml(f32x16& p0, f32x16& p1, float& m, float& l, bool first) {
    float mx = p0[0];
#pragma unroll
    for (int r = 1; r < 16; ++r) mx = fmaxf(mx, p0[r]);
#pragma unroll
    for (int r = 0; r < 16; ++r) mx = fmaxf(mx, p1[r]);
    mx = swap_max(mx);
    if (first || __any(mx > AT_THR)) {
        const float d = (first || mx > AT_THR) ? mx : 0.f;
        m += d; l = first ? 0.f : l * __builtin_amdgcn_exp2f(-d);
#pragma unroll
        for (int r = 0; r < 16; ++r) { p0[r] -= d; p1[r] -= d; }
    }
    float s = 0.f;
#pragma unroll
    for (int r = 0; r < 16; ++r) s += __builtin_amdgcn_exp2f(p0[r]);
#pragma unroll
    for (int r = 0; r < 16; ++r) s += __builtin_amdgcn_exp2f(p1[r]);
    l += s;
}

struct ConvCur { unsigned wg0, nme; int k; int l; bool on; };
template <int MAP> __device__ __forceinline__ void attn_one_map(Frame& F, const bf16* Z, int b, int h, int qrow0, int NT, f32x16 (&o)[4], ConvCur& cv) {
    const size_t cn16 = (size_t)PEER_NEXP * 1024 / 16;
    const float* csu = F.peer_u + (size_t)cv.l * PEER_NEXP * 1024; const float* csv = F.peer_v + (size_t)cv.l * PEER_NEXP * 1024;
    LAS unsigned char* cst = F.lds + 131072 + F.wave * 4096;
    const bool cvw = cv.on && F.wave < 6;
    const int tid = F.tid, wid = F.wave, lane = F.lane, r32 = lane & 31, hi = lane >> 5;
    LAS char* V_lds = (LAS char*)F.lds; LAS char* K_lds = V_lds + 2 * AT_SHM_V;
    bf16x8 qr[8];
    {
#pragma unroll
      for (int d0 = 4 * MAP; d0 < 4 * MAP + 4; ++d0) qr[d0] = __builtin_bit_cast(bf16x8, ldz8(z8p(Z, (size_t)(qrow0 + wid * 32 + r32), ZQ + h * 128 + hi * 8 + d0 * 16))); }
    const int sr = tid >> 4, sc = (tid & 15) * 8, vst0 = v_st(sr, sc), vst1 = v_st(32 + sr, sc);
    const int kr = tid >> 3, kcol = 64 * MAP + (tid & 7) * 8, kc = kcol * 2;
    const int vb0 = (int)(uintptr_t)V_lds + v_rd_base(lane);
#define KBASE(j) ((size_t)((j) < 4 ? NLAT + b * 256 + (j) * 64 : b * 2048 + ((j) - 4) * 64) * (size_t)(ZW * 2))
    const char* Zc = (const char*)Z;
    const unsigned kofs = (unsigned)z8off(kr, ZK + h * 128 + kcol), vofs0 = (unsigned)z8off(sr, ZV + h * 128 + sc), vofs1 = vofs0 + (unsigned)(32 * ZW * 2);
#define PK4(P, BASE, OUT) do { unsigned a0 = cvtpk(P[BASE + 0], P[BASE + 1]), a1 = cvtpk(P[BASE + 2], P[BASE + 3]);   \
    unsigned b0 = cvtpk(P[BASE + 4], P[BASE + 5]), b1 = cvtpk(P[BASE + 6], P[BASE + 7]);                              \
    auto r0 = __builtin_amdgcn_permlane32_swap(a0, b0, false, false); auto r1 = __builtin_amdgcn_permlane32_swap(a1, b1, false, false); \
    v4u w_ = {r0[0], r1[0], r0[1], r1[1]}; OUT = __builtin_bit_cast(bf16x8, w_); } while (0)
    o[0] = f32x16{}; o[1] = f32x16{}; o[2] = f32x16{}; o[3] = f32x16{};
    float m = 0.f, l = 0.f;
    u32x2 ks = *(const u32x2*)(Zc + KBASE(0) + kofs);
    u32x2 vs0 = *(const u32x2*)(Zc + KBASE(0) + vofs0), vs1 = *(const u32x2*)(Zc + KBASE(0) + vofs1);
    *(LAS v4u*)(K_lds + KSWZ(kr, kc)) = fp8x8_bf16(ks);
    *(LAS v4u*)(V_lds + vst0) = fp8x8_bf16(vs0); *(LAS v4u*)(V_lds + vst1) = fp8x8_bf16(vs1);
    __syncthreads();
    for (int j = 0; j < NT; ++j) {
        const int cur = j & 1; const bool more = j + 1 < NT, first = j == 0;
        if (more) { const char* zt = Zc + KBASE(j + 1); ks = *(const u32x2*)(zt + kofs); vs0 = *(const u32x2*)(zt + vofs0); vs1 = *(const u32x2*)(zt + vofs1); }
        if (cvw && j % 3 == 0) { const size_t ci = (size_t)cv.wg0 + (unsigned)(F.wave * 64 + lane) + (size_t)cv.k * cv.nme;
            if (ci < 2 * cn16) { const float* s_ = ci < cn16 ? csu + ci * 16 : csv + (ci - cn16) * 16;
#pragma unroll
                for (int q = 0; q < 4; ++q) __builtin_amdgcn_global_load_lds((const GAS unsigned*)(s_ + 4 * q), (LAS unsigned*)(cst + q * 1024), 16, 0, 0); } }
        const LAS char* Kc = K_lds + cur * AT_SHM_K;
        f32x16 p0, p1;
        { float c = -m; asm volatile("" : "+v"(c)); qkt_map<MAP>(p0, p1, Kc, qr, r32, hi, c); }
        float mx = p0[0];
#pragma unroll
        for (int r = 1; r < 16; ++r) mx = fmaxf(mx, p0[r]);
#pragma unroll
        for (int r = 0; r < 16; ++r) mx = fmaxf(mx, p1[r]);
        mx = swap_max(mx);
        if (first || __any(mx > AT_THR)) {
            const float d = (first || mx > AT_THR) ? mx : 0.f;
            m += d;
#pragma unroll
            for (int r = 0; r < 16; ++r) { p0[r] -= d; p1[r] -= d; }
            if (!first) { const float f = __builtin_amdgcn_exp2f(-d); l *= f;
#pragma unroll
                for (int r = 0; r < 16; ++r) { const float fr = bperm(f, crow(r, hi));
                    o[0][r] *= fr; o[1][r] *= fr; o[2][r] *= fr; o[3][r] *= fr; } }
        }
        SBAR();
        float s = 0.f;
#pragma unroll
        for (int r = 0; r < 16; ++r) { p0[r] = __builtin_amdgcn_exp2f(p0[r]); s += p0[r]; }
#pragma unroll
        for (int r = 0; r < 16; ++r) { p1[r] = __builtin_amdgcn_exp2f(p1[r]); s += p1[r]; }
        l += s;
        bf16x8 pa0, pa1, pa2, pa3;
        PK4(p0, 0, pa0); PK4(p0, 8, pa1); PK4(p1, 0, pa2); PK4(p1, 8, pa3);
        SBAR();
        const int vb = vb0 + cur * AT_SHM_V;
        pv_one<0>(o[0], vb, pa0, pa1, pa2, pa3); pv_one<1>(o[1], vb, pa0, pa1, pa2, pa3); pv_one<2>(o[2], vb, pa0, pa1, pa2, pa3); pv_one<3>(o[3], vb, pa0, pa1, pa2, pa3);
        if (more) { LAS char* Kn = K_lds + (cur ^ 1) * AT_SHM_K; LAS char* Vn = V_lds + (cur ^ 1) * AT_SHM_V;
            *(LAS v4u*)(Kn + KSWZ(kr, kc)) = fp8x8_bf16(ks);
            *(LAS v4u*)(Vn + vst0) = fp8x8_bf16(vs0); *(LAS v4u*)(Vn + vst1) = fp8x8_bf16(vs1); }
        if (cvw && j % 3 == 2) { const size_t ci = (size_t)cv.wg0 + (unsigned)(F.wave * 64 + lane) + (size_t)cv.k * cv.nme;
          asm volatile("s_waitcnt vmcnt(0)" ::: "memory");
          if (ci < 2 * cn16) { const bool isu_ = ci < cn16; const size_t j_ = isu_ ? ci : ci - cn16; const float sc_ = isu_ ? PEER_USCALE : PEER_VSCALE;
            f32x4 ct[4];
#pragma unroll
            for (int q = 0; q < 4; ++q) ct[q] = *(const LAS f32x4*)(cst + q * 1024 + lane * 16);
            typedef float cv16f __attribute__((ext_vector_type(16))); typedef unsigned cv6u __attribute__((ext_vector_type(6)));
            cv16f a_, b_;
#pragma unroll
            for (int q = 0; q < 4; ++q) { a_[2 * q] = ct[q].x * sc_; b_[2 * q] = ct[q].y * sc_; a_[2 * q + 1] = ct[q].z * sc_; b_[2 * q + 1] = ct[q].w * sc_; }
#pragma unroll
            for (int q = 8; q < 16; ++q) { a_[q] = 0.f; b_[q] = 0.f; }
            const cv6u w_ = __builtin_amdgcn_cvt_scalef32_2xpk16_fp6_f32(a_, b_, 1.0f);
            unsigned* o_ = (unsigned*)((isu_ ? WSP(unsigned char, WS_TU) : WSP(unsigned char, WS_TV)) + j_ * 12); o_[0] = w_[0]; o_[1] = w_[1]; o_[2] = w_[2];
          }
        }
        if (cv.on && j % 3 == 2) cv.k += 1;
        __syncthreads();
    }
#undef PK4
#undef KBASE
    l = swap_sum(l);
    const float inv = 1.0f / l;
#pragma unroll
    for (int r = 0; r < 16; ++r) { const float fr = bperm(inv, crow(r, hi));
        o[0][r] *= fr; o[1][r] *= fr; o[2][r] *= fr; o[3][r] *= fr; }
}
__device__ __forceinline__ void attn_item(Frame& F, int l, int b, int h, int qb, float lam, float postscale, ConvCur& cv) {
    const int wid = F.wave, lane = F.lane, r32 = lane & 31, hi = lane >> 5;
    const bool ctxq = qb < 0; const int NT = ctxq ? 4 : 36;
    const int qrow0 = ctxq ? NLAT + b * 256 : b * 2048 + qb * 256;
    const bf16* Z = WSP(bf16, WS_Z);
    f32x16 o[4];
    {
        LAS char* stash = (LAS char*)F.lds + 2 * AT_SHM_V + 2 * AT_SHM_K + wid * 8192 + lane * 16;
        attn_one_map<0>(F, Z, b, h, qrow0, NT, o, cv);
#pragma unroll
        for (int d0 = 0; d0 < 4; ++d0)
#pragma unroll
            for (int i = 0; i < 2; ++i) { v4u w; w.x = cvtpk(o[d0][8 * i + 0], o[d0][8 * i + 1]); w.y = cvtpk(o[d0][8 * i + 2], o[d0][8 * i + 3]); w.z = cvtpk(o[d0][8 * i + 4], o[d0][8 * i + 5]); w.w = cvtpk(o[d0][8 * i + 6], o[d0][8 * i + 7]);
                *(LAS v4u*)(stash + (d0 * 2 + i) * 1024) = w; }
        SBAR();
        attn_one_map<1>(F, Z, b, h, qrow0, NT, o, cv);
        const float nlam = -lam;
#pragma unroll
        for (int d0 = 0; d0 < 4; ++d0)
#pragma unroll
            for (int i = 0; i < 2; ++i) { const v4u w = *(const LAS v4u*)(stash + (d0 * 2 + i) * 1024);
#pragma unroll
                for (int q = 0; q < 4; ++q) { o[d0][8 * i + 2 * q] = fmaf(nlam, o[d0][8 * i + 2 * q], __uint_as_float(w[q] << 16)); o[d0][8 * i + 2 * q + 1] = fmaf(nlam, o[d0][8 * i + 2 * q + 1], __uint_as_float(w[q] & 0xffff0000u)); } }
    }
    const float* sg = F.da_subln_g + l * 128;
    unsigned char* Yda = WSP(unsigned char, WS_Y);
    float g4[4];
#pragma unroll
    for (int d0 = 0; d0 < 4; ++d0) g4[d0] = sg[32 * d0 + r32] * postscale * ABLF(l, 0);
#pragma unroll
    for (int r = 0; r < 16; ++r) {
        float ss = (o[0][r] * o[0][r] + o[1][r] * o[1][r]) + (o[2][r] * o[2][r] + o[3][r] * o[3][r]);
        ss += swz<0x041F>(ss); ss += swz<0x081F>(ss); ss += swz<0x101F>(ss); ss += swz<0x201F>(ss); ss += swz<0x401F>(ss);
        const float rstd = 1.0f / sqrtf(ss * (1.0f / 128.0f) + EPS);
        unsigned char* yr = Yda + (size_t)(qrow0 + wid * 32 + crow(r, hi)) * 512 + h * 128 + r32;
#pragma unroll
        for (int d0 = 0; d0 < 4; ++d0) yr[32 * d0] = (unsigned char)f2fp8(o[d0][r] * rstd * g4[d0]);
    }
}
__device__ __forceinline__ void phase_attn(Frame& F0, int l) {
    PHASE_FRAME;
    const float lam = MISCF[MISC_LAM + l]; const float lam_init = 0.8f - 0.6f * expf(-0.3f * (float)l);
    const int nitems = l == 0 ? 288 : 256;
    const int nctx = (l == 0 && F.G == 256) ? 32 : 0; const bool do_conv = F.vcu >= nctx;
    const size_t cme = (size_t)(F.vcu - nctx) * NTHR + F.tid, cnme = (size_t)(F.G - nctx) * NTHR;
    const bool conv_first = (F.vcu & 1) == 0;
    (void)conv_first;
    ConvCur cv{(unsigned)((F.vcu - nctx) * 384), (unsigned)((F.G - nctx) * 384), 0, l, do_conv}; ConvCur cvoff{0u, 1u, 0, l, false}; (void)cme; (void)cnme;
    for (int it = F.vcu; it < nitems; it += F.G) {
        if (it < 256) attn_item(F, l, it >> 5, (it >> 3) & 3, it & 7, lam, 1.0f - lam_init, cv);
        else { const int j = it - 256; attn_item(F, l, j >> 2, j & 3, -1, lam, 1.0f - lam_init, cvoff); }
    }
    if (do_conv && F.wave < 6) peer_table_convert16(F, l, (size_t)cv.wg0 + (unsigned)(F.wave * 64 + F.lane) + (size_t)cv.k * cv.nme, (size_t)cv.nme);
}

__device__ __forceinline__ unsigned fkey(float f) { const unsigned b = __float_as_uint(f); return (b & 0x80000000u) ? ~b : (b | 0x80000000u); }
__device__ __forceinline__ float funkey(unsigned k) { return __uint_as_float((k & 0x80000000u) ? (k & 0x7fffffffu) : ~k); }
__device__ __forceinline__ void ins16(unsigned (&lst)[16], unsigned v) {
#pragma unroll
    for (int i = 0; i < 16; ++i) { const unsigned hi = lst[i] > v ? lst[i] : v; v = lst[i] > v ? v : lst[i]; lst[i] = hi; }
}
#define CE_D(a, b) do { const unsigned hi_ = (a) > (b) ? (a) : (b), lo_ = (a) > (b) ? (b) : (a); (a) = hi_; (b) = lo_; } while (0)
__device__ __forceinline__ void sort16_desc(unsigned (&k)[16]) {
#pragma unroll
    for (int kk = 2; kk <= 16; kk <<= 1)
#pragma unroll
        for (int j = kk >> 1; j > 0; j >>= 1)
#pragma unroll
            for (int i = 0; i < 16; ++i) { const int l = i ^ j;
                if (l > i) { if ((i & kk) == 0) CE_D(k[i], k[l]); else CE_D(k[l], k[i]); } }
}
__device__ __forceinline__ void merge16_desc(unsigned (&cur)[16], const unsigned (&blk)[16]) {
#pragma unroll
    for (int i = 0; i < 16; ++i) cur[i] = cur[i] > blk[15 - i] ? cur[i] : blk[15 - i];
#pragma unroll
    for (int j = 8; j > 0; j >>= 1)
#pragma unroll
        for (int i = 0; i < 16; ++i) { const int l = i ^ j; if (l > i) CE_D(cur[i], cur[l]); }
}
typedef short s16x2 __attribute__((ext_vector_type(2)));
__device__ __forceinline__ v4u ld16h(const LAS unsigned char* p) { return *(const LAS v4u*)p; }
__device__ __forceinline__ v4u ld16h(const unsigned char* p) { return *(const v4u*)p; }
template <class SP> __device__ __forceinline__ void peer_top16_of_128(SP s, unsigned (&lst)[16]) {
#pragma unroll 1
    for (int blk = 0; blk < 8; ++blk) {
        const v4u w0 = ld16h(s + blk * 16);
        const unsigned base = 127u - (unsigned)(blk * 16);
        unsigned ka[16];
#pragma unroll
        for (int t = 0; t < 4; ++t) { const unsigned w = w0[t];
            ka[4 * t] = (w << 24) | (base - (unsigned)(4 * t)); ka[4 * t + 1] = ((w << 16) & 0xFF000000u) | (base - (unsigned)(4 * t + 1));
            ka[4 * t + 2] = ((w << 8) & 0xFF000000u) | (base - (unsigned)(4 * t + 2)); ka[4 * t + 3] = (w & 0xFF000000u) | (base - (unsigned)(4 * t + 3)); }
        sort16_desc(ka);
        if (blk == 0) {
#pragma unroll
            for (int i = 0; i < 16; ++i) lst[i] = ka[i];
        } else merge16_desc(lst, ka);
    }
}
__device__ __forceinline__ float key16_score(unsigned key) { return ((float)(int)(key >> 24) - 128.0f) * (1.0f / PEER_SQ); }
__device__ __forceinline__ unsigned pick16(const unsigned (&P)[4], unsigned idx) {
    const unsigned sel = (idx & 7u) | 0x0c0c0c00u;
    const unsigned lo = __builtin_amdgcn_perm(P[1], P[0], sel), hi = __builtin_amdgcn_perm(P[3], P[2], sel);
    return (idx & 8u) ? hi : lo;
}
template <class IP, class GP> __device__ __forceinline__ void peer_topk_finish(const unsigned (&l0)[16], const unsigned (&l1)[16], IP eo, GP go) {
        float v0[16], v1[16]; unsigned P0[4], P1[4];
#pragma unroll
        for (int i = 0; i < 16; ++i) { v0[i] = key16_score(l0[i]); v1[i] = key16_score(l1[i]); }
#pragma unroll
        for (int q = 0; q < 4; ++q) {
            P0[q] = (127u - (l0[4 * q] & 127u)) | ((127u - (l0[4 * q + 1] & 127u)) << 8) | ((127u - (l0[4 * q + 2] & 127u)) << 16) | ((127u - (l0[4 * q + 3] & 127u)) << 24);
            P1[q] = (127u - (l1[4 * q] & 127u)) | ((127u - (l1[4 * q + 1] & 127u)) << 8) | ((127u - (l1[4 * q + 2] & 127u)) << 16) | ((127u - (l1[4 * q + 3] & 127u)) << 24); }
#define PKEY(i, j) ((fkey(v0[i] + v1[j]) & ~255u) | (255u - (unsigned)((i) * 16 + (j))))
        unsigned A[16], B[16], C[16], D[16];
#pragma unroll
        for (int j = 0; j < 16; ++j) A[j] = PKEY(0, j);
        {
            int cnt = 0;
#pragma unroll
            for (int i = 1; i < 16; ++i)
#pragma unroll
                for (int j = 0; j < 16; ++j) if ((i + 1) * (j + 1) <= 16) { const unsigned key = PKEY(i, j);
                    if (cnt < 16) B[cnt] = key; else if (cnt < 32) C[cnt - 16] = key; else D[cnt - 32] = key; ++cnt; }
#pragma unroll
            for (int c = 2; c < 16; ++c) D[c] = 0u;
        }
#undef PKEY
        sort16_desc(B); sort16_desc(C); sort16_desc(D);
        merge16_desc(A, B); merge16_desc(C, D); merge16_desc(A, C);
        float bs[16]; float mx = funkey(A[0] & ~255u), sum = 0.f;
#pragma unroll
        for (int r = 0; r < 16; ++r) { bs[r] = __expf(funkey(A[r] & ~255u) - mx); sum += bs[r]; }
        const float inv = 1.0f / sum;
#pragma unroll
        for (int r = 0; r < 16; ++r) { const unsigned flat = 255u - (A[r] & 255u);
            eo[r] = (int)(pick16(P0, flat >> 4) * 128u + pick16(P1, flat)); go[r] = bs[r] * inv; }
}
template <class IP, class GP> __device__ __forceinline__ void peer_topk_problem(const unsigned char* SC, int row, int hh, IP eo, GP go) {
    const unsigned char* sp = SC + (size_t)row * 2048 + hh * 256;
    unsigned l0[16], l1[16];
    peer_top16_of_128(sp, l0); peer_top16_of_128(sp + 128, l1);
    peer_topk_finish(l0, l1, eo, go);
}
__device__ __forceinline__ void phase_peer_topk(Frame& F0, int l) {
    PHASE_FRAME;
    const int nprob = (l == 0 ? NROW : NLAT) * 8;
    const unsigned char* SC = WSP(unsigned char, WS_SC);
    LAS char* stg = (LAS char*)F.lds + F.wave * 17408;
    const int lane = F.lane;
    const int ntask = nprob / 64, nbase = F.G * NWAVES;
    const bool spread = ntask >= nbase && ntask - nbase <= F.G;
    for (int k = 0;; ++k) {
        int task;
        if (spread) { if (k == 0) task = F.vcu * NWAVES + F.wave; else if (k == 1 && F.wave == (F.vcu & 7) && nbase + F.vcu < ntask) task = nbase + F.vcu; else break; }
        else { task = F.vcu * NWAVES + F.wave + k * nbase; if (task >= ntask) break; }
        const int pbase = task * 64;
        unsigned l0[16], l1[16];
#pragma unroll
        for (int q = 0; q < 16; ++q) { const int pw = 4 * q + (lane >> 4), pid = pbase + pw, chunk = lane & 15;
            const v4u w = *(const v4u*)(SC + (size_t)(pid >> 3) * 2048 + (pid & 7) * 256 + chunk * 16);
            *(LAS v4u*)(stg + pw * 272 + chunk * 16) = w; }
        asm volatile("s_waitcnt lgkmcnt(0)" ::: "memory");
        peer_top16_of_128((const LAS unsigned char*)(stg + lane * 272), l0); peer_top16_of_128((const LAS unsigned char*)(stg + lane * 272 + 128), l1);
        asm volatile("s_waitcnt lgkmcnt(0)" ::: "memory");
        const int pid = pbase + lane, row = pid >> 3, hh = pid & 7;
        peer_topk_finish(l0, l1, WSP(int, WS_EIDX) + (size_t)row * 128 + hh * 16, WSP(float, WS_EGATE) + (size_t)row * 128 + hh * 16);
    }
}

typedef float f32x2v __attribute__((ext_vector_type(2)));
__device__ __forceinline__ void fp8x16_to_f32(const v4u w, float (&f)[16]) {
#pragma unroll
    for (int q = 0; q < 4; ++q) { const f32x2v a = __builtin_amdgcn_cvt_pk_f32_fp8((int)w[q], false), b = __builtin_amdgcn_cvt_pk_f32_fp8((int)w[q], true);
        f[4 * q] = a.x; f[4 * q + 1] = a.y; f[4 * q + 2] = b.x; f[4 * q + 3] = b.y; }
}
typedef unsigned v3u __attribute__((ext_vector_type(3)));
typedef unsigned v6u __attribute__((ext_vector_type(6)));
typedef float v32f __attribute__((ext_vector_type(32)));
__device__ __forceinline__ v32f fp6x32_to_f32(const v3u a, const v3u b) { const v6u w = {a.x, a.y, a.z, b.x, b.y, b.z}; return __builtin_amdgcn_cvt_scalef32_pk32_f32_fp6(w, 1.0f); }
__device__ __forceinline__ const GAS unsigned* srow(const unsigned char* tab, int e, unsigned lane12) { asm volatile("" : "+v"(lane12));
    return (const GAS unsigned*)((const GAS unsigned char*)tab + (size_t)(unsigned)e * (unsigned)PEER_ROWB + lane12); }
#ifndef PG_SORT
#define PG_SORT 1
#endif
template <int K, int J> __device__ __forceinline__ void bsort_step(unsigned& a, unsigned& b, int lane) {
    if constexpr (J == 64) { const unsigned lo = a < b ? a : b, hi = a < b ? b : a; a = lo; b = hi; }
    else {
        unsigned pa, pb;
        if constexpr (J == 32) { pa = (unsigned)__builtin_amdgcn_ds_bpermute((lane ^ 32) << 2, (int)a); pb = (unsigned)__builtin_amdgcn_ds_bpermute((lane ^ 32) << 2, (int)b); }
        else { pa = (unsigned)__builtin_amdgcn_ds_swizzle((int)a, 0x1F | (J << 10)); pb = (unsigned)__builtin_amdgcn_ds_swizzle((int)b, 0x1F | (J << 10)); }
        const bool lower = (lane & J) == 0;
        bool asca, ascb;
        if constexpr (K < 64) { asca = (lane & K) == 0; ascb = asca; } else if constexpr (K == 64) { asca = true; ascb = false; } else { asca = true; ascb = true; }
        const unsigned mna = a < pa ? a : pa, mxa = a < pa ? pa : a, mnb = b < pb ? b : pb, mxb = b < pb ? pb : b;
        a = (lower == asca) ? mna : mxa; b = (lower == ascb) ? mnb : mxb;
    }
}
template <int K, int J> __device__ __forceinline__ void bsort_stage(unsigned& a, unsigned& b, int lane) { bsort_step<K, J>(a, b, lane); if constexpr (J > 1) bsort_stage<K, J / 2>(a, b, lane); }
__device__ __forceinline__ void bsort128(unsigned& a, unsigned& b, int lane) {
    bsort_stage<2, 1>(a, b, lane); bsort_stage<4, 2>(a, b, lane); bsort_stage<8, 4>(a, b, lane); bsort_stage<16, 8>(a, b, lane);
    bsort_stage<32, 16>(a, b, lane); bsort_stage<64, 32>(a, b, lane); bsort_stage<128, 64>(a, b, lane);
}
__device__ __forceinline__ unsigned pick_key(int id, float g) { return ((unsigned)id << 16) | (unsigned)__builtin_bit_cast(unsigned short, (_Float16)g); }
__device__ __forceinline__ float key_gate(unsigned k) { return (float)__builtin_bit_cast(_Float16, (unsigned short)(k & 0xffffu)); }
template <int NB, bool LIDX, bool PIPE = false> __device__ __forceinline__ void phase_peer_gather(Frame& F0, int l, bool dry, int mode) {
    PHASE_FRAME;
    const int gw = mode == 0 ? F.vcu * NWAVES + F.wave : ((int)blockIdx.x - 128) * NWAVES + F.wave, NGW = mode == 0 ? F.G * NWAVES : 1024;
    const int nrows = l == 0 ? NROW : NLAT;
    LAS int* EIl = (LAS int*)(F.lds + 65536); LAS float* EGl = (LAS float*)(F.lds + 65536 + 72 * 128 * 4);
    const int rpb = nrows / 256, brow0 = (int)blockIdx.x * rpb;
    if (LIDX) {
        const unsigned char* SCp = WSP(unsigned char, WS_SC);
        for (int pr = F.tid; pr < rpb * 8; pr += NTHR) { const int rl = pr >> 3, hh = pr & 7; peer_topk_problem(SCp, brow0 + rl, hh, EIl + rl * 128 + hh * 16, EGl + rl * 128 + hh * 16); }
        __syncthreads();
    }
    const bf16* H = WSP(bf16, WS_H); const unsigned char* TU = WSP(unsigned char, WS_TU); const unsigned char* TV = WSP(unsigned char, WS_TV);
    const int* EI = WSP(int, WS_EIDX); const float* EG = WSP(float, WS_EGATE);
    const bool fuse_n1 = (l + 1 < DEPTH) && !dry;
    LAS float* wg = (LAS float*)F.lds;
    if (fuse_n1) {
        const float* src = WSP(float, WS_WG) + (size_t)(l + 1) * 16384;
        for (int e = F.tid * 4; e < 16384; e += NTHR * 4) *(LAS f32x4*)(wg + e) = *(const f32x4*)(src + e);
        __syncthreads();
    }
    constexpr bool PREF = PG_SORT && NB == 16 && !LIDX && !PIPE;
    int pfiA = 0, pfiB = 0; float pfgA = 0.f, pfgB = 0.f; v4u pfh = {0u, 0u, 0u, 0u};
    if (PREF && gw < nrows) { const int lane = F.lane;
        pfiA = EI[(size_t)gw * 128 + lane]; pfiB = EI[(size_t)gw * 128 + 64 + lane]; pfgA = EG[(size_t)gw * 128 + lane]; pfgB = EG[(size_t)gw * 128 + 64 + lane];
        pfh = *(const v4u*)(WSP(unsigned char, WS_H8) + (size_t)gw * 1024 + lane * 16); }
    for (int rit = 0;; ++rit) {
        const int rl = F.wave + 8 * rit, row = LIDX ? brow0 + rl : gw + rit * NGW;
        if (LIDX ? rl >= rpb : row >= nrows) break;
        int lane = F.lane; asm volatile("" : "+v"(lane));
        const int myi = red16_index(lane); const unsigned lane12 = (unsigned)lane * 12u;
        float hf[16];
        unsigned kA = 0u, kB = 0u;
        { v4u w8;
          if constexpr (PREF) { w8 = pfh; kA = pick_key(pfiA, pfgA); kB = pick_key(pfiB, pfgB);
              const int nrow = row + NGW;
              if (nrow < nrows) { pfiA = EI[(size_t)nrow * 128 + lane]; pfiB = EI[(size_t)nrow * 128 + 64 + lane]; pfgA = EG[(size_t)nrow * 128 + lane]; pfgB = EG[(size_t)nrow * 128 + 64 + lane];
                  pfh = *(const v4u*)(WSP(unsigned char, WS_H8) + (size_t)nrow * 1024 + lane * 16); } }
          else w8 = *(const v4u*)(WSP(unsigned char, WS_H8) + (size_t)row * 1024 + lane * 16);
#pragma unroll
          for (int q = 0; q < 4; ++q) { const f32x2v a = __builtin_amdgcn_cvt_pk_f32_fp8((int)w8[q], false), b = __builtin_amdgcn_cvt_pk_f32_fp8((int)w8[q], true);
              hf[4 * q] = a.x; hf[4 * q + 1] = a.y; hf[4 * q + 2] = b.x; hf[4 * q + 3] = b.y; } }
        v4u xpf0 = {0u, 0u, 0u, 0u}, xpf1 = {0u, 0u, 0u, 0u};
        if (row < NLAT) { const char* xs_ = (const char*)F.out + (size_t)row * 4096 + lane * 32; xpf0 = *(const v4u*)xs_; xpf1 = *(const v4u*)(xs_ + 16); }
        float y[16];
#pragma unroll
        for (int i = 0; i < 16; ++i) y[i] = 0.f;
        if constexpr (PIPE) {
            const int idA = EI[(size_t)row * 128 + lane], idB = EI[(size_t)row * 128 + 64 + lane]; const float gA = EG[(size_t)row * 128 + lane], gB = EG[(size_t)row * 128 + 64 + lane];
            v3u ru[16], rv[16];
#define PG_LOAD(dst, TAB, idv, lb) _Pragma("unroll") for (int i = 0; i < 16; ++i) { const int e = __builtin_amdgcn_readlane(idv, (lb) + i); const GAS unsigned* pp = srow(TAB, e, lane12); dst[i] = (v3u){pp[0], pp[1], pp[2]}; }
#define PG_MB() do { asm volatile("" ::: "memory"); SBAR(); } while (0)
#define PG_OPQ(r) asm volatile("" : "+v"(r))
            PG_LOAD(ru, TU, idA, 0);
            PG_MB();
#pragma unroll 1
            for (int kb = 0; kb < 128; kb += 16) {
                const int idv = kb < 64 ? idA : idB; const int lb = kb & 63;
                PG_LOAD(rv, TV, idv, lb);
                PG_MB();
                float p[16];
#pragma unroll
                for (int i = 0; i < 16; i += 2) { v3u r0 = ru[i], r1 = ru[i + 1]; PG_OPQ(r0); PG_OPQ(r1); const v32f a = fp6x32_to_f32(r0, r1);
                    f32x2v s0 = {0.f, 0.f}, s1 = {0.f, 0.f};
#pragma unroll
                    for (int q = 0; q < 8; ++q) { const f32x2v h2 = {hf[2 * q], hf[2 * q + 1]};
                        s0 = __builtin_elementwise_fma((f32x2v){a[2 * q], a[2 * q + 1]}, h2, s0); s1 = __builtin_elementwise_fma((f32x2v){a[16 + 2 * q], a[17 + 2 * q]}, h2, s1); }
                    p[i] = s0.x + s0.y; p[i + 1] = s1.x + s1.y; SBAR(); }
                const float act = reduce16(p, lane) * (1.0f / PEER_USCALE);
                const float myg = bperm(kb < 64 ? gA : gB, lb + myi);
                const float wv = myg * gelu_exact(act) * ABLF(l, 3) * (1.0f / PEER_VSCALE);
                PG_MB();
                if (kb + 16 < 128) { const int kn = kb + 16; const int idn = kn < 64 ? idA : idB; const int ln = kn & 63; PG_LOAD(ru, TU, idn, ln); }
                PG_MB();
#pragma unroll
                for (int i = 0; i < 16; i += 2) { const float w0 = rlane(wv, red16_lane(i)), w1 = rlane(wv, red16_lane(i + 1));
                    v3u r0 = rv[i], r1 = rv[i + 1]; PG_OPQ(r0); PG_OPQ(r1); const v32f a = fp6x32_to_f32(r0, r1);
#pragma unroll
                    for (int q = 0; q < 8; ++q) { f32x2v yy = {y[2 * q], y[2 * q + 1]};
                        yy = __builtin_elementwise_fma((f32x2v){w0, w0}, (f32x2v){a[2 * q], a[2 * q + 1]}, yy); yy = __builtin_elementwise_fma((f32x2v){w1, w1}, (f32x2v){a[16 + 2 * q], a[17 + 2 * q]}, yy);
                        y[2 * q] = yy.x; y[2 * q + 1] = yy.y; }
                    SBAR(); }
            }
#undef PG_LOAD
#undef PG_MB
#undef PG_OPQ
        } else {
        constexpr bool SORTED = PG_SORT && NB == 16 && !LIDX;
#ifndef PG_DOSORT
#define PG_DOSORT 0
#endif
        if constexpr (SORTED && PG_DOSORT) bsort128(kA, kB, lane);
#pragma unroll 1
        for (int kb = 0; kb < 128; kb += 16) {
            int mye; float myg;
            if constexpr (SORTED) { const unsigned kk = (unsigned)__builtin_amdgcn_ds_bpermute(((kb & 63) + myi) << 2, (int)(kb < 64 ? kA : kB)); mye = (int)(kk >> 16); myg = key_gate(kk); }
            else { mye = LIDX ? EIl[rl * 128 + kb + myi] : EI[(size_t)row * 128 + kb + myi]; myg = LIDX ? EGl[rl * 128 + kb + myi] : EG[(size_t)row * 128 + kb + myi]; }
            float p[16]; v3u raw[NB];
#pragma unroll
            for (int hb = 0; hb < 16; hb += NB) {
#pragma unroll
                for (int i = 0; i < NB; ++i) { const int e = __builtin_amdgcn_readlane(mye, red16_lane(hb + i)); const GAS unsigned* pp = srow(TU, e, lane12); raw[i] = (v3u){pp[0], pp[1], pp[2]}; }
                SBAR();
#pragma unroll
                for (int i = 0; i < NB; i += 2) { const v32f a = fp6x32_to_f32(raw[i], raw[i + 1]);
                    f32x2v s0 = {0.f, 0.f}, s1 = {0.f, 0.f};
#pragma unroll
                    for (int q = 0; q < 8; ++q) { const f32x2v h2 = {hf[2 * q], hf[2 * q + 1]};
                        s0 = __builtin_elementwise_fma((f32x2v){a[2 * q], a[2 * q + 1]}, h2, s0); s1 = __builtin_elementwise_fma((f32x2v){a[16 + 2 * q], a[17 + 2 * q]}, h2, s1); }
                    p[hb + i] = s0.x + s0.y; p[hb + i + 1] = s1.x + s1.y; SBAR(); } }
            const float act = reduce16(p, lane) * (1.0f / PEER_USCALE);
            const float wv = myg * gelu_exact(act) * ABLF(l, 3) * (1.0f / PEER_VSCALE);
#pragma unroll
            for (int hb = 0; hb < 16; hb += NB) {
#pragma unroll
                for (int i = 0; i < NB; ++i) { const int e = __builtin_amdgcn_readlane(mye, red16_lane(hb + i)); const GAS unsigned* pp = srow(TV, e, lane12); raw[i] = (v3u){pp[0], pp[1], pp[2]}; }
                SBAR();
#pragma unroll
                for (int i = 0; i < NB; i += 2) { const float w0 = __uint_as_float(__builtin_amdgcn_readlane(__float_as_uint(wv), red16_lane(hb + i))), w1 = __uint_as_float(__builtin_amdgcn_readlane(__float_as_uint(wv), red16_lane(hb + i + 1)));
                    const v32f a = fp6x32_to_f32(raw[i], raw[i + 1]);
#pragma unroll
                    for (int q = 0; q < 8; ++q) { f32x2v yy = {y[2 * q], y[2 * q + 1]};
                        yy = __builtin_elementwise_fma((f32x2v){w0, w0}, (f32x2v){a[2 * q], a[2 * q + 1]}, yy); yy = __builtin_elementwise_fma((f32x2v){w1, w1}, (f32x2v){a[16 + 2 * q], a[17 + 2 * q]}, yy);
                        y[2 * q] = yy.x; y[2 * q + 1] = yy.y; }
                    SBAR(); } }
        }
        }
        const bool lat = row < NLAT;
        float* xr = (lat ? F.out + (size_t)row * 1024 : WSP(float, WS_XC) + (size_t)(row - NLAT) * 1024) + lane * 16;
        const float* g2 = WSP(float, WS_MOD) + (size_t)(l * 9 + (lat ? (row >> 11) : 8)) * 6144 + 5 * 1024 + lane * 16;
        float xo[16], gg[8], xx[8];
        char* xslot = (char*)F.out + (size_t)row * 4096;
        if (lat) unpack8(xpf0, xx); else ld8f(xr, xx);
        ld8f(g2, gg);
#pragma unroll
        for (int q = 0; q < 8; ++q) xo[q] = xx[q] + gg[q] * y[q];
        if (lat) unpack8(xpf1, xx); else ld8f(xr + 8, xx);
        ld8f(g2 + 8, gg);
#pragma unroll
        for (int q = 0; q < 8; ++q) xo[8 + q] = xx[q] + gg[q] * y[8 + q];
        if (l == DEPTH - 1) {
            float ss = 0.f;
#pragma unroll
            for (int q = 0; q < 16; ++q) ss += xo[q] * xo[q];
            const float rstd = 1.0f / sqrtf(wave_sum(ss) * (1.0f / 1024.0f) + EPS);
            ld8f(F.final_g + lane * 16, gg);
#pragma unroll
            for (int q = 0; q < 8; ++q) xo[q] = xo[q] * rstd * gg[q];
            ld8f(F.final_g + lane * 16 + 8, gg);
#pragma unroll
            for (int q = 0; q < 8; ++q) xo[8 + q] = xo[8 + q] * rstd * gg[q];
        }
        if (!dry || xo[0] == 1234.567f) {
            if (lat && l != DEPTH - 1) {
                float t[8];
#pragma unroll
                for (int q = 0; q < 8; ++q) t[q] = xo[q];
                *(v4u*)(xslot + lane * 32) = pack8(t);
#pragma unroll
                for (int q = 0; q < 8; ++q) t[q] = xo[8 + q];
                *(v4u*)(xslot + lane * 32 + 16) = pack8(t);
            } else {
#pragma unroll
                for (int q = 0; q < 4; ++q) *(f32x4*)(xr + 4 * q) = (f32x4){xo[4 * q], xo[4 * q + 1], xo[4 * q + 2], xo[4 * q + 3]}; } }
        if (fuse_n1) {
            float ss = 0.f;
#pragma unroll
            for (int q = 0; q < 16; ++q) ss += xo[q] * xo[q];
            const float rstd = 1.0f / sqrtf(wave_sum(ss) * (1.0f / 1024.0f) + EPS);
            const float* gn = F.norm1_g + (l + 1) * 1024 + lane * 16;
            const float* mod = WSP(float, WS_MOD) + (size_t)((l + 1) * 9 + (lat ? (row >> 11) : 8)) * 6144 + lane * 16;
            float hh[16], sh[8], sc[8];
            ld8f(gn, gg); ld8f(mod, sh); ld8f(mod + 1024, sc);
#pragma unroll
            for (int q = 0; q < 8; ++q) hh[q] = (xo[q] * rstd * gg[q]) * (sc[q] + 1.0f) + sh[q];
            ld8f(gn + 8, gg); ld8f(mod + 8, sh); ld8f(mod + 1024 + 8, sc);
#pragma unroll
            for (int q = 0; q < 8; ++q) hh[8 + q] = (xo[8 + q] * rstd * gg[q]) * (sc[q] + 1.0f) + sh[q];
            bf16* hp = WSP(bf16, WS_H) + (size_t)row * 1024 + lane * 16;
            { v4u w8; w8.x = pk4fp8(hh[0], hh[1], hh[2], hh[3]); w8.y = pk4fp8(hh[4], hh[5], hh[6], hh[7]); w8.z = pk4fp8(hh[8], hh[9], hh[10], hh[11]); w8.w = pk4fp8(hh[12], hh[13], hh[14], hh[15]);
              *(v4u*)(WSP(unsigned char, WS_H8) + (size_t)row * 1024 + lane * 16) = w8; }
            { float t[8];
#pragma unroll
              for (int q = 0; q < 8; ++q) t[q] = hh[q];
              const v4u w0 = pack8(t);
#pragma unroll
              for (int q = 0; q < 8; ++q) t[q] = hh[8 + q];
              const v4u w1 = pack8(t);
              if (mode == 0) { *(v4u*)hp = w0; *(v4u*)(hp + 8) = w1; }
              else {
                  gu64* h8 = (gu64*)hp;
                  __hip_atomic_store(h8 + 0, ((unsigned long long)w0.y << 32) | w0.x, RLX_AGENT); __hip_atomic_store(h8 + 1, ((unsigned long long)w0.w << 32) | w0.z, RLX_AGENT);
                  __hip_atomic_store(h8 + 2, ((unsigned long long)w1.y << 32) | w1.x, RLX_AGENT); __hip_atomic_store(h8 + 3, ((unsigned long long)w1.w << 32) | w1.z, RLX_AGENT); } }
            float p[16];
#pragma unroll
            for (int jj = 0; jj < 16; ++jj) { float sacc = 0.f;
#pragma unroll
                for (int q4 = 0; q4 < 4; ++q4) { const f32x4 w = *(LAS f32x4*)(wg + jj * 1024 + lane * 16 + 4 * q4);
                    sacc += (hh[4 * q4] * w.x + hh[4 * q4 + 1] * w.y) + (hh[4 * q4 + 2] * w.z + hh[4 * q4 + 3] * w.w); }
                p[jj] = sacc; if ((jj & 3) == 3) SBAR(); }
            const float tot = reduce16(p, lane);
            if ((lane & 3) == 0) WSP(float, WS_G)[(size_t)row * 16 + myi] = tot;
            if (mode != 0) {
                asm volatile("s_waitcnt vmcnt(0)" ::: "memory");
                if (lane == 0) __hip_atomic_fetch_add((unsigned*)(F.ctl + CW_TILE + 64 * (row >> 8)), 1u, RLX_AGENT);
            }
        }
    }
}

#ifndef PG8_SP2
#define PG8_SP2 true
#endif
#ifndef PG8_ALIGN
#define PG8_ALIGN true
#endif
__device__ __forceinline__ void phase_gemm_in(Frame& F0, int l) {
    PHASE_FRAME;
    pg8::EpiZ E{(pg8::bf16_t*)WSP(bf16, WS_Z), ZW, MISCF + MISC_COS, MISCF + MISC_SIN, NLAT, QSCALE, Z8COLS / 256, ZGT / 256};
    { pg8::Gemm g{(const pg8::bf16_t*)WSP(unsigned char, WS_H8), (const pg8::bf16_t*)(WSP(unsigned char, WS_WIN) + (size_t)l * ZW * 1024), NROW, ZW, 512};
      pg8::SubOrder S; S.S.init(NROW, ZW - (ZGT - ZBG), F.G, (int)blockIdx.x); S.cut = ZBG / 256; S.skip = (ZGT - ZBG) / 256; S.base = 0;
      pg8::gemm_phase<pg8::EpiZ, pg8::SubOrder, PG8_ALIGN, PG8_SP2, true>(F.lds, g, S, E, F.wave); }
    __syncthreads();
    { pg8::Gemm g{(const pg8::bf16_t*)WSP(bf16, WS_H), (const pg8::bf16_t*)(WSP(bf16, WS_WINC) + (size_t)l * (ZGT - ZBG) * 1024) - (size_t)ZBG * 1024, NROW, ZW, 1024};
      pg8::SubOrder S; S.S.init(NROW, ZGT - ZBG, F.G, F.G - 1 - (int)blockIdx.x); S.cut = 1 << 20; S.skip = 0; S.base = ZBG / 256;
      pg8::gemm_phase<pg8::EpiZ, pg8::SubOrder, PG8_ALIGN, PG8_SP2>(F.lds, g, S, E, F.wave); }
}
#ifdef PROBE_G1
__device__ __forceinline__ void phase_gemm_in_probe(Frame& F0, int l) {
    PHASE_FRAME;
    pg8::EpiNull E{(pg8::bf16_t*)WSP(bf16, WS_Z)};
    { pg8::Gemm g{(const pg8::bf16_t*)WSP(unsigned char, WS_H8), (const pg8::bf16_t*)(WSP(unsigned char, WS_WIN) + (size_t)l * ZW * 1024), NROW, ZW, 512};
      pg8::SubOrder S; S.S.init(NROW, ZW - (ZGT - ZBG), F.G, (int)blockIdx.x); S.cut = ZBG / 256; S.skip = (ZGT - ZBG) / 256; S.base = 0;
      pg8::gemm_phase<pg8::EpiNull, pg8::SubOrder, PG8_ALIGN, PG8_SP2, true>(F.lds, g, S, E, F.wave); }
    __syncthreads();
    { pg8::Gemm g{(const pg8::bf16_t*)WSP(bf16, WS_H), (const pg8::bf16_t*)(WSP(bf16, WS_WINC) + (size_t)l * (ZGT - ZBG) * 1024) - (size_t)ZBG * 1024, NROW, ZW, 1024};
      pg8::SubOrder S; S.S.init(NROW, ZGT - ZBG, F.G, F.G - 1 - (int)blockIdx.x); S.cut = 1 << 20; S.skip = 0; S.base = ZBG / 256;
      pg8::gemm_phase<pg8::EpiNull, pg8::SubOrder, PG8_ALIGN, PG8_SP2>(F.lds, g, S, E, F.wave); }
    __syncthreads();
}
#endif
__device__ __forceinline__ void phase_gemm_merge(Frame& F0, int l) {
    PHASE_FRAME;
    const int nrows = l == 0 ? NROW : NLAT;
    const bool spread = l == 0 && F.G == 256;
    pg8::EpiMerge E{(const pg8::bf16_t*)WSP(bf16, WS_Z), (pg8::bf16_t*)WSP(bf16, WS_H), NROW / 256, ZW, ZGT, (pg8::bf16_t*)WSP(bf16, WS_ST), (unsigned*)(F.ctl + CW_TILE), spread ? NLAT / 256 : -1};
    const int ntile = spread ? 256 : (nrows / 256) * 4;
    { pg8::Gemm g{(const pg8::bf16_t*)WSP(unsigned char, WS_Y), (const pg8::bf16_t*)(WSP(unsigned char, WS_WBR) + (size_t)l * 3 * 1024 * 512 * 2), 2 * NROW, 2 * 1024, 256};
      pg8::MergeOrder S{ntile, F.G, F.vcu, NROW / 256, 2, 0, 0, spread ? 64 : 0, 256};
      pg8::gemm_phase<pg8::EpiMerge, pg8::MergeOrder, PG8_ALIGN, PG8_SP2, true>(F.lds, g, S, E, F.wave); }
    __syncthreads();
    { pg8::Gemm g{(const pg8::bf16_t*)WSP(bf16, WS_Y), (const pg8::bf16_t*)(WSP(bf16, WS_WBR) + (size_t)l * 3 * 1024 * 512), 3 * NROW, 3 * 1024, 512};
      pg8::MergeOrder S{ntile, F.G, F.vcu, NROW / 256, 1, 2, 64, spread ? 32 : 0, 256};
      pg8::gemm_phase<pg8::EpiMerge, pg8::MergeOrder, PG8_ALIGN, PG8_SP2>(F.lds, g, S, E, F.wave); }
    if (DEFER_PROLOGUE && l == 0 && F.G == 256 && F.vcu >= 32) { __syncthreads(); prologue_wqk(F, F.vcu - 32, 224); }
}
__device__ __forceinline__ void phase_gemm_out(Frame& F0, int l) {
    PHASE_FRAME;
    const int nrows = l == 0 ? NROW : NLAT;
    pg8::Gemm g{(const pg8::bf16_t*)WSP(bf16, WS_H), (const pg8::bf16_t*)(WSP(bf16, WS_WO) + (size_t)l * 1024 * 1024), nrows, 1024, 1024};
    pg8::StaticOrder S; S.init(nrows, 1024, F.G, (int)blockIdx.x);
    pg8::EpiRes E{l == 0 ? F.x : F.out, F.out, l == 0 ? F.ctx : WSP(float, WS_XC), WSP(float, WS_XC), WSP(float, WS_MOD) + (size_t)l * 9 * 6144, 2 * 1024, NLAT, l == 0};
    pg8::gemm_phase<pg8::EpiRes, pg8::StaticOrder, PG8_ALIGN, PG8_SP2>(F.lds, g, S, E, F.wave);

}
__device__ __forceinline__ void phase_gemm_peerq(Frame& F0, int l) {
    PHASE_FRAME;
    const int nrows = l == 0 ? NROW : NLAT;
    pg8::Gemm g{(const pg8::bf16_t*)WSP(unsigned char, WS_H8), (const pg8::bf16_t*)(WSP(unsigned char, WS_WQK) + (size_t)l * 2048 * 1024), nrows, 2048, 512};
    pg8::StaticOrder S; S.init(nrows, 2048, F.G, (int)blockIdx.x);
    pg8::EpiStore8 E{WSP(unsigned char, WS_SC), 2048, PEER_SQ};
    pg8::gemm_phase<pg8::EpiStore8, pg8::StaticOrder, PG8_ALIGN, PG8_SP2, true>(F.lds, g, S, E, F.wave);
    if (DEFER_PROLOGUE && l == 0 && F.G == 256 && (int)blockIdx.x >= 64) { __syncthreads();
        prologue_transposes(F, 1, ((int)blockIdx.x - 64) * NWAVES + F.wave, 192 * NWAVES);
        peer_table_convert(F, 1, (size_t)((int)blockIdx.x - 64) * NTHR + F.tid, (size_t)192 * NTHR); }
}

struct TileWaitOrder {
    int isA, blk, wave; const unsigned* ready; unsigned* tmo;
    __device__ __forceinline__ bool next(int i, pg8::Unit& u) const {
        if (isA) { if (i < 16) { const int x = blk & 7, j = blk >> 3; u.pm = 4 * i + (j >> 2); u.pn = 4 * x + (j & 3); return true; }
                   if (i == 16) { u.pm = 64 + (blk >> 5); u.pn = blk & 31; return true; } return false; }
        if (i == 0) { u.pm = 64 + (blk >> 5); u.pn = blk & 31; return true; } return false;
    }
    __device__ __forceinline__ void a_ready(const pg8::Unit& u) const {
        if (wave == 0) {
            const unsigned long long t0 = __builtin_amdgcn_s_memrealtime(); unsigned polls = 0;
            while ((unsigned)__builtin_amdgcn_readfirstlane(__hip_atomic_load(ready + 64 * u.pm, __ATOMIC_RELAXED, __HIP_MEMORY_SCOPE_AGENT)) < 256u) {
                if ((++polls & 255u) == 0u && __builtin_amdgcn_readfirstlane(__hip_atomic_load(tmo, __ATOMIC_RELAXED, __HIP_MEMORY_SCOPE_AGENT)) != 0u) break;
                if (__builtin_amdgcn_s_memrealtime() - t0 > 2000000ull) { __hip_atomic_store(tmo, 1u, __ATOMIC_RELAXED, __HIP_MEMORY_SCOPE_AGENT); break; }
                __builtin_amdgcn_s_sleep(2); }
            __builtin_amdgcn_fence(__ATOMIC_ACQUIRE, "agent");
            asm volatile("s_waitcnt vmcnt(0)" ::: "memory");
        }
        asm volatile("" ::: "memory"); __builtin_amdgcn_s_barrier(); asm volatile("" ::: "memory");
    }
    __device__ __forceinline__ void done(const pg8::Unit&) const {}
};
__device__ __forceinline__ void phase_gather_project(Frame& F0) {
    PHASE_FRAME;
    const int blk = (int)blockIdx.x;
    if (blk >= 128) { phase_peer_gather<8, false>(F, 0, false, 1); __syncthreads(); }
    pg8::Gemm g{(const pg8::bf16_t*)WSP(bf16, WS_H), (const pg8::bf16_t*)(WSP(bf16, WS_WIN) + (size_t)1 * ZW * 1024), NROW, ZW, 1024};
    TileWaitOrder S{blk < 128 ? 1 : 0, blk, F.wave, (const unsigned*)(F.ctl + CW_TILE), (unsigned*)(F.ctl + CW_TMO)};
    pg8::EpiZ E{(pg8::bf16_t*)WSP(bf16, WS_Z), ZW, MISCF + MISC_COS, MISCF + MISC_SIN, NLAT, QSCALE, Z8COLS / 256, ZGT / 256};
    pg8::gemm_phase<pg8::EpiZ, TileWaitOrder, PG8_ALIGN, PG8_SP2>(F.lds, g, S, E, F.wave);
}

#ifndef MK_ONE_LAUNCH
#define MK_ONE_LAUNCH 1
#endif
#ifndef ENMASK
#define ENMASK 0xFFFFFFFFu
#endif
#ifndef DUPMASK
#define DUPMASK 0u
#endif
#define EN(i, stmt) do { if (ENMASK & (1u << (i))) { stmt; } if (DUPMASK & (1u << (i))) { __syncthreads(); stmt; } } while (0)
constexpr int CVA = 8192, CVB = 9216;
constexpr int PH_PER_LAYER = 11, N_PHASES = 1 + DEPTH * PH_PER_LAYER;
__global__ void __launch_bounds__(NTHR, 2) fwd_kernel(Args args) {
    extern __shared__ __attribute__((aligned(16))) unsigned char lds[];
    Frame F;
    F.lds = (LAS unsigned char*)lds; F.ldsg = lds;
    F.MISC = (volatile LAS unsigned*)(F.lds + LDSCTL_OFF);
    F.tid = threadIdx.x; F.lane = F.tid & 63; F.wave = __builtin_amdgcn_readfirstlane(F.tid >> 6);
    F.G = gridDim.x; { const int bx = blockIdx.x; F.vcu = (F.G % 8 == 0) ? (bx % 8) * (F.G / 8) + bx / 8 : bx; }
    F.ws = (GAS unsigned char*)args.ws; F.out = args.out; F.ctl = (gu32*)(args.ws + WS_CTL);
    F.x = args.in[0]; F.c = args.in[1]; F.ctx = args.in[2]; F.c_ctx = args.in[3]; F.w_ada = args.in[4]; F.b_ada = args.in[5]; F.norm1_g = args.in[6]; F.norm2_g = args.in[7];
    F.w_in = args.in[8]; F.ml_gate_b = args.in[9]; F.ml_conv_w = args.in[10]; F.ml_norm_g = args.in[11]; F.cv_conv_w = args.in[12]; F.da_lam = args.in[13]; F.da_subln_g = args.in[14];
    F.w_da = args.in[15]; F.w_ml = args.in[16]; F.w_cv = args.in[17]; F.w_o = args.in[18]; F.peer_wq = args.in[19]; F.peer_keys = args.in[20]; F.peer_u = args.in[21]; F.peer_v = args.in[22];
    F.final_g = args.in[23];
    for (int u = F.tid; u < (LDS_BYTES - LDSCTL_OFF) / 4; u += NTHR) ((LAS unsigned*)(F.lds + LDSCTL_OFF))[u] = 0u;
    __syncthreads();
    XcdBarrier bar; bar.bar = (unsigned*)(F.ctl + CW_BAR); bar.x = 0; bar.st = nullptr; bar.leader = F.wave == 0;
    const int lo = args.ph_lo, hi = args.ph_hi;
#ifndef FUSE_PGG
#define FUSE_PGG 0
#endif
    const bool fusedpg = FUSE_PGG && F.G == 256;
#ifndef FUSE_PK
#define FUSE_PK 0
#endif
    const bool fusedpk = FUSE_PK && !fusedpg && F.G == 256 && (hi - lo > 1 || MK_ONE_LAUNCH);
    if (MK_ONE_LAUNCH || hi - lo > 1) bar = xcd_barrier_post((unsigned*)(F.ctl + CW_BAR), F.MISC + 8, F.tid == 0); bar.leader = F.wave == 0;
#if MK_ONE_LAUNCH
#define IN(k) true
#else
#define IN(k) (lo <= (k) && (k) < hi)
#endif
#define SEAM(k) do { if (IN(k) && IN((k) + 1)) xcd_barrier(bar); } while (0)
    if (IN(0)) { EN(0, phase_prologue(F)); } SEAM(0);
    static_assert(DEPTH == 2, "two layer bodies below");
    { constexpr int l = 0;
        constexpr int pb = 1 + l * PH_PER_LAYER;
        if (l == 0) { if (IN(pb + 0)) { EN(1, phase_norm(F, l, 0)); } SEAM(pb + 0); }
#ifdef PROBE_G1
        if (IN(pb + 1)) { phase_gemm_in_probe(F, l); }
#endif
        if (l == 0 || !fusedpg) { if (IN(pb + 1)) { EN(2, phase_gemm_in(F, l)); } SEAM(pb + 1); }
        if (IN(pb + 2)) { if (l == 1) { EN(4, phase_convbranch(F, l, 0, CVB, 0)); } EN(5, phase_ml_a(F, l)); EN(4, phase_convbranch(F, l, l == 0 ? 0 : CVB, l == 0 ? CVA : NLAT, F.G == 256 ? 64 : 0)); } SEAM(pb + 2);
        if (IN(pb + 3)) { EN(6, phase_ml_b(F)); EN(7, phase_attn(F, l)); } SEAM(pb + 3);
        if (IN(pb + 4)) { EN(8, phase_ml_c(F, l)); if (l == 0) { EN(4, phase_convbranch(F, l, CVA, NROW, F.G == 256 ? 64 : 0)); } } SEAM(pb + 4);
        if (IN(pb + 5)) { EN(9, phase_gemm_merge(F, l)); } SEAM(pb + 5);
        if (IN(pb + 6)) { EN(10, phase_gemm_out(F, l)); } SEAM(pb + 6);
        if (IN(pb + 7)) { EN(11, phase_norm(F, l, 1)); } SEAM(pb + 7);
        if (IN(pb + 8)) { EN(12, phase_gemm_peerq(F, l)); } SEAM(pb + 8);
        if (!fusedpk) { if (IN(pb + 9)) { EN(13, phase_peer_topk(F, l)); } SEAM(pb + 9); }
        if (IN(pb + 10)) { if (DUPMASK & (1u << 14)) { phase_peer_gather<8, false>(F, l, true, 0); __syncthreads(); } if (ENMASK & (1u << 14)) { if (l == 0 && fusedpg) phase_gather_project(F); else if (fusedpk) phase_peer_gather<8, true>(F, l, false, 0); else phase_peer_gather<16, false, false>(F, l, false, 0); } } SEAM(pb + 10);
    }
    { constexpr int l = 1;
        constexpr int pb = 1 + l * PH_PER_LAYER;
        if (l == 0) { if (IN(pb + 0)) { EN(1, phase_norm(F, l, 0)); } SEAM(pb + 0); }
#ifdef PROBE_G1
        if (IN(pb + 1)) { phase_gemm_in_probe(F, l); }
#endif
        if (l == 0 || !fusedpg) { if (IN(pb + 1)) { EN(2, phase_gemm_in(F, l)); } SEAM(pb + 1); }
        if (IN(pb + 2)) { if (l == 1) { EN(4, phase_convbranch(F, l, 0, CVB, 0)); } EN(5, phase_ml_a(F, l)); EN(4, phase_convbranch(F, l, l == 0 ? 0 : CVB, l == 0 ? CVA : NLAT, F.G == 256 ? 64 : 0)); } SEAM(pb + 2);
        if (IN(pb + 3)) { EN(6, phase_ml_b(F)); EN(7, phase_attn(F, l)); } SEAM(pb + 3);
        if (IN(pb + 4)) { EN(8, phase_ml_c(F, l)); if (l == 0) { EN(4, phase_convbranch(F, l, CVA, NROW, F.G == 256 ? 64 : 0)); } } SEAM(pb + 4);
        if (IN(pb + 5)) { EN(9, phase_gemm_merge(F, l)); } SEAM(pb + 5);
        if (IN(pb + 6)) { EN(10, phase_gemm_out(F, l)); } SEAM(pb + 6);
        if (IN(pb + 7)) { EN(11, phase_norm(F, l, 1)); } SEAM(pb + 7);
        if (IN(pb + 8)) { EN(12, phase_gemm_peerq(F, l)); } SEAM(pb + 8);
        if (!fusedpk) { if (IN(pb + 9)) { EN(13, phase_peer_topk(F, l)); } SEAM(pb + 9); }
        if (IN(pb + 10)) { if (DUPMASK & (1u << 14)) { phase_peer_gather<8, false>(F, l, true, 0); __syncthreads(); } if (ENMASK & (1u << 14)) { if (l == 0 && fusedpg) phase_gather_project(F); else if (fusedpk) phase_peer_gather<8, true>(F, l, false, 0); else phase_peer_gather<16, false, false>(F, l, false, 0); } } SEAM(pb + 10);
    }
#undef IN
#undef SEAM
}

extern "C" void kernel_launch(void* const* d_in, const int* in_sizes, int n_in, void* d_out, int out_size, void* d_ws, size_t ws_size, hipStream_t stream) {
    static int grid = 0;
    if (grid == 0) {
        if (n_in != 24 || in_sizes[0] != NLAT * DM || out_size != NLAT * DM || ws_size < WS_END) {
            fprintf(stderr, "kernel_launch: shape mismatch n_in %d in0 %d out %d ws %zu (need %zu)\n", n_in, n_in > 0 ? in_sizes[0] : -1, out_size, ws_size, (size_t)WS_END); grid = -1; return; }
        int dev = 0, cus = 0;
        if (hipGetDevice(&dev) != hipSuccess || hipDeviceGetAttribute(&cus, hipDeviceAttributeMultiprocessorCount, dev) != hipSuccess) { grid = -1; return; }
        if (hipFuncSetAttribute((const void*)fwd_kernel, hipFuncAttributeMaxDynamicSharedMemorySize, LDS_BYTES) != hipSuccess) { fprintf(stderr, "kernel_launch: hipFuncSetAttribute failed\n"); grid = -1; return; }
        int per_cu = 0;
        if (hipOccupancyMaxActiveBlocksPerMultiprocessor(&per_cu, (const void*)fwd_kernel, NTHR, LDS_BYTES) != hipSuccess || per_cu < 1) { fprintf(stderr, "kernel_launch: occupancy query says %d\n", per_cu); }
        (void)hipGetLastError();
        grid = cus;
    }
    if (grid < 0) return;
    (void)hipMemsetAsync((char*)d_ws + WS_CTL, 0, CTL_ZERO_BYTES, stream);
    Args a{};
    for (int i = 0; i < 24; ++i) a.in[i] = (const float*)d_in[i];
    a.out = (float*)d_out; a.ws = (unsigned char*)d_ws;
#if MK_ONE_LAUNCH
    a.ph_lo = 0; a.ph_hi = N_PHASES;
    hipLaunchKernelGGL(fwd_kernel, dim3(grid), dim3(NTHR), LDS_BYTES, stream, a);
#else
    for (int p = 0; p < N_PHASES; ++p) { a.ph_lo = p; a.ph_hi = p + 1; hipLaunchKernelGGL(fwd_kernel, dim3(grid), dim3(NTHR), LDS_BYTES, stream, a); }
#endif
    const hipError_t le = hipPeekAtLastError();
    if (le != hipSuccess) fprintf(stderr, "kernel_launch: launch failed: %s\n", hipGetErrorName(le));
}
```
